# Optimizing an MI355X kernel written in HIP

```python
import math
import jax, jax.numpy as jnp
from jax import lax
import numpy as np

D_MODEL = 1024
BATCH = 8
SEQ = 4096
DEPTH = 2

GRID_W = 64
CTX_LEN = 256
N_EVEN = (DEPTH + 1) // 2
N_ODD = DEPTH // 2
EPS = 1e-6

NA_HEADS = 8
NA_HEAD_DIM = 64
D_A = NA_HEADS * NA_HEAD_DIM
NA_WIN_H_MAX = 8
NA_WIN_W = 16
D_B = 512
CONV_WIDTH = 31
D_IN_AB = 3 * D_A + 2 * D_B
ML_HEADS = 8
ML_QK_DIM = 64
ML_V_DIM = 128
D_CQK = ML_HEADS * ML_QK_DIM
D_CV = ML_HEADS * ML_V_DIM
ML_SHORT_CONV = 5
ML_CHUNK = 128
D_IN_C = 2 * D_CQK + 2 * D_CV + 4 * ML_HEADS
ROPE_BASE = 10000.0
D_FF = ((math.ceil(8 * D_MODEL / 3) + 255) // 256) * 256

kernel_name = 'hybrid_na_conformer_mlstm_dit_block'


def rms_norm(x, g):
    xf = x.astype(jnp.float32)
    y = xf * lax.rsqrt(jnp.mean(xf * xf, axis=-1, keepdims=True) + EPS)
    return (y * g.astype(jnp.float32)).astype(x.dtype)


def layer_norm(x, g, b):
    xf = x.astype(jnp.float32)
    mu = jnp.mean(xf, axis=-1, keepdims=True)
    var = jnp.mean(jnp.square(xf - mu), axis=-1, keepdims=True)
    y = (xf - mu) * lax.rsqrt(var + EPS)
    return (y * g.astype(jnp.float32) + b.astype(jnp.float32)).astype(x.dtype)


def modulate(x, g, shift, scale):
    return rms_norm(x, g) * (1 + scale) + shift


def depthwise_conv(x, w, b):
    width = w.shape[0]
    pad = width // 2
    y = lax.conv_general_dilated(x, w[:, None, :].astype(x.dtype), window_strides=(1,),
                                 padding=[(pad, width - 1 - pad)],
                                 dimension_numbers=('NWC', 'WIO', 'NWC'),
                                 feature_group_count=x.shape[-1])
    return y + b


def rope_1d(xa, pos):
    nf = xa.shape[-1] // 2
    inv = ROPE_BASE ** (-jnp.arange(nf, dtype=jnp.float32) / nf)
    ang = pos.astype(jnp.float32)[:, None] * inv[None, :]
    cos = jnp.cos(ang)[None, :, None, :]
    sin = jnp.sin(ang)[None, :, None, :]
    x1 = xa[..., :nf].astype(jnp.float32)
    x2 = xa[..., nf:].astype(jnp.float32)
    return jnp.concatenate([x1 * cos - x2 * sin, x1 * sin + x2 * cos], axis=-1).astype(xa.dtype)


def axial_rope(x, row_pos, col_pos):
    half = x.shape[-1] // 2
    return jnp.concatenate([rope_1d(x[..., :half], row_pos), rope_1d(x[..., half:], col_pos)], axis=-1)


def swiglu(h, w_gate, w_up, w_down):
    return (jax.nn.silu(h @ w_gate) * (h @ w_up)) @ w_down


def neighbourhood_attention(q, k, v, k_ctx, v_ctx, rpb):
    B, T, H, dh = q.shape
    rows = T // GRID_W
    win_h = min(NA_WIN_H_MAX, rows)
    n_loc = win_h * NA_WIN_W
    qg = q.reshape(B, rows, GRID_W, H, dh)
    kg = k.reshape(B, rows, GRID_W, H, dh)
    vg = v.reshape(B, rows, GRID_W, H, dh)
    col = jnp.arange(GRID_W)
    c0 = jnp.clip(col - NA_WIN_W // 2, 0, GRID_W - NA_WIN_W)
    col_idx = c0[:, None] + jnp.arange(NA_WIN_W)[None, :]
    col_rel = col_idx - col[:, None] + (NA_WIN_W - 1)
    rpb_cols = rpb[:, :, col_rel]

    def row_block(r):
        r0 = jnp.clip(r - win_h // 2, 0, rows - win_h)
        q_r = lax.dynamic_index_in_dim(qg, r, axis=1, keepdims=False)
        k_rows = lax.dynamic_slice_in_dim(kg, r0, win_h, axis=1)
        v_rows = lax.dynamic_slice_in_dim(vg, r0, win_h, axis=1)
        k_win = k_rows[:, :, col_idx]
        v_win = v_rows[:, :, col_idx]
        s_loc = jnp.einsum('bchd,bacwhd->bhcaw', q_r, k_win).astype(jnp.float32)
        row_rel = r0 + jnp.arange(win_h) - r + (NA_WIN_H_MAX - 1)
        bias = jnp.take(rpb_cols, row_rel, axis=1).transpose(0, 2, 1, 3)
        s_loc = (s_loc + bias[None].astype(jnp.float32)).reshape(B, H, GRID_W, n_loc)
        s_ctx = jnp.einsum('bchd,bnhd->bhcn', q_r, k_ctx).astype(jnp.float32)
        p = jax.nn.softmax(jnp.concatenate([s_loc, s_ctx], axis=-1), axis=-1).astype(v.dtype)
        p_loc = p[..., :n_loc].reshape(B, H, GRID_W, win_h, NA_WIN_W)
        p_ctx = p[..., n_loc:]
        return (jnp.einsum('bhcaw,bacwhd->bchd', p_loc, v_win)
                + jnp.einsum('bhcn,bnhd->bchd', p_ctx, v_ctx))

    o = lax.map(row_block, jnp.arange(rows))
    return o.transpose(1, 0, 2, 3, 4).reshape(B, T, H * dh)


def na_conv_mixer(h_lat, h_ctx, w_in, q_g, k_g, rpb, conv_w, conv_b, ln_g, ln_b, w_out, ctx_out):
    def project(h):
        B, T, _ = h.shape
        q, k, v, u, gt = jnp.split(h @ w_in, [D_A, 2 * D_A, 3 * D_A, 3 * D_A + D_B], axis=-1)
        heads = lambda a: a.reshape(B, T, NA_HEADS, NA_HEAD_DIM)
        q = rms_norm(heads(q), q_g) * NA_HEAD_DIM ** -0.5
        k = rms_norm(heads(k), k_g)
        return q, k, heads(v), u * jax.nn.sigmoid(gt)

    def conv_module(glu):
        y = depthwise_conv(glu, conv_w, conv_b)
        return jax.nn.silu(layer_norm(y, ln_g, ln_b))

    qc, kc, vc, glu_c = project(h_ctx)
    ql, kl, vl, glu_l = project(h_lat)
    att_lat = neighbourhood_attention(ql, kl, vl, kc, vc, rpb)
    out_lat = jnp.concatenate([att_lat, conv_module(glu_l)], axis=-1) @ w_out
    out_ctx = None
    if ctx_out:
        B, N = qc.shape[:2]
        s = jnp.einsum('bnhd,bmhd->bhnm', qc, kc).astype(jnp.float32)
        p = jax.nn.softmax(s, axis=-1).astype(vc.dtype)
        att_c = jnp.einsum('bhnm,bmhd->bnhd', p, vc).reshape(B, N, D_A)
        out_ctx = jnp.concatenate([att_c, conv_module(glu_c)], axis=-1) @ w_out
    return out_lat, out_ctx


def mlstm_chunkwise(q, k, v, ig, lf, state, return_h):
    B, H, T, dk = q.shape
    L = min(ML_CHUNK, T)
    nc = T // L

    def chunks(a):
        a = a.astype(jnp.float32).reshape(a.shape[:2] + (nc, L) + a.shape[3:])
        return jnp.moveaxis(a, 2, 0)

    causal = jnp.tril(jnp.ones((L, L), dtype=bool))

    def step(carry, xs):
        S, n, m = carry
        qc, kc, vc, igc, lfc = xs
        b = jnp.cumsum(lfc, axis=-1)
        b_end = b[..., -1]
        w_end = b_end[..., None] - b + igc
        m_new = jnp.maximum(b_end + m, jnp.max(w_end, axis=-1))
        decay = jnp.exp(b_end + m - m_new)
        wk = jnp.exp(w_end - m_new[..., None])
        S_new = decay[..., None, None] * S + jnp.einsum('bhl,bhlk,bhlv->bhkv', wk, kc, vc)
        n_new = decay[..., None] * n + jnp.einsum('bhl,bhlk->bhk', wk, kc)
        if not return_h:
            return (S_new, n_new, m_new), None
        g = b + m[..., None]
        dmat = jnp.where(causal, b[..., :, None] - b[..., None, :] + igc[..., None, :], -jnp.inf)
        m_q = jnp.maximum(g, jnp.max(dmat, axis=-1))
        p = jnp.exp(dmat - m_q[..., None]) * jnp.einsum('bhik,bhjk->bhij', qc, kc)
        inter = jnp.exp(g - m_q)
        num = inter[..., None] * jnp.einsum('bhik,bhkv->bhiv', qc, S) + jnp.einsum('bhij,bhjv->bhiv', p, vc)
        den = inter * jnp.einsum('bhik,bhk->bhi', qc, n) + jnp.sum(p, axis=-1)
        h = num / jnp.maximum(jnp.abs(den), jnp.exp(-m_q))[..., None]
        return (S_new, n_new, m_new), h

    carry, h = lax.scan(step, state, (chunks(q), chunks(k), chunks(v), chunks(ig), chunks(lf)))
    if return_h:
        h = jnp.moveaxis(h, 0, 2).reshape(B, H, T, -1)
    return h, carry


def mlstm_mixer(h_lat, h_ctx, w_in, conv_w, conv_b, gate_b, norm_g, w_out, row_pos, col_pos, ctx_out):
    def project(h, use_rope):
        B, T, _ = h.shape
        qk, v, o, gates = jnp.split(h @ w_in, [2 * D_CQK, 2 * D_CQK + D_CV, 2 * D_CQK + 2 * D_CV], axis=-1)
        qk = jax.nn.silu(depthwise_conv(qk, conv_w, conv_b))
        q, k = jnp.split(qk, 2, axis=-1)
        q = q.reshape(B, T, ML_HEADS, ML_QK_DIM) * ML_QK_DIM ** -0.5
        k = k.reshape(B, T, ML_HEADS, ML_QK_DIM)
        if use_rope:
            q = axial_rope(q, row_pos, col_pos)
            k = axial_rope(k, row_pos, col_pos)
        v = v.reshape(B, T, ML_HEADS, ML_V_DIM)
        heads = lambda a: jnp.transpose(a, (0, 2, 1, 3))
        g = jnp.transpose(gates.astype(jnp.float32) + gate_b.astype(jnp.float32), (0, 2, 1))
        ig_f, ig_b, fg_f, fg_b = jnp.split(g, 4, axis=1)
        return (heads(q), heads(k), heads(v), o, ig_f, ig_b,
                jax.nn.log_sigmoid(fg_f), jax.nn.log_sigmoid(fg_b))

    rev = lambda a: jnp.flip(a, axis=2)
    qc, kc, vc, oc, igf_c, igb_c, lff_c, lfb_c = project(h_ctx, False)
    ql, kl, vl, ol, igf_l, igb_l, lff_l, lfb_l = project(h_lat, True)
    B, H = ql.shape[:2]
    zero = (jnp.zeros((B, H, ML_QK_DIM, ML_V_DIM), jnp.float32),
            jnp.zeros((B, H, ML_QK_DIM), jnp.float32),
            jnp.zeros((B, H), jnp.float32))
    hcf, st_f = mlstm_chunkwise(qc, kc, vc, igf_c, lff_c, zero, ctx_out)
    hcb, st_b = mlstm_chunkwise(rev(qc), rev(kc), rev(vc), rev(igb_c), rev(lfb_c), zero, ctx_out)
    hlf, _ = mlstm_chunkwise(ql, kl, vl, igf_l, lff_l, st_f, True)
    hlb, _ = mlstm_chunkwise(rev(ql), rev(kl), rev(vl), rev(igb_l), rev(lfb_l), st_b, True)

    def finish(h, o):
        Bh, Hh, T, dv = h.shape
        h = rms_norm(jnp.transpose(h, (0, 2, 1, 3)), norm_g.reshape(Hh, dv)).reshape(Bh, T, Hh * dv)
        return (h.astype(o.dtype) * jax.nn.sigmoid(o)) @ w_out

    out_lat = finish(hlf + rev(hlb), ol)
    out_ctx = finish(hcf + rev(hcb), oc) if ctx_out else None
    return out_lat, out_ctx


def setup_inputs(seed: int = 0) -> dict:
    key = jax.random.key(seed)
    ks = iter(jax.random.split(key, 40))
    nrm = lambda shape, s: jax.random.normal(next(ks), shape, jnp.float32) * s
    D = D_MODEL
    inp = {}
    inp['x'] = nrm((BATCH, SEQ, D), 1.0)
    inp['c'] = nrm((BATCH, D), 1.0)
    inp['ctx'] = nrm((BATCH, CTX_LEN, D), 1.0)
    inp['c_ctx'] = nrm((D,), 1.0)
    inp['ada_w'] = nrm((DEPTH, D, 6 * D), 0.5 * D ** -0.5)
    inp['ada_b'] = nrm((DEPTH, 6 * D), 0.02)
    inp['norm_mix_g'] = 1.0 + nrm((DEPTH, D), 0.02)
    inp['norm_ffn_g'] = 1.0 + nrm((DEPTH, D), 0.02)
    inp['ffn_w_gate'] = nrm((DEPTH, D, D_FF), D ** -0.5)
    inp['ffn_w_up'] = nrm((DEPTH, D, D_FF), D ** -0.5)
    inp['ffn_w_down'] = nrm((DEPTH, D_FF, D), D_FF ** -0.5)
    inp['ab_w_in'] = nrm((N_EVEN, D, D_IN_AB), D ** -0.5)
    inp['na_q_norm_g'] = 1.0 + nrm((N_EVEN, NA_HEAD_DIM), 0.02)
    inp['na_k_norm_g'] = 1.0 + nrm((N_EVEN, NA_HEAD_DIM), 0.02)
    inp['na_rpb'] = nrm((N_EVEN, NA_HEADS, 2 * NA_WIN_H_MAX - 1, 2 * NA_WIN_W - 1), 0.1)
    inp['conv_w'] = nrm((N_EVEN, CONV_WIDTH, D_B), CONV_WIDTH ** -0.5)
    inp['conv_b'] = nrm((N_EVEN, D_B), 0.02)
    inp['conv_ln_g'] = 1.0 + nrm((N_EVEN, D_B), 0.02)
    inp['conv_ln_b'] = nrm((N_EVEN, D_B), 0.02)
    inp['ab_w_out'] = nrm((N_EVEN, D_A + D_B, D), (D_A + D_B) ** -0.5)
    inp['ml_w_in'] = nrm((N_ODD, D, D_IN_C), D ** -0.5)
    inp['ml_conv_w'] = nrm((N_ODD, ML_SHORT_CONV, 2 * D_CQK), ML_SHORT_CONV ** -0.5)
    inp['ml_conv_b'] = nrm((N_ODD, 2 * D_CQK), 0.02)
    inp['ml_gate_b'] = jnp.concatenate([nrm((N_ODD, 2 * ML_HEADS), 0.1),
                                        3.0 + nrm((N_ODD, 2 * ML_HEADS), 0.5)], axis=-1)
    inp['ml_norm_g'] = 1.0 + nrm((N_ODD, D_CV), 0.02)
    inp['ml_w_out'] = nrm((N_ODD, D_CV, D), D_CV ** -0.5)
    return inp


def reference(x, c, ctx, c_ctx, ada_w, ada_b, norm_mix_g, norm_ffn_g, ffn_w_gate, ffn_w_up, ffn_w_down,
              ab_w_in, na_q_norm_g, na_k_norm_g, na_rpb, conv_w, conv_b, conv_ln_g, conv_ln_b, ab_w_out,
              ml_w_in, ml_conv_w, ml_conv_b, ml_gate_b, ml_norm_g, ml_w_out):
    T = x.shape[1]
    t = jnp.arange(T)
    row_pos = t // GRID_W
    col_pos = t % GRID_W
    s_lat = jax.nn.silu(c)
    s_ctx = jax.nn.silu(c_ctx)
    for l in range(DEPTH):
        last = l == DEPTH - 1
        j = l // 2
        mod_lat = (s_lat @ ada_w[l] + ada_b[l])[:, None, :]
        mod_ctx = s_ctx @ ada_w[l] + ada_b[l]
        sh1, sc1, g1, sh2, sc2, g2 = jnp.split(mod_lat, 6, axis=-1)
        csh1, csc1, cg1, csh2, csc2, cg2 = jnp.split(mod_ctx, 6, axis=-1)
        h_lat = modulate(x, norm_mix_g[l], sh1, sc1)
        h_ctx = modulate(ctx, norm_mix_g[l], csh1, csc1)
        if l % 2 == 0:
            out_lat, out_ctx = na_conv_mixer(h_lat, h_ctx, ab_w_in[j], na_q_norm_g[j], na_k_norm_g[j], na_rpb[j],
                                             conv_w[j], conv_b[j], conv_ln_g[j], conv_ln_b[j], ab_w_out[j],
                                             not last)
        else:
            out_lat, out_ctx = mlstm_mixer(h_lat, h_ctx, ml_w_in[j], ml_conv_w[j], ml_conv_b[j], ml_gate_b[j],
                                           ml_norm_g[j], ml_w_out[j], row_pos, col_pos, not last)
        x = x + g1 * out_lat
        x = x + g2 * swiglu(modulate(x, norm_ffn_g[l], sh2, sc2), ffn_w_gate[l], ffn_w_up[l], ffn_w_down[l])
        if not last:
            ctx = ctx + cg1 * out_ctx
            ctx = ctx + cg2 * swiglu(modulate(ctx, norm_ffn_g[l], csh2, csc2),
                                     ffn_w_gate[l], ffn_w_up[l], ffn_w_down[l])
    return x
```

```cpp
#include <hip/hip_runtime.h>
#include <hip/hip_cooperative_groups.h>
#include <cstdio>
#include <cstdint>
namespace cg = cooperative_groups;
#ifndef REPMASK
#define REPMASK 0
#endif

namespace pg8 {
#define PG8_LAS __attribute__((address_space(3)))
typedef unsigned short bf16_t;
typedef short bf16x8 __attribute__((ext_vector_type(8)));
typedef float f32x4 __attribute__((ext_vector_type(4)));
typedef unsigned u32x4 __attribute__((ext_vector_type(4)));
typedef unsigned u32x2 __attribute__((ext_vector_type(2)));
constexpr int BM = 256, BK = 64, HALF = 128, HTB = HALF * BK * 2  , STAGE_BYTES = 8 * HTB, NXCD = 8, WGM = 4;

__host__ __device__ __forceinline__ int lds_byte(int r, int c) { const int st = (r >> 4) * 2 + (c >> 5), rr = r & 15, cc = c & 31, ob = rr * 64 + cc * 2; return st * 1024 + (ob ^ (((ob >> 9) & 1) << 5)); }
__host__ __device__ __forceinline__ void stage_rc(int b, int& R, int& C) { const int st = b / 1024, sb = b % 1024, swz = sb ^ (((sb >> 9) & 1) << 5); R = (st >> 1) * 16 + swz / 64; C = (st & 1) * 32 + (swz % 64) / 2; }
__host__ __device__ __forceinline__ int perm32(int rho) { const int n = rho >> 4, i = rho & 15; return 8 * (i >> 2) + 4 * n + (i & 3); }

struct Unit { int pm, pn; };
struct Gemm { const bf16_t* A; const bf16_t* Bt; int M, N, K; };

struct StaticOrder {
    int nM, nN, nwg, G, c;
    __host__ __device__ void init(int M, int N, int G_, int c_) { nM = M / BM; nN = N / BM; nwg = nM * nN; G = G_; c = c_; }
    __host__ __device__ bool next(int i, Unit& u) const {
        const long L = (long)i * G + c; if (L >= nwg) return false;
        int wgid = (int)L; { const int q = nwg / NXCD, r = nwg % NXCD, xcd = wgid % NXCD, off = wgid / NXCD; wgid = (xcd < r ? xcd * (q + 1) : r * (q + 1) + (xcd - r) * q) + off; }
        const int nig = WGM * nN, gid = wgid / nig, fm = gid * WGM, gsz = (nM - fm) < WGM ? (nM - fm) : WGM;
        u.pm = fm + ((wgid % nig) % gsz); u.pn = (wgid % nig) / gsz; return true;
    }
    __device__ __forceinline__ void a_ready(const Unit&) const {}
    __device__ __forceinline__ void done(const Unit&) const {}
};


struct OneUnit { int pm, pn, valid;
    __device__ __forceinline__ bool next(int i, Unit& u) const { if (i != 0 || !valid) return false; u.pm = pm; u.pn = pn; return true; }
    __device__ __forceinline__ void a_ready(const Unit&) const {}
    __device__ __forceinline__ void done(const Unit&) const {} };
struct XcdPanels { int x, j, nb, P, PL, pm0, pmx, nN;
    __device__ __forceinline__ bool next(int i, Unit& u) const {
        const int t = i * nb + j; if (j < 0 || t >= P * nN) return false;
        int grp = t / (2 * nN), r = t - grp * 2 * nN; const int gsz = (P - 2 * grp) >= 2 ? 2 : 1;
        const int idx = 2 * grp + (gsz == 2 ? (r & 1) : 0); u.pn = gsz == 2 ? (r >> 1) : r;
        u.pm = idx < PL ? pm0 + x * PL + idx : pmx + x; return true; }
    __device__ __forceinline__ void a_ready(const Unit&) const {}
    __device__ __forceinline__ void done(const Unit&) const {} };

__device__ __forceinline__ unsigned cvt_pk_bf16(float lo, float hi) { unsigned r; asm volatile("v_cvt_pk_bf16_f32 %0, %1, %2" : "=v"(r) : "v"(lo), "v"(hi)); return r; }
__device__ __forceinline__ u32x4 pack8(const f32x4 v0, const f32x4 v1) { u32x4 w; w.x = cvt_pk_bf16(v0[0], v0[1]); w.y = cvt_pk_bf16(v0[2], v0[3]); w.z = cvt_pk_bf16(v1[0], v1[1]); w.w = cvt_pk_bf16(v1[2], v1[3]); return w; }
__device__ __forceinline__ float fast_sigmoid(float x) { return __builtin_amdgcn_rcpf(1.0f + __expf(-x)); }

struct EpiStore {
    static constexpr bool PERM = true, AFTER_DRAIN = false;
    bf16_t* O; int ldc;
    __device__ __forceinline__ void operator()(const f32x4 (&acc)[2][2][4][2], const Unit& u, int wr, int wc, int fr, int fq) const {
        const int row0 = u.pm * BM + wr * 64 + fr, col0 = u.pn * BM + wc * 32 + 8 * fq;
#pragma unroll
        for (int ai = 0; ai < 2; ++ai)
#pragma unroll
            for (int m = 0; m < 4; ++m) { bf16_t* rowp = O + (size_t)(row0 + ai * HALF + m * 16) * ldc + col0;
#pragma unroll
                for (int bj = 0; bj < 2; ++bj) *(u32x4*)(rowp + bj * HALF) = pack8(acc[ai][bj][m][0], acc[ai][bj][m][1]); }
    }
};
struct EpiResid {
    static constexpr bool PERM = true, AFTER_DRAIN = false;
    const bf16_t* res_lat; const bf16_t* res_ctx; float* out; const float* gate;
    __device__ __forceinline__ void operator()(const f32x4 (&acc)[2][2][4][2], const Unit& u, int wr, int wc, int fr, int fq) const {
        const int base = u.pm * BM; const int bb = base < 32768 ? (base >> 12) : 8; const bf16_t* res = base < 32768 ? res_lat : res_ctx;
        const int row0 = base + wr * 64 + fr, col0 = u.pn * BM + wc * 32 + 8 * fq;
        f32x4 gv[2][2];
#pragma unroll
        for (int bj = 0; bj < 2; ++bj)
#pragma unroll
            for (int n = 0; n < 2; ++n) gv[bj][n] = *(const f32x4*)(gate + (size_t)bb * 6144 + col0 + bj * HALF + 4 * n);
#pragma unroll
        for (int ai = 0; ai < 2; ++ai)
#pragma unroll
            for (int m = 0; m < 4; ++m) { const size_t ro = (size_t)(row0 + ai * HALF + m * 16) * 1024 + col0;
#pragma unroll
                for (int bj = 0; bj < 2; ++bj)
#pragma unroll
                    for (int n = 0; n < 2; ++n) { const size_t ix = ro + bj * HALF + 4 * n; const u32x2 rw = *(const u32x2*)(res + ix);
                        const f32x4 r = {__builtin_bit_cast(float, rw.x << 16), __builtin_bit_cast(float, rw.x & 0xffff0000u), __builtin_bit_cast(float, rw.y << 16), __builtin_bit_cast(float, rw.y & 0xffff0000u)};
                        *(f32x4*)(out + ix) = r + gv[bj][n] * acc[ai][bj][m][n]; } }
    }
};
struct EpiSwiGLU {
    static constexpr bool PERM = true, AFTER_DRAIN = false;
    bf16_t* O; int ldc;
    __device__ __forceinline__ void operator()(const f32x4 (&acc)[2][2][4][2], const Unit& u, int wr, int wc, int fr, int fq) const {
        const int row0 = u.pm * BM + wr * 64 + fr, col0 = u.pn * HALF + wc * 32 + 8 * fq;
#pragma unroll
        for (int ai = 0; ai < 2; ++ai)
#pragma unroll
            for (int m = 0; m < 4; ++m) {
                f32x4 o[2];
#pragma unroll
                for (int n = 0; n < 2; ++n)
#pragma unroll
                    for (int e = 0; e < 4; ++e) { const float g = acc[ai][0][m][n][e], up = acc[ai][1][m][n][e]; o[n][e] = g * fast_sigmoid(g) * up; }
                *(u32x4*)(O + (size_t)(row0 + ai * HALF + m * 16) * ldc + col0) = pack8(o[0], o[1]);
            }
    }
};
struct EpiMlIn {
    static constexpr bool PERM = true, AFTER_DRAIN = false;
    bf16_t* O; float* gates; const float* gate_b;
    __device__ __forceinline__ void operator()(const f32x4 (&acc)[2][2][4][2], const Unit& u, int wr, int wc, int fr, int fq) const {
        const int row0 = u.pm * BM + wr * 64 + fr;
        if (u.pn < 12) {
            const int col0 = u.pn * BM + wc * 32 + 8 * fq;
#pragma unroll
            for (int ai = 0; ai < 2; ++ai)
#pragma unroll
                for (int m = 0; m < 4; ++m) { bf16_t* rowp = O + (size_t)(row0 + ai * HALF + m * 16) * 3072 + col0;
#pragma unroll
                    for (int bj = 0; bj < 2; ++bj) *(u32x4*)(rowp + bj * HALF) = pack8(acc[ai][bj][m][0], acc[ai][bj][m][1]); }
        } else if (wc == 0) {
            const int col0 = 8 * fq;
#pragma unroll
            for (int ai = 0; ai < 2; ++ai)
#pragma unroll
                for (int m = 0; m < 4; ++m)
#pragma unroll
                    for (int n = 0; n < 2; ++n) { f32x4 v = acc[ai][0][m][n] + *(const f32x4*)(gate_b + col0 + 4 * n);
                        if (col0 >= 16) {
#pragma unroll
                            for (int e = 0; e < 4; ++e) { const float x = v[e]; v[e] = fminf(x, 0.f) - log1pf(__expf(-fabsf(x))); } }
                        *(f32x4*)(gates + (size_t)(row0 + ai * HALF + m * 16) * 32 + col0 + 4 * n) = v; }
        }
    }
};


template <bool RES_BF16> struct EpiResid2 {
    static constexpr bool PERM = true, AFTER_DRAIN = false;
    const void* res_lat; const void* res_ctx; bf16_t* out; const float* gate; const float* gm; bf16_t* A2; float* rss;
    __device__ __forceinline__ void operator()(const f32x4 (&acc)[2][2][4][2], const Unit& u, int wr, int wc, int fr, int fq) const {
        const int base = u.pm * BM; const int bb = base < 32768 ? (base >> 12) : 8; const void* res = base < 32768 ? res_lat : res_ctx;
        const int row0 = base + wr * 64 + fr, col0 = u.pn * BM + wc * 32 + 8 * fq;
        f32x4 gv[2][2], gmv[2][2];
#pragma unroll
        for (int bj = 0; bj < 2; ++bj)
#pragma unroll
            for (int n = 0; n < 2; ++n) { gv[bj][n] = *(const f32x4*)(gate + (size_t)bb * 6144 + col0 + bj * HALF + 4 * n); gmv[bj][n] = *(const f32x4*)(gm + (size_t)bb * 1024 + col0 + bj * HALF + 4 * n); }
#pragma unroll
        for (int ai = 0; ai < 2; ++ai)
#pragma unroll
            for (int m = 0; m < 4; ++m) { const int row = row0 + ai * HALF + m * 16; const size_t ro = (size_t)row * 1024 + col0; float ss = 0.f;
#pragma unroll
                for (int bj = 0; bj < 2; ++bj) { f32x4 r[2];
                    if constexpr (RES_BF16) { const u32x4 rw = *(const u32x4*)((const bf16_t*)res + ro + bj * HALF);
                        r[0] = (f32x4){__builtin_bit_cast(float, rw.x << 16), __builtin_bit_cast(float, rw.x & 0xffff0000u), __builtin_bit_cast(float, rw.y << 16), __builtin_bit_cast(float, rw.y & 0xffff0000u)};
                        r[1] = (f32x4){__builtin_bit_cast(float, rw.z << 16), __builtin_bit_cast(float, rw.z & 0xffff0000u), __builtin_bit_cast(float, rw.w << 16), __builtin_bit_cast(float, rw.w & 0xffff0000u)}; }
                    else { r[0] = *(const f32x4*)((const float*)res + ro + bj * HALF); r[1] = *(const f32x4*)((const float*)res + ro + bj * HALF + 4); }
                    f32x4 o[2];
#pragma unroll
                    for (int n = 0; n < 2; ++n) { o[n] = r[n] + gv[bj][n] * acc[ai][bj][m][n]; ss += (o[n][0] * o[n][0] + o[n][1] * o[n][1]) + (o[n][2] * o[n][2] + o[n][3] * o[n][3]); }
                    *(u32x4*)(out + ro + bj * HALF) = pack8(o[0], o[1]);
                    *(u32x4*)(A2 + ro + bj * HALF) = pack8(o[0] * gmv[bj][0], o[1] * gmv[bj][1]); }
                ss += __shfl_xor(ss, 16); ss += __shfl_xor(ss, 32);
                if (fq == 0) (void)__hip_atomic_fetch_add(rss + row, ss, __ATOMIC_RELAXED, __HIP_MEMORY_SCOPE_AGENT); }
    }
};
struct EpiSwiGLU2 {
    static constexpr bool PERM = true, AFTER_DRAIN = false;
    bf16_t* O; int ldc; const float* rss; const float* shw; int ldn;
    __device__ __forceinline__ void operator()(const f32x4 (&acc)[2][2][4][2], const Unit& u, int wr, int wc, int fr, int fq) const {
        const int base = u.pm * BM; const int bb = base < 32768 ? (base >> 12) : 8;
        const int row0 = base + wr * 64 + fr, col0 = u.pn * HALF + wc * 32 + 8 * fq, bcol0 = u.pn * BM + wc * 32 + 8 * fq;
        f32x4 sg[2], su[2];
#pragma unroll
        for (int n = 0; n < 2; ++n) { sg[n] = *(const f32x4*)(shw + (size_t)bb * ldn + bcol0 + 4 * n); su[n] = *(const f32x4*)(shw + (size_t)bb * ldn + bcol0 + HALF + 4 * n); }
#pragma unroll
        for (int ai = 0; ai < 2; ++ai)
#pragma unroll
            for (int m = 0; m < 4; ++m) { const int row = row0 + ai * HALF + m * 16; const float rstd = rsqrtf(rss[row] * (1.f / 1024.f) + 1e-6f);
                f32x4 o[2];
#pragma unroll
                for (int n = 0; n < 2; ++n)
#pragma unroll
                    for (int e = 0; e < 4; ++e) { const float g = acc[ai][0][m][n][e] * rstd + sg[n][e], up = acc[ai][1][m][n][e] * rstd + su[n][e]; o[n][e] = g * fast_sigmoid(g) * up; }
                *(u32x4*)(O + (size_t)row * ldc + col0) = pack8(o[0], o[1]);
            }
    }
};
struct EpiMlIn2 {
    static constexpr bool PERM = true, AFTER_DRAIN = false;
    bf16_t* O; float* gates; const float* gate_b; const float* rss; const float* shw;
    __device__ __forceinline__ void operator()(const f32x4 (&acc)[2][2][4][2], const Unit& u, int wr, int wc, int fr, int fq) const {
        const int base = u.pm * BM; const int bb = base < 32768 ? (base >> 12) : 8;
        const int row0 = base + wr * 64 + fr;
        if (u.pn < 12) {
            const int col0 = u.pn * BM + wc * 32 + 8 * fq;
            f32x4 sv[2][2];
#pragma unroll
            for (int bj = 0; bj < 2; ++bj)
#pragma unroll
                for (int n = 0; n < 2; ++n) sv[bj][n] = *(const f32x4*)(shw + (size_t)bb * 3328 + col0 + bj * HALF + 4 * n);
#pragma unroll
            for (int ai = 0; ai < 2; ++ai)
#pragma unroll
                for (int m = 0; m < 4; ++m) { const int row = row0 + ai * HALF + m * 16; const float rstd = rsqrtf(rss[row] * (1.f / 1024.f) + 1e-6f); bf16_t* rowp = O + (size_t)row * 3072 + col0;
#pragma unroll
                    for (int bj = 0; bj < 2; ++bj) *(u32x4*)(rowp + bj * HALF) = pack8(acc[ai][bj][m][0] * rstd + sv[bj][0], acc[ai][bj][m][1] * rstd + sv[bj][1]); }
        } else if (wc == 0) {
            const int col0 = 8 * fq;
#pragma unroll
            for (int ai = 0; ai < 2; ++ai)
#pragma unroll
                for (int m = 0; m < 4; ++m) { const int row = row0 + ai * HALF + m * 16; const float rstd = rsqrtf(rss[row] * (1.f / 1024.f) + 1e-6f);
#pragma unroll
                    for (int n = 0; n < 2; ++n) { f32x4 v = acc[ai][0][m][n] * rstd + *(const f32x4*)(shw + (size_t)bb * 3328 + 3072 + col0 + 4 * n) + *(const f32x4*)(gate_b + col0 + 4 * n);
                        if (col0 >= 16) {
#pragma unroll
                            for (int e = 0; e < 4; ++e) { const float x = v[e]; v[e] = fminf(x, 0.f) - log1pf(__expf(-fabsf(x))); } }
                        *(f32x4*)(gates + (size_t)row * 32 + col0 + 4 * n) = v; } }
        }
    }
};

template <class Epi, class Sched, bool ALIGN_EPI = false, bool SP2 = false>
__device__ __forceinline__ void gemm_phase(PG8_LAS unsigned char* lds, const Gemm g, const Sched& S, const Epi& E) {
    const int tid = threadIdx.x, wid = __builtin_amdgcn_readfirstlane(tid >> 6), lane = tid & 63, wr = wid >> 2, wc = wid & 3, fr = lane & 15, fq = lane >> 4;
    const int K = g.K, nt = K / BK;
    unsigned voffA[2], voffB[2];
#pragma unroll
    for (int i = 0; i < 2; ++i) { int R, C; stage_rc(tid * 16 + i * 8192, R, C); const int Rb = Epi::PERM ? ((R & ~31) + perm32(R & 31)) : R;
        voffA[i] = (unsigned)(R * K + C) * 2u; voffB[i] = (unsigned)(Rb * K + C) * 2u; }
    const size_t kstep = (size_t)(BK * 2);
    const size_t hstep = (size_t)HALF * K * 2;
    const size_t tstep = 2 * hstep;
    const unsigned ldsw = (unsigned)wid * 1024u;
    const int aoff = lds_byte(wr * 64 + fr, fq * 8), boff = lds_byte(wc * 32 + fr, fq * 8);
#define PG8_SA(b, h) (((b) * 2 + (h)) * HTB)
#define PG8_SB(b, h) ((4 + (b) * 2 + (h)) * HTB)
#define PG8_STAGE(bufoff, gbase, voff) do { _Pragma("unroll") for (int _i = 0; _i < 2; ++_i) \
        __builtin_amdgcn_global_load_lds((const unsigned*)((const char*)(gbase) + (voff)[_i]), (PG8_LAS unsigned*)(lds + (bufoff) + ldsw + _i * 8192), 16, 0, 0); } while (0)
#define PG8_LDA(dst, b, h) do { _Pragma("unroll") for (int m = 0; m < 4; ++m) _Pragma("unroll") for (int k = 0; k < 2; ++k) dst[m][k] = *(const PG8_LAS bf16x8*)(lds + PG8_SA(b, h) + aoff + m * 2048 + k * 1024); } while (0)
#define PG8_LDB(dst, b, h) do { _Pragma("unroll") for (int n = 0; n < 2; ++n) _Pragma("unroll") for (int k = 0; k < 2; ++k) dst[n][k] = *(const PG8_LAS bf16x8*)(lds + PG8_SB(b, h) + boff + n * 2048 + k * 1024); } while (0)
#define PG8_MMA(ai, bj, At, Bt) do { __builtin_amdgcn_s_setprio(1); _Pragma("unroll") for (int m = 0; m < 4; ++m) _Pragma("unroll") for (int n = 0; n < 2; ++n) _Pragma("unroll") for (int k = 0; k < 2; ++k) \
        acc[ai][bj][m][n] = __builtin_amdgcn_mfma_f32_16x16x32_bf16(Bt[n][k], At[m][k], acc[ai][bj][m][n], 0, 0, 0); __builtin_amdgcn_s_setprio(0); } while (0)
#define PG8_WAIT_V(n) asm volatile("s_waitcnt vmcnt(" #n ")" ::: "memory")
#define PG8_WAIT_L(n) asm volatile("s_waitcnt lgkmcnt(" #n ")" ::: "memory")
#define PG8_BAR __builtin_amdgcn_s_barrier()
#define PG8_SCHED __builtin_amdgcn_sched_barrier(0)
    Unit cur, nxt; int ui = 0;
    if (!S.next(0, cur)) return;
    f32x4 acc[2][2][4][2];
#pragma unroll
    for (int a = 0; a < 2; ++a)
#pragma unroll
        for (int b = 0; b < 2; ++b)
#pragma unroll
            for (int m = 0; m < 4; ++m)
#pragma unroll
                for (int n = 0; n < 2; ++n) acc[a][b][m][n] = (f32x4){0.f, 0.f, 0.f, 0.f};
    bf16x8 At[4][2], B0[2][2], B1[2][2];
    const char* cA = (const char*)g.A + (size_t)cur.pm * tstep; const char* cB = (const char*)g.Bt + (size_t)cur.pn * tstep;
    S.a_ready(cur);
    if constexpr (SP2) {
        PG8_STAGE(PG8_SB(0, 0), cB, voffB); PG8_STAGE(PG8_SB(0, 1), cB + hstep, voffB); PG8_STAGE(PG8_SA(0, 0), cA, voffA); PG8_STAGE(PG8_SA(0, 1), cA + hstep, voffA);
        if (wr == 1) PG8_BAR;
        PG8_WAIT_V(2); PG8_BAR;
        PG8_STAGE(PG8_SB(1, 0), cB + kstep, voffB); PG8_STAGE(PG8_SA(1, 0), cA + kstep, voffA); PG8_STAGE(PG8_SB(1, 1), cB + hstep + kstep, voffB);
        PG8_WAIT_V(6); PG8_BAR;
    } else {
        PG8_STAGE(PG8_SB(0, 0), cB, voffB); PG8_STAGE(PG8_SA(0, 0), cA, voffA); PG8_STAGE(PG8_SB(0, 1), cB + hstep, voffB); PG8_STAGE(PG8_SA(0, 1), cA + hstep, voffA);
        if (wr == 1) PG8_BAR;
        PG8_WAIT_V(4); PG8_BAR;
        PG8_STAGE(PG8_SB(1, 0), cB + kstep, voffB); PG8_STAGE(PG8_SA(1, 0), cA + kstep, voffA); PG8_STAGE(PG8_SB(1, 1), cB + hstep + kstep, voffB);
        PG8_WAIT_V(6); PG8_BAR;
    }
    for (;;) {
        const bool has_next = S.next(ui + 1, nxt);
        const char* nA = has_next ? (const char*)g.A + (size_t)nxt.pm * tstep : cA; const char* nB = has_next ? (const char*)g.Bt + (size_t)nxt.pn * tstep : cB;
        for (int t = 0; t < nt; t += 2) {
            const bool last = (t == nt - 2);
            const char* a1 = cA + (size_t)(t + 1) * kstep;
            const char* a2 = last ? nA : cA + (size_t)(t + 2) * kstep; const char* b2 = last ? nB : cB + (size_t)(t + 2) * kstep;
            const char* a3 = a2 + kstep; const char* b3 = b2 + kstep;
            if (last && has_next) S.a_ready(nxt);
            if constexpr (SP2) {
            PG8_LDB(B0, 0, 0); PG8_LDB(B1, 0, 1); PG8_SCHED; PG8_LDA(At, 0, 0); PG8_STAGE(PG8_SA(1, 1), a1 + hstep, voffA);
            PG8_WAIT_V(8); PG8_WAIT_L(0); PG8_BAR; PG8_MMA(0, 0, At, B0); PG8_MMA(0, 1, At, B1); PG8_BAR; PG8_SCHED;
            PG8_LDA(At, 0, 1); PG8_STAGE(PG8_SB(0, 0), b2, voffB); PG8_STAGE(PG8_SB(0, 1), b2 + hstep, voffB); PG8_STAGE(PG8_SA(0, 0), a2, voffA);
            PG8_WAIT_V(8); PG8_WAIT_L(0); PG8_BAR; PG8_MMA(1, 0, At, B0); PG8_MMA(1, 1, At, B1); PG8_BAR; PG8_SCHED;
            PG8_LDB(B0, 1, 0); PG8_LDB(B1, 1, 1); PG8_SCHED; PG8_LDA(At, 1, 0); PG8_STAGE(PG8_SA(0, 1), a2 + hstep, voffA);
            PG8_WAIT_V(8); PG8_WAIT_L(0); PG8_BAR; PG8_MMA(0, 0, At, B0); PG8_MMA(0, 1, At, B1); PG8_BAR; PG8_SCHED;
            PG8_LDA(At, 1, 1); PG8_STAGE(PG8_SB(1, 0), b3, voffB); PG8_STAGE(PG8_SB(1, 1), b3 + hstep, voffB); PG8_STAGE(PG8_SA(1, 0), a3, voffA);
            PG8_WAIT_V(8); PG8_WAIT_L(0); PG8_BAR; PG8_MMA(1, 0, At, B0); PG8_MMA(1, 1, At, B1); PG8_BAR; PG8_SCHED;
            } else {
            PG8_LDB(B0, 0, 0); PG8_SCHED; PG8_LDA(At, 0, 0); PG8_STAGE(PG8_SA(1, 1), a1 + hstep, voffA);
            PG8_WAIT_L(8); PG8_BAR; PG8_WAIT_L(0); PG8_MMA(0, 0, At, B0); PG8_BAR; PG8_SCHED;
            PG8_LDB(B1, 0, 1); PG8_STAGE(PG8_SB(0, 0), b2, voffB);
            PG8_BAR; PG8_WAIT_L(0); PG8_MMA(0, 1, At, B1); PG8_BAR;
            PG8_LDA(At, 0, 1); PG8_STAGE(PG8_SA(0, 0), a2, voffA);
            PG8_BAR; PG8_WAIT_L(0); PG8_MMA(1, 0, At, B0); PG8_BAR; PG8_SCHED;
            PG8_STAGE(PG8_SB(0, 1), b2 + hstep, voffB);
            PG8_WAIT_V(6); PG8_BAR; PG8_MMA(1, 1, At, B1); PG8_BAR;
            PG8_LDB(B0, 1, 0); PG8_SCHED; PG8_LDA(At, 1, 0); PG8_STAGE(PG8_SA(0, 1), a2 + hstep, voffA);
            PG8_WAIT_L(8); PG8_BAR; PG8_WAIT_L(0); PG8_MMA(0, 0, At, B0); PG8_BAR; PG8_SCHED;
            PG8_LDB(B1, 1, 1); PG8_STAGE(PG8_SB(1, 0), b3, voffB);
            PG8_BAR; PG8_WAIT_L(0); PG8_MMA(0, 1, At, B1); PG8_BAR;
            PG8_LDA(At, 1, 1); PG8_STAGE(PG8_SA(1, 0), a3, voffA);
            PG8_BAR; PG8_WAIT_L(0); PG8_MMA(1, 0, At, B0); PG8_BAR; PG8_SCHED;
            PG8_STAGE(PG8_SB(1, 1), b3 + hstep, voffB);
            PG8_WAIT_V(6); PG8_BAR; PG8_MMA(1, 1, At, B1); PG8_BAR;
            }
        }
        if constexpr (ALIGN_EPI) { if (wr == 0) PG8_BAR; }
        if constexpr (!Epi::AFTER_DRAIN) { E(acc, cur, wr, wc, fr, fq); S.done(cur); }
        if (!has_next) break;
#pragma unroll
        for (int a = 0; a < 2; ++a)
#pragma unroll
            for (int b = 0; b < 2; ++b)
#pragma unroll
                for (int m = 0; m < 4; ++m)
#pragma unroll
                    for (int n = 0; n < 2; ++n) acc[a][b][m][n] = (f32x4){0.f, 0.f, 0.f, 0.f};
        cur = nxt; cA = nA; cB = nB; ++ui;
        if constexpr (ALIGN_EPI) { if (wr == 1) PG8_BAR; }
    }
    PG8_WAIT_V(0);
    if constexpr (!ALIGN_EPI) { if (wr == 0) PG8_BAR; }
    PG8_BAR;
    if constexpr (Epi::AFTER_DRAIN) { E.fused(acc, cur, wr, wc, fr, fq, lds, wid, lane); S.done(cur); }
#undef PG8_SA
#undef PG8_SB
#undef PG8_STAGE
#undef PG8_LDA
#undef PG8_LDB
#undef PG8_MMA
#undef PG8_WAIT_V
#undef PG8_WAIT_L
#undef PG8_BAR
#undef PG8_SCHED
}
}

constexpr int D = 1024, NB = 8, TL = 4096, NCTX = 256, MLAT = NB * TL, MCTX = NB * NCTX, MT = MLAT + MCTX;
constexpr int DFF = 2816, NAB = 2560, NML = 3104, NMLP = 3328, LDQ0 = 2560, LDQ1 = 3072;
constexpr int NTHR = 512, NWAVES = 8;
constexpr float EPS = 1e-6f;
constexpr size_t MiB = 1u << 20;
constexpr size_t WS_MOD = 0;
constexpr size_t WS_W_ABIN = 1 * MiB, WS_W_ABOUT = 6 * MiB, WS_W_GU0 = 8 * MiB, WS_W_GU1 = 19 * MiB, WS_W_DN0 = 30 * MiB, WS_W_DN1 = 36 * MiB, WS_W_MLIN = 42 * MiB, WS_W_MLOUT = 49 * MiB;
constexpr size_t WS_BUFA = 52 * MiB;
constexpr size_t WS_XS = 120 * MiB;
constexpr size_t WS_QKV = 256 * MiB;
constexpr size_t WS_GATES = 460 * MiB;
constexpr size_t WS_CTXQK = 466 * MiB;
constexpr size_t WS_NPREV = 471 * MiB;
constexpr size_t WS_MPREV = 473 * MiB;
constexpr size_t WS_RSS = 474 * MiB;
constexpr size_t WS_SHW = 475 * MiB;
constexpr size_t WS_GM = 476 * MiB;
constexpr size_t WS_END = 477 * MiB;
constexpr size_t WS_BAR = 512 * 1024;
constexpr size_t WS_BAR_BYTES = 16384;
constexpr int LDS_BYTES = 147456;
constexpr int LDS_XB_OFF = 131072 + 256;

#define LAS __attribute__((address_space(3)))
typedef unsigned short bf16;
typedef short bf16x8 __attribute__((ext_vector_type(8)));
typedef short s16x4 __attribute__((ext_vector_type(4)));
typedef float f32x4 __attribute__((ext_vector_type(4)));
typedef unsigned u32x4 __attribute__((ext_vector_type(4)));
typedef unsigned u32x2 __attribute__((ext_vector_type(2)));

__device__ __forceinline__ float bf2f(unsigned h) { return __builtin_bit_cast(float, h << 16); }
__device__ __forceinline__ float bflo(unsigned w) { return __builtin_bit_cast(float, w << 16); }
__device__ __forceinline__ float bfhi(unsigned w) { return __builtin_bit_cast(float, w & 0xffff0000u); }
__device__ __forceinline__ unsigned f2bf(float f) { unsigned u = __builtin_bit_cast(unsigned, f); return (u + 0x7fffu + ((u >> 16) & 1u)) >> 16; }
typedef float f32x2_t __attribute__((ext_vector_type(2))); typedef __bf16 bf16x2_t __attribute__((ext_vector_type(2)));
__device__ __forceinline__ unsigned pk2(float lo, float hi) { const f32x2_t v = {lo, hi}; const bf16x2_t b = __builtin_convertvector(v, bf16x2_t); return __builtin_bit_cast(unsigned, b); }
__device__ __forceinline__ float wave_sum(float v) {
#pragma unroll
    for (int o = 1; o < 64; o <<= 1) v += __shfl_xor(v, o);
    return v;
}
__device__ __forceinline__ float wave_max(float v) {
#pragma unroll
    for (int o = 1; o < 64; o <<= 1) v = fmaxf(v, __shfl_xor(v, o));
    return v;
}
__device__ __forceinline__ float fast_sig(float x) { return __builtin_amdgcn_rcpf(1.0f + __expf(-x)); }
__device__ __forceinline__ float silu_f(float x) { return x * __builtin_amdgcn_rcpf(1.0f + __expf(-x)); }
__device__ __forceinline__ void unpack8(const u32x4 w, float (&f)[8]) { f[0] = bflo(w.x); f[1] = bfhi(w.x); f[2] = bflo(w.y); f[3] = bfhi(w.y); f[4] = bflo(w.z); f[5] = bfhi(w.z); f[6] = bflo(w.w); f[7] = bfhi(w.w); }
__device__ __forceinline__ u32x4 pack8f(const float (&f)[8]) { u32x4 w; w.x = pk2(f[0], f[1]); w.y = pk2(f[2], f[3]); w.z = pk2(f[4], f[5]); w.w = pk2(f[6], f[7]); return w; }
typedef short v4i16_t __attribute__((ext_vector_type(4)));
__device__ __forceinline__ s16x4 trread(const LAS char* p) { return __builtin_bit_cast(s16x4, __builtin_amdgcn_ds_read_tr16_b64_v4i16((LAS v4i16_t*)p)); }
__device__ __forceinline__ bf16x8 cat44(const s16x4 a, const s16x4 b) { bf16x8 r; r[0] = a[0]; r[1] = a[1]; r[2] = a[2]; r[3] = a[3]; r[4] = b[0]; r[5] = b[1]; r[6] = b[2]; r[7] = b[3]; return r; }
#define MFMA16(a, b, c) __builtin_amdgcn_mfma_f32_16x16x32_bf16((a), (b), (c), 0, 0, 0)

struct Params {
    const float* in[26]; float* out; unsigned char* ws; int ph_lo, ph_hi; int rep, pad;
};

__device__ __forceinline__ void transpose_matrix(const float* W, int K, int N, bf16* WT, int kind, LAS float* scr, int gw, int NGW, int lane, int& start) {
    const int nblk = N / 32, items = nblk * (K / 64);
    int first = gw - start; if (first < 0) first += NGW;
    for (int it = first; it < items; it += NGW) {
        const int kb = it / nblk, nb = it % nblk, k0 = 64 * kb, n0 = 32 * nb;
        { const int kr = lane >> 3, nc = lane & 7; f32x4 v[8];
#pragma unroll
          for (int i = 0; i < 8; ++i) v[i] = *(const f32x4*)(W + (size_t)(k0 + 8 * i + kr) * N + n0 + 4 * nc);
#pragma unroll
          for (int i = 0; i < 8; ++i) { LAS float* sp = scr + (8 * i + kr) * 33 + 4 * nc; sp[0] = v[i][0]; sp[1] = v[i][1]; sp[2] = v[i][2]; sp[3] = v[i][3]; } }
        asm volatile("s_waitcnt lgkmcnt(0)" ::: "memory");
        const int drow0 = kind == 0 ? n0 : ((n0 >> 7) * 256 + (kind == 2 ? 128 : 0) + (n0 & 127));
        const int c = lane & 7;
#pragma unroll
        for (int j = 0; j < 4; ++j) { const int n = (lane >> 3) + 8 * j; const LAS float* s = scr + (8 * c) * 33 + n;
            u32x4 o; o.x = pk2(s[0 * 33], s[1 * 33]); o.y = pk2(s[2 * 33], s[3 * 33]); o.z = pk2(s[4 * 33], s[5 * 33]); o.w = pk2(s[6 * 33], s[7 * 33]);
            *(u32x4*)(WT + (size_t)(drow0 + n) * K + k0 + 8 * c) = o; }
        asm volatile("s_waitcnt lgkmcnt(0)" ::: "memory");
    }
    start = (start + items) % NGW;
}

__device__ __forceinline__ void phase_prologue(const Params& p, LAS unsigned char* lds, int tid, int lane, int wave) {
    unsigned char* ws = p.ws;
    const int gw = blockIdx.x * NWAVES + wave, NGW = gridDim.x * NWAVES;
    LAS float* scr = (LAS float*)(lds + wave * 8704);
    int start = 0;
    transpose_matrix(p.in[11], D, NAB, (bf16*)(ws + WS_W_ABIN), 0, scr, gw, NGW, lane, start);
    __syncthreads();
    LAS float* sv = (LAS float*)lds;
    LAS float* part = (LAS float*)(lds + 40960);
    for (int i = tid; i < 9 * 1024; i += NTHR) { const float c = i < 8192 ? p.in[1][i] : p.in[3][i - 8192]; sv[i] = silu_f(c); }
    __syncthreads();
    float* mod = (float*)(ws + WS_MOD);
    for (int item = blockIdx.x; item < 192; item += gridDim.x) {
        const int l = item / 96, cgp = item % 96, col = cgp * 64 + lane;
        const float* W = p.in[4] + (size_t)l * D * 6144 + col;
        float a[9];
#pragma unroll
        for (int b = 0; b < 9; ++b) a[b] = 0.f;
#pragma unroll 16
        for (int k = wave * 128; k < wave * 128 + 128; ++k) { const float wv = W[(size_t)k * 6144];
#pragma unroll
            for (int b = 0; b < 9; ++b) a[b] += sv[b * 1024 + k] * wv; }
#pragma unroll
        for (int b = 0; b < 9; ++b) part[(wave * 9 + b) * 64 + lane] = a[b];
        __syncthreads();
        for (int i = tid; i < 576; i += NTHR) { const int b = i >> 6, ln = i & 63; float s = 0.f;
#pragma unroll
            for (int w = 0; w < 8; ++w) s += part[(w * 9 + b) * 64 + ln];
            mod[(size_t)(l * 9 + b) * 6144 + cgp * 64 + ln] = s + p.in[5][l * 6144 + cgp * 64 + ln]; }
        __syncthreads();
    }
}


__device__ __forceinline__ void phase_aux(const Params& p, LAS unsigned char* lds, int tid, int lane, int wave) {
    unsigned char* ws = p.ws; const float* mod = (const float*)(ws + WS_MOD);
    const int gt = blockIdx.x * NTHR + tid, NGT = gridDim.x * NTHR;
    const int gw = blockIdx.x * NWAVES + wave, NGW = gridDim.x * NWAVES;
    float* rss = (float*)(ws + WS_RSS); for (int i = gt; i < 3 * MT; i += NGT) rss[i] = 0.f;
    float* gm = (float*)(ws + WS_GM);
    for (int i = gt; i < 3 * 9 * 1024; i += NGT) { const int s = i / 9216, r = i % 9216, bb = r >> 10, k = r & 1023;
        const float* ng = s == 1 ? p.in[6] + D : (s == 0 ? p.in[7] : p.in[7] + D); const int l = s == 0 ? 0 : 1; const int sc_off = s == 1 ? 1024 : 4096;
        gm[i] = ng[k] * (1.0f + mod[(size_t)(l * 9 + bb) * 6144 + sc_off + k]); }
    __syncthreads();
}
__device__ __forceinline__ void shw_compute(const Params& p, int s, int rank, int nblk, LAS unsigned char* lds, int tid, int lane, int wave) {
    unsigned char* ws = p.ws; const float* mod = (const float*)(ws + WS_MOD);
    const int gw = rank * NWAVES + wave, NGW = nblk * NWAVES;
    LAS float* shl = (LAS float*)lds;
    float* shw = (float*)(ws + WS_SHW);
    const int l = s == 0 ? 0 : 1, sh_off = s == 1 ? 0 : 3072, N = s == 1 ? NMLP : 2 * DFF;
    const bf16* Wt = (const bf16*)(ws + (s == 0 ? WS_W_GU0 : (s == 1 ? WS_W_MLIN : WS_W_GU1)));
    float* dst = shw + (s == 0 ? 0 : (s == 1 ? 9 * 5632 : 9 * 5632 + 9 * 3328));
    __syncthreads();
    for (int i = tid; i < 9 * 1024; i += NTHR) shl[i] = mod[(size_t)(l * 9 + (i >> 10)) * 6144 + sh_off + (i & 1023)];
    __syncthreads();
    for (int n = gw; n < N; n += NGW) {
        float w[16]; { const u32x4* wp = (const u32x4*)(Wt + (size_t)n * D + lane * 16); float t8[8]; unpack8(wp[0], t8);
#pragma unroll
            for (int e = 0; e < 8; ++e) w[e] = t8[e];
            unpack8(wp[1], t8);
#pragma unroll
            for (int e = 0; e < 8; ++e) w[8 + e] = t8[e]; }
        float res = 0.f;
#pragma unroll
        for (int bb = 0; bb < 9; ++bb) { float a = 0.f; const LAS f32x4* sp = (const LAS f32x4*)(shl + bb * 1024 + lane * 16);
#pragma unroll
            for (int j = 0; j < 4; ++j) { const f32x4 sv = sp[j]; a += (w[4 * j] * sv[0] + w[4 * j + 1] * sv[1]) + (w[4 * j + 2] * sv[2] + w[4 * j + 3] * sv[3]); }
            a = wave_sum(a); if (lane == bb) res = a; }
        if (lane < 9) dst[(size_t)lane * N + n] = res;
    }
    __syncthreads();
}
__device__ __forceinline__ void side_weights(const Params& p, int set, int rank, int nblk, LAS unsigned char* lds, int tid, int lane, int wave) {
    unsigned char* ws = p.ws;
    const int gw = rank * NWAVES + wave, NGW = nblk * NWAVES;
    LAS float* scr = (LAS float*)(lds + wave * 8704);
    int start = 0;
    if (set == 0) {
        transpose_matrix(p.in[19], D, D, (bf16*)(ws + WS_W_ABOUT), 0, scr, gw, NGW, lane, start);
        transpose_matrix(p.in[8], D, DFF, (bf16*)(ws + WS_W_GU0), 1, scr, gw, NGW, lane, start);
        transpose_matrix(p.in[9], D, DFF, (bf16*)(ws + WS_W_GU0), 2, scr, gw, NGW, lane, start);
    } else if (set == 1) {
        transpose_matrix(p.in[10], DFF, D, (bf16*)(ws + WS_W_DN0), 0, scr, gw, NGW, lane, start);
        transpose_matrix(p.in[20], D, NML, (bf16*)(ws + WS_W_MLIN), 0, scr, gw, NGW, lane, start);
        u32x4* z = (u32x4*)(ws + WS_W_MLIN + (size_t)NML * D * 2); const int n16 = (NMLP - NML) * D * 2 / 16;
        for (int i = rank * NTHR + tid; i < n16; i += nblk * NTHR) z[i] = (u32x4){0u, 0u, 0u, 0u};
    } else {
        transpose_matrix(p.in[25], D, D, (bf16*)(ws + WS_W_MLOUT), 0, scr, gw, NGW, lane, start);
        transpose_matrix(p.in[8] + (size_t)D * DFF, D, DFF, (bf16*)(ws + WS_W_GU1), 1, scr, gw, NGW, lane, start);
        transpose_matrix(p.in[9] + (size_t)D * DFF, D, DFF, (bf16*)(ws + WS_W_GU1), 2, scr, gw, NGW, lane, start);
        transpose_matrix(p.in[10] + (size_t)DFF * D, DFF, D, (bf16*)(ws + WS_W_DN1), 0, scr, gw, NGW, lane, start);
    }
    __syncthreads();
}

__device__ __forceinline__ void phase_norm(const float* __restrict__ src_lat, const float* __restrict__ src_ctx, const float* __restrict__ g, const float* __restrict__ modl, int sh_off, int sc_off, int Mrows, bf16* __restrict__ H, int lane, int wave) {
    const int gw = blockIdx.x * NWAVES + wave, NGW = gridDim.x * NWAVES;
    f32x4 gv[4];
#pragma unroll
    for (int j = 0; j < 4; ++j) gv[j] = ((const f32x4*)g)[lane + 64 * j];
#pragma unroll 2
    for (int row = gw; row < Mrows; row += NGW) {
        const float* src = row < MLAT ? src_lat : src_ctx; const int bb = row < MLAT ? (row >> 12) : 8;
        const f32x4* xr = (const f32x4*)(src + (size_t)row * D) + lane;
        f32x4 v[4]; float ss = 0.f;
#pragma unroll
        for (int j = 0; j < 4; ++j) { v[j] = xr[64 * j]; ss += (v[j].x * v[j].x + v[j].y * v[j].y) + (v[j].z * v[j].z + v[j].w * v[j].w); }
        const float rstd = rsqrtf(wave_sum(ss) * (1.f / D) + EPS);
        const f32x4* sc = (const f32x4*)(modl + (size_t)bb * 6144 + sc_off) + lane; const f32x4* sh = (const f32x4*)(modl + (size_t)bb * 6144 + sh_off) + lane;
        u32x2* o = (u32x2*)(H + (size_t)row * D) + lane;
#pragma unroll
        for (int j = 0; j < 4; ++j) { const f32x4 y = v[j] * rstd * gv[j] * (sc[64 * j] + 1.0f) + sh[64 * j]; u32x2 w; w.x = pk2(y.x, y.y); w.y = pk2(y.z, y.w); o[64 * j] = w; }
    }
}

__device__ __forceinline__ void phase_qknorm(bf16* QKV, const float* qg, const float* kg, int lane, int wave) {
    const int gw = blockIdx.x * NWAVES + wave, NGW = gridDim.x * NWAVES;
    float gq[8], gk[8];
#pragma unroll
    for (int e = 0; e < 8; ++e) { gq[e] = qg[(lane & 7) * 8 + e] * 0.125f; gk[e] = kg[(lane & 7) * 8 + e]; }
    for (int item = gw; item < MT * 2; item += NGW) {
        const int row = item >> 1, half = item & 1;
        u32x4* ptr = (u32x4*)(QKV + (size_t)row * LDQ0 + half * 512) + lane;
        float f[8]; unpack8(*ptr, f);
        float ss = 0.f;
#pragma unroll
        for (int e = 0; e < 8; ++e) ss += f[e] * f[e];
        ss += __shfl_xor(ss, 1); ss += __shfl_xor(ss, 2); ss += __shfl_xor(ss, 4);
        const float rstd = rsqrtf(ss * (1.f / 64.f) + EPS);
#pragma unroll
        for (int e = 0; e < 8; ++e) f[e] = f[e] * rstd * (half ? gk[e] : gq[e]);
        *ptr = pack8f(f);
    }
}

__device__ __forceinline__ void phase_conv(const bf16* QKV, const float* cw, const float* cb, const float* lng, const float* lnb, bf16* ATT, LAS unsigned char* lds, int tid, int lane, int wave) {
    LAS unsigned short* glu = (LAS unsigned short*)lds;
    LAS float* ybuf = (LAS float*)(lds + 65536);
    float w[31];
#pragma unroll
    for (int i = 0; i < 31; ++i) w[i] = cw[i * 512 + tid];
    const float bias = cb[tid];
    float lg[8], lb[8];
#pragma unroll
    for (int e = 0; e < 8; ++e) { lg[e] = lng[lane * 8 + e]; lb[e] = lnb[lane * 8 + e]; }
    u32x4 ru[8], rgt[8];
#define CONV_LOAD(it_) do { int sb_, sl_, t0_; if ((it_) < 1024) { sb_ = ((it_) >> 7) * TL; sl_ = TL; t0_ = ((it_) & 127) * 32; } else { const int j_ = (it_) - 1024; sb_ = MLAT + (j_ >> 3) * NCTX; sl_ = NCTX; t0_ = (j_ & 7) * 32; } \
        _Pragma("unroll") for (int ps_ = 0; ps_ < 8; ++ps_) { const int i_ = ps_ * 8 + (tid >> 6); const int t_ = t0_ - 15 + i_; ru[ps_] = (u32x4){0u, 0u, 0u, 0u}; rgt[ps_] = ru[ps_]; \
            if (i_ < 62 && t_ >= 0 && t_ < sl_) { const bf16* rp_ = QKV + (size_t)(sb_ + t_) * LDQ0 + 1536 + lane * 8; ru[ps_] = *(const u32x4*)rp_; rgt[ps_] = *(const u32x4*)(rp_ + 512); } } } while (0)
    if ((int)blockIdx.x < 1088) CONV_LOAD((int)blockIdx.x);
    for (int it = blockIdx.x; it < 1088; it += gridDim.x) {
        int seq_base, t0;
        if (it < 1024) { seq_base = (it >> 7) * TL; t0 = (it & 127) * 32; } else { const int j = it - 1024; seq_base = MLAT + (j >> 3) * NCTX; t0 = (j & 7) * 32; }
#pragma unroll
        for (int ps = 0; ps < 8; ++ps) { const int i = ps * 8 + (tid >> 6);
            if (i < 62) { float u[8], gt[8]; unpack8(ru[ps], u); unpack8(rgt[ps], gt);
#pragma unroll
                for (int e = 0; e < 8; ++e) u[e] = u[e] * __builtin_amdgcn_rcpf(1.0f + __expf(-gt[e]));
                *(LAS u32x4*)(glu + i * 512 + lane * 8) = pack8f(u); } }
        if (it + (int)gridDim.x < 1088) CONV_LOAD(it + (int)gridDim.x);
        __syncthreads();
        for (int tg = 0; tg < 4; ++tg) {
            float v[38];
#pragma unroll
            for (int j = 0; j < 38; ++j) v[j] = bf2f(glu[(tg * 8 + j) * 512 + tid]);
#pragma unroll
            for (int t = 0; t < 8; ++t) { float a = bias;
#pragma unroll
                for (int k = 0; k < 31; ++k) a += v[t + k] * w[k];
                ybuf[(tg * 8 + t) * 512 + tid] = a; }
        }
        __syncthreads();
#pragma unroll
        for (int q = 0; q < 4; ++q) { const int t = wave * 4 + q; const LAS f32x4* yp = (const LAS f32x4*)(ybuf + t * 512 + lane * 8);
            const f32x4 a = yp[0], b = yp[1]; float f[8] = {a.x, a.y, a.z, a.w, b.x, b.y, b.z, b.w};
            float s = 0.f;
#pragma unroll
            for (int e = 0; e < 8; ++e) s += f[e];
            const float mu = wave_sum(s) * (1.f / 512.f); float s2 = 0.f;
#pragma unroll
            for (int e = 0; e < 8; ++e) { f[e] -= mu; s2 += f[e] * f[e]; }
            const float rstd = rsqrtf(wave_sum(s2) * (1.f / 512.f) + EPS);
#pragma unroll
            for (int e = 0; e < 8; ++e) f[e] = silu_f(f[e] * rstd * lg[e] + lb[e]);
            *(u32x4*)(ATT + (size_t)(seq_base + t0 + t) * D + 512 + lane * 8) = pack8f(f); }
    }
    __syncthreads();
}

constexpr int AVS = 144;
template <int NQR>
__device__ __forceinline__ void attn_wave(const bf16* QKV, int tq0, int h, int krlo, int nkr, int tkloc0, int tkctx0, const LAS float* rpbh, int rbase, int qc0, int kc0, bf16* ATT, LAS char* vl, int lane, const LAS float* gqk) {
    const int fr = lane & 15, g = lane >> 4, q4 = (lane & 15) >> 2, p4 = lane & 3;
    bf16x8 qf[NQR][2]; f32x4 oacc[NQR][4]; float lrun[NQR]; int r0q[NQR];
    const float sref = __builtin_bit_cast(float, __builtin_amdgcn_readfirstlane(__builtin_bit_cast(int, gqk[64])));
#pragma unroll
    for (int qr = 0; qr < NQR; ++qr) {
        const bf16* qp = QKV + (size_t)(tq0 + 64 * qr + fr) * LDQ0 + h * 64 + 8 * g;
        { float a8[8], b8[8]; unpack8(*(const u32x4*)qp, a8); unpack8(*(const u32x4*)(qp + 32), b8); float ss = 0.f;
#pragma unroll
          for (int e = 0; e < 8; ++e) ss += a8[e] * a8[e] + b8[e] * b8[e];
          ss += __shfl_xor(ss, 16); ss += __shfl_xor(ss, 32); const float rq = rsqrtf(ss * (1.f / 64.f) + EPS);
#pragma unroll
          for (int e = 0; e < 8; ++e) { a8[e] *= rq * gqk[8 * g + e]; b8[e] *= rq * gqk[32 + 8 * g + e]; }
          qf[qr][0] = __builtin_bit_cast(bf16x8, pack8f(a8)); qf[qr][1] = __builtin_bit_cast(bf16x8, pack8f(b8)); }
#pragma unroll
        for (int c = 0; c < 4; ++c) oacc[qr][c] = (f32x4){0.f, 0.f, 0.f, 0.f};
        lrun[qr] = 0.f; r0q[qr] = min(max(rbase + qr - 4, 0), 56);
    }
    const int ns = nkr + 8;
    const int qcol = qc0 + fr; const int lo = min(max(qcol - 8, 0), 48);
    bf16x8 kf[4]; u32x4 vv[4];
    {
        const int tk0 = nkr > 0 ? tkloc0 : tkctx0;
        const bf16* kp = QKV + (size_t)(tk0 + fr) * LDQ0 + 512 + h * 64 + 8 * g;
        kf[0] = *(const bf16x8*)kp; kf[1] = *(const bf16x8*)(kp + 32); kf[2] = *(const bf16x8*)(kp + 16 * LDQ0); kf[3] = *(const bf16x8*)(kp + 16 * LDQ0 + 32);
#pragma unroll
        for (int i = 0; i < 4; ++i) { const int c = lane + 64 * i; vv[i] = *(const u32x4*)(QKV + (size_t)(tk0 + (c >> 3)) * LDQ0 + 1024 + h * 64 + (c & 7) * 8); }
    }
    for (int s = 0; s < ns; ++s) {
        bf16x8 kn[4]; u32x4 vn[4];
        if (s + 1 < ns) {
            const int tk0 = (s + 1) < nkr ? tkloc0 + (s + 1) * 64 : tkctx0 + (s + 1 - nkr) * 32;
            const bf16* kp = QKV + (size_t)(tk0 + fr) * LDQ0 + 512 + h * 64 + 8 * g;
            kn[0] = *(const bf16x8*)kp; kn[1] = *(const bf16x8*)(kp + 32); kn[2] = *(const bf16x8*)(kp + 16 * LDQ0); kn[3] = *(const bf16x8*)(kp + 16 * LDQ0 + 32);
#pragma unroll
            for (int i = 0; i < 4; ++i) { const int c = lane + 64 * i; vn[i] = *(const u32x4*)(QKV + (size_t)(tk0 + (c >> 3)) * LDQ0 + 1024 + h * 64 + (c & 7) * 8); }
        } else {
#pragma unroll
            for (int i = 0; i < 4; ++i) { kn[i] = kf[i]; vn[i] = vv[i]; }
        }
#pragma unroll
        for (int i = 0; i < 4; ++i) { const int c = lane + 64 * i; *(LAS u32x4*)(vl + (c >> 3) * AVS + (c & 7) * 16) = vv[i]; }
        asm volatile("s_waitcnt lgkmcnt(0)" ::: "memory");
        bf16x8 vfr[4];
#pragma unroll
        for (int c = 0; c < 4; ++c) vfr[c] = cat44(trread(vl + (4 * g + q4) * AVS + (16 * c + 4 * p4) * 2), trread(vl + (16 + 4 * g + q4) * AVS + (16 * c + 4 * p4) * 2));
        asm volatile("s_waitcnt lgkmcnt(0)" ::: "memory");
        const bool local = s < nkr; const int kr = krlo + s;
#pragma unroll
        for (int jb = 0; jb < 2; ++jb) { float a8[8], b8[8]; unpack8(__builtin_bit_cast(u32x4, kf[2 * jb]), a8); unpack8(__builtin_bit_cast(u32x4, kf[2 * jb + 1]), b8); float ss = 0.f;
#pragma unroll
            for (int e = 0; e < 8; ++e) ss += a8[e] * a8[e] + b8[e] * b8[e];
            ss += __shfl_xor(ss, 16); ss += __shfl_xor(ss, 32); const float rk = rsqrtf(ss * (1.f / 64.f) + EPS);
#pragma unroll
            for (int e = 0; e < 8; ++e) { a8[e] *= rk; b8[e] *= rk; }
            kf[2 * jb] = __builtin_bit_cast(bf16x8, pack8f(a8)); kf[2 * jb + 1] = __builtin_bit_cast(bf16x8, pack8f(b8)); }
#pragma unroll
        for (int qr = 0; qr < NQR; ++qr) {
            if (!local || (kr >= r0q[qr] && kr < r0q[qr] + 8)) {
                f32x4 st[2];
#pragma unroll
                for (int jb = 0; jb < 2; ++jb) { st[jb] = MFMA16(kf[2 * jb], qf[qr][0], ((f32x4){0.f, 0.f, 0.f, 0.f})); st[jb] = MFMA16(kf[2 * jb + 1], qf[qr][1], st[jb]); }
                float ps = 0.f; float pv[8];
                if (local) {
                    const LAS float* rrow = rpbh + (kr - (rbase + qr) + 7) * 31;
#pragma unroll
                    for (int jb = 0; jb < 2; ++jb)
#pragma unroll
                        for (int e = 0; e < 4; ++e) { const int kcol = kc0 + 16 * jb + 4 * g + e; const bool valid = (kcol >= lo) && (kcol < lo + 16);
                            const int rel = min(max(kcol - qcol + 15, 0), 30); const float bv = valid ? rrow[rel] : -1e30f;
                            const float pe = __builtin_amdgcn_exp2f(st[jb][e] + bv); pv[jb * 4 + e] = pe; ps += pe; }
                } else {
#pragma unroll
                    for (int jb = 0; jb < 2; ++jb)
#pragma unroll
                        for (int e = 0; e < 4; ++e) { const float pe = __builtin_amdgcn_exp2f(st[jb][e] - sref); pv[jb * 4 + e] = pe; ps += pe; }
                }
                lrun[qr] += ps;
                const bf16x8 pf = __builtin_bit_cast(bf16x8, pack8f(pv));
#pragma unroll
                for (int c = 0; c < 4; ++c) oacc[qr][c] = MFMA16(vfr[c], pf, oacc[qr][c]);
            }
        }
#pragma unroll
        for (int i = 0; i < 4; ++i) { kf[i] = kn[i]; vv[i] = vn[i]; }
    }
#pragma unroll
    for (int qr = 0; qr < NQR; ++qr) {
        float lt = lrun[qr]; lt += __shfl_xor(lt, 16); lt += __shfl_xor(lt, 32);
        const float inv = 1.0f / lt;
        bf16* op = ATT + (size_t)(tq0 + 64 * qr + fr) * D + h * 64 + 4 * g;
#pragma unroll
        for (int c = 0; c < 4; ++c) { u32x2 w; w.x = pk2(oacc[qr][c][0] * inv, oacc[qr][c][1] * inv); w.y = pk2(oacc[qr][c][2] * inv, oacc[qr][c][3] * inv); *(u32x2*)(op + 16 * c) = w; }
    }
}

__device__ __forceinline__ void phase_attn(const bf16* QKV, const float* rpb, const float* qg, const float* kg, bf16* ATT, LAS unsigned char* lds, int lane, int wave) {
    const int gw = blockIdx.x * NWAVES + wave, NGW = gridDim.x * NWAVES;
    LAS char* vl = (LAS char*)lds + wave * 4608;
    LAS float* rpbl = (LAS float*)(lds + 40960);
    LAS float* gqk = (LAS float*)(lds + 57344);
    if (threadIdx.x < 64) { const float gv = qg[threadIdx.x] * kg[threadIdx.x] * (0.125f * 1.44269504f); gqk[threadIdx.x] = gv;
        const float bnd = 64.0f * wave_max(fabsf(gv)); if (threadIdx.x == 0) gqk[64] = bnd; }
    __syncthreads();
    { const float bnd = gqk[64]; for (int i = threadIdx.x; i < 8 * 15 * 31; i += NTHR) rpbl[i] = rpb[i] * 1.44269504f - bnd; }
    __syncthreads();
    for (int item = gw; item < 4096; item += NGW) {
        const int cgp = item & 3, h = (item >> 2) & 7, rg = (item >> 5) & 15, b = item >> 9;
        const int rbase = 4 * rg; const int krlo = min(max(rbase - 4, 0), 56); const int krhi = min(max(rbase + 3 - 4, 0), 56) + 8;
        const int kc0 = cgp == 0 ? 0 : (cgp == 1 ? 8 : (cgp == 2 ? 24 : 32));
        attn_wave<4>(QKV, b * TL + rbase * 64 + 16 * cgp, h, krlo, krhi - krlo, b * TL + krlo * 64 + kc0, MLAT + b * NCTX, rpbl + h * 15 * 31, rbase, 16 * cgp, kc0, ATT, vl, lane, gqk);
    }
    for (int item = (gw + NGW / 2) % NGW; item < 1024; item += NGW) {
        const int qg = item & 15, h = (item >> 4) & 7, b = item >> 7;
        attn_wave<1>(QKV, MLAT + b * NCTX + 16 * qg, h, 0, 0, 0, MLAT + b * NCTX, rpbl, 0, 0, 0, ATT, vl, lane, gqk);
    }
}

__device__ __forceinline__ void phase_mlprep(const bf16* __restrict__ QKVO, const float* __restrict__ cw, const float* __restrict__ cb, bf16* __restrict__ QKP, bf16* __restrict__ CTXQK, int lane, int wave) {
    const int gw = blockIdx.x * NWAVES + wave, NGW = gridDim.x * NWAVES;
    for (int half = 0; half < 2; ++half) {
        const int cbase = half * 512 + lane * 8;
        float w[5][8], bias[8];
#pragma unroll
        for (int k = 0; k < 5; ++k)
#pragma unroll
            for (int e = 0; e < 8; ++e) w[k][e] = cw[k * 1024 + cbase + e];
#pragma unroll
        for (int e = 0; e < 8; ++e) bias[e] = cb[cbase + e];
        float inv[8];
#pragma unroll
        for (int e = 0; e < 8; ++e) inv[e] = exp2f(-(float)((lane & 1) * 8 + e) * (13.287712379549449f / 16.f));
        const int mrows = half == 0 ? MLAT : MT;
#pragma unroll 2
        for (int row = gw; row < mrows; row += NGW) {
            int t, len; if (row < MLAT) { t = row & (TL - 1); len = TL; } else { t = (row - MLAT) & (NCTX - 1); len = NCTX; }
            float a[8];
#pragma unroll
            for (int e = 0; e < 8; ++e) a[e] = bias[e];
#pragma unroll
            for (int k = 0; k < 5; ++k) { const int tt = t + k - 2;
                if (tt >= 0 && tt < len) { float f[8]; unpack8(*(const u32x4*)(QKVO + (size_t)(row + k - 2) * LDQ1 + cbase), f);
#pragma unroll
                    for (int e = 0; e < 8; ++e) a[e] += f[e] * w[k][e]; } }
            const float qs = half == 0 ? 0.125f : 1.0f;
#pragma unroll
            for (int e = 0; e < 8; ++e) a[e] = silu_f(a[e]) * qs;
            if (row < MLAT) {
                const float pos = (float)((lane & 4) ? (t & 63) : (t >> 6));
#pragma unroll
                for (int e = 0; e < 8; ++e) { const float ang = pos * inv[e]; const float cs = __cosf(ang), sn = __sinf(ang); const float other = __shfl_xor(a[e], 2);
                    a[e] = (lane & 2) ? (other * sn + a[e] * cs) : (a[e] * cs - other * sn); }
                *(u32x4*)(QKP + (size_t)row * D + cbase) = pack8f(a);
            } else {
                *(u32x4*)(CTXQK + (size_t)(row - MLAT) * D + cbase) = pack8f(a);
            }
        }
    }
}

constexpr int SKS = 144;
__device__ __forceinline__ void phase_mlscan(const bf16* QKVO, const bf16* QKP, const bf16* CTXQK, const float* GATES, bf16* SPREV, float* NPREV, float* MPREV, LAS unsigned char* lds, int tid, int lane, int wave) {
    LAS char* tb = (LAS char*)lds;
    LAS float* lnb = (LAS float*)(lds + 73728);
    LAS float* weT = (LAS float*)(lds + 77824);
    LAS float* totT = (LAS float*)(lds + 95232);
    LAS float* mlocT = totT + 64;
    LAS float* mbefT = totT + 128;
    LAS float* mnewT = totT + 192;
    LAS float* decT = totT + 256;
    const int g = lane >> 4, fr = lane & 15, q4 = (lane & 15) >> 2, p4 = lane & 3;
    const int dvb = wave >> 1, dkb0 = 2 * (wave & 1);
    for (int item = blockIdx.x; item < 256; item += gridDim.x) {
        const int vh = item & 1, dir = (item >> 1) & 1, h = (item >> 2) & 7, b = item >> 5;
#define SCAN_ROW0(st) ((st) < 2 ? MLAT + b * NCTX + (dir ? 1 - (st) : (st)) * 128 : b * TL + (dir ? 31 - ((st) - 2) : (st) - 2) * 128)
#pragma unroll 1
        for (int st = wave; st < 34; st += 8) {
            const int r0 = SCAN_ROW0(st);
            const float* gp = GATES + (size_t)(r0 + 2 * lane) * 32 + dir * 8 + h;
            const float ig0 = gp[0], ig1 = gp[32], lf0 = gp[16], lf1 = gp[48];
            float ps = lf0 + lf1;
#pragma unroll
            for (int o = 1; o < 64; o <<= 1) { const float t = __shfl_up(ps, o); if (lane >= o) ps += t; }
            const float total = __shfl(ps, 63); const float cum1 = ps, cum0 = ps - lf1;
            float we0, we1;
            if (dir == 0) { we0 = total - cum0 + ig0; we1 = total - cum1 + ig1; } else { we0 = (cum0 - lf0) + ig0; we1 = (cum1 - lf1) + ig1; }
            const float mloc = wave_max(fmaxf(we0, we1));
            weT[st * 128 + 2 * lane] = we0; weT[st * 128 + 2 * lane + 1] = we1;
            if (lane == 0) { totT[st] = total; mlocT[st] = mloc; }
        }
        __syncthreads();
        if (wave == 0) {
            float m = 0.f;
#pragma unroll 1
            for (int st = 0; st < 34; ++st) { const float total = totT[st], mloc = mlocT[st]; const float mnew = fmaxf(total + m, mloc); const float dec = __expf(total + m - mnew);
                if (lane == 0) { mbefT[st] = m; mnewT[st] = mnew; decT[st] = dec; } m = mnew; }
        }
        __syncthreads();
        u32x4 nk[2], nv[2];
#define SCAN_LOAD(st) do { const bool ic_ = (st) < 2; const int r0_ = SCAN_ROW0(st); \
            _Pragma("unroll") for (int i_ = 0; i_ < 2; ++i_) { const int id_ = tid + 512 * i_; const int l_ = id_ >> 3, c_ = id_ & 7; \
                const bf16* kp_ = ic_ ? CTXQK + (size_t)(r0_ - MLAT + l_) * D + 512 + h * 64 + c_ * 8 : QKP + (size_t)(r0_ + l_) * D + 512 + h * 64 + c_ * 8; \
                nk[i_] = *(const u32x4*)kp_; nv[i_] = *(const u32x4*)(QKVO + (size_t)(r0_ + l_) * LDQ1 + 1024 + h * 128 + vh * 64 + c_ * 8); } } while (0)
#define SCAN_STAGE(st) do { LAS char* lk_ = tb + ((st) & 1) * 36864; LAS char* lv_ = lk_ + 18432; const float mn_ = mnewT[st]; \
            _Pragma("unroll") for (int i_ = 0; i_ < 2; ++i_) { const int id_ = tid + 512 * i_; const int l_ = id_ >> 3, c_ = id_ & 7; \
                float f_[8]; unpack8(nk[i_], f_); const float wl_ = __expf(weT[(st) * 128 + l_] - mn_); \
                _Pragma("unroll") for (int e_ = 0; e_ < 8; ++e_) f_[e_] *= wl_; \
                *(LAS u32x4*)(lk_ + l_ * SKS + c_ * 16) = pack8f(f_); *(LAS u32x4*)(lv_ + l_ * SKS + c_ * 16) = nv[i_]; } } while (0)
        SCAN_LOAD(0); SCAN_STAGE(0); SCAN_LOAD(1);
        __syncthreads();
        f32x4 acc[2]; acc[0] = (f32x4){0.f, 0.f, 0.f, 0.f}; acc[1] = acc[0];
        float nst = 0.f;
#pragma unroll 1
        for (int step = 0; step < 34; ++step) {
            if (step >= 2) {
                const int cc = dir ? 31 - (step - 2) : step - 2;
                const size_t idx = (size_t)((b * 8 + h) * 2 + dir) * 32 + cc;
#pragma unroll
                for (int t = 0; t < 2; ++t) { u32x2 w; w.x = pk2(acc[t][0], acc[t][1]); w.y = pk2(acc[t][2], acc[t][3]);
                    *(u32x2*)(SPREV + (idx * 64 + 16 * (dkb0 + t) + fr) * 128 + vh * 64 + 16 * dvb + 4 * g) = w; }
                if (vh == 0 && tid < 64) NPREV[idx * 64 + tid] = nst;
                if (vh == 0 && tid == 0) MPREV[idx] = mbefT[step];
            }
            if (step + 1 < 34) { SCAN_STAGE(step + 1); if (step + 2 < 34) SCAN_LOAD(step + 2); }
            const LAS char* lk = tb + (step & 1) * 36864; const LAS char* lv = lk + 18432;
            const float decay = decT[step];
            acc[0] = acc[0] * decay; acc[1] = acc[1] * decay;
#pragma unroll
            for (int s4 = 0; s4 < 4; ++s4) {
                const int rb = (32 * s4 + 8 * g + q4) * SKS;
                const bf16x8 af = cat44(trread(lv + rb + (16 * dvb + 4 * p4) * 2), trread(lv + rb + 4 * SKS + (16 * dvb + 4 * p4) * 2));
#pragma unroll
                for (int t = 0; t < 2; ++t) { const bf16x8 bfr = cat44(trread(lk + rb + (16 * (dkb0 + t) + 4 * p4) * 2), trread(lk + rb + 4 * SKS + (16 * (dkb0 + t) + 4 * p4) * 2));
                    acc[t] = MFMA16(af, bfr, acc[t]); }
            }
            { const int dk = tid & 63, part = tid >> 6; float s = 0.f;
#pragma unroll
              for (int l = 0; l < 16; ++l) s += bf2f(*(const LAS unsigned short*)(lk + (part * 16 + l) * SKS + dk * 2));
              lnb[(step & 1) * 512 + part * 64 + dk] = s; }
            __syncthreads();
            if (tid < 64) { float s = 0.f;
#pragma unroll
                for (int pt = 0; pt < 8; ++pt) s += lnb[(step & 1) * 512 + pt * 64 + tid];
                nst = decay * nst + s; }
        }
        __syncthreads();
#undef SCAN_ROW0
#undef SCAN_LOAD
#undef SCAN_STAGE
    }
}

constexpr int OVS = 272;
__device__ __forceinline__ void phase_mlout(const bf16* QKVO, const bf16* QKP, const float* GATES, const bf16* SPREV, const float* NPREV, const float* MPREV, const float* normg, bf16* HN,
                                            LAS unsigned char* lds, int tid, int lane, int wave) {
    LAS char* lk = (LAS char*)lds; LAS char* lv = (LAS char*)lds + 18432; LAS char* ls = (LAS char*)lds + 53248;
    LAS float* arr = (LAS float*)(lds + 88064);
    const int g = lane >> 4, fr = lane & 15, q4 = (lane & 15) >> 2, p4 = lane & 3;
    u32x4 pvv[4], pss[4]; float pg0 = 0.f, pg1 = 0.f, pl0 = 0.f, pl1 = 0.f, pmp = 0.f, pnp = 0.f; bf16x8 pq[2];
#define MLOUT_LOAD(it_) do { const int c_ = (it_) & 31, h_ = ((it_) >> 5) & 7, b_ = (it_) >> 8; const int r0_ = b_ * TL + c_ * 128; \
        _Pragma("unroll") for (int i_ = 0; i_ < 4; ++i_) { const int id_ = tid + 512 * i_; pvv[i_] = *(const u32x4*)(QKVO + (size_t)(r0_ + (id_ >> 4)) * LDQ1 + 1024 + h_ * 128 + (id_ & 15) * 8); } \
        _Pragma("unroll") for (int i_ = 0; i_ < 4; ++i_) { const int id_ = tid + 512 * i_; const int dr_ = id_ >> 10, rem_ = id_ & 1023; \
            const size_t ix_ = (size_t)((b_ * 8 + h_) * 2 + dr_) * 32 + c_; pss[i_] = *(const u32x4*)(SPREV + (ix_ * 64 + (rem_ >> 4)) * 128 + (rem_ & 15) * 8); } \
        { const int tq_ = r0_ + 16 * wave + fr; const bf16* qp_ = QKP + (size_t)tq_ * D + h_ * 64 + 8 * g; pq[0] = *(const bf16x8*)qp_; pq[1] = *(const bf16x8*)(qp_ + 32); } \
        if (wave < 2) { const size_t ix_ = (size_t)((b_ * 8 + h_) * 2 + wave) * 32 + c_; const float* gp_ = GATES + (size_t)(r0_ + 2 * lane) * 32 + wave * 8 + h_; \
            pg0 = gp_[0]; pg1 = gp_[32]; pl0 = gp_[16]; pl1 = gp_[48]; pmp = MPREV[ix_]; pnp = NPREV[ix_ * 64 + lane]; } } while (0)
    if ((int)blockIdx.x < 2048) MLOUT_LOAD((int)blockIdx.x);
    for (int item = blockIdx.x; item < 2048; item += gridDim.x) {
        const int c = item & 31, h = (item >> 5) & 7, b = item >> 8;
        const int row0 = b * TL + c * 128;
#pragma unroll
        for (int i = 0; i < 2; ++i) { const int id = tid + 512 * i; const int l = id >> 3, c16 = id & 7; *(LAS u32x4*)(lk + l * SKS + c16 * 16) = *(const u32x4*)(QKP + (size_t)(row0 + l) * D + 512 + h * 64 + c16 * 8); }
#pragma unroll
        for (int i = 0; i < 4; ++i) { const int id = tid + 512 * i; const int l = id >> 4, c16 = id & 15; *(LAS u32x4*)(lv + l * OVS + c16 * 16) = pvv[i]; }
#pragma unroll
        for (int i = 0; i < 4; ++i) { const int id = tid + 512 * i; const int dr = id >> 10, rem = id & 1023; const int l = rem >> 4, c16 = rem & 15; *(LAS u32x4*)(ls + dr * 17408 + l * OVS + c16 * 16) = pss[i]; }
        const float cg0 = pg0, cg1 = pg1, cl0 = pl0, cl1 = pl1, cmp_ = pmp, cnp = pnp; bf16x8 qf[2]; qf[0] = pq[0]; qf[1] = pq[1];
        if (item + (int)gridDim.x < 2048) MLOUT_LOAD(item + (int)gridDim.x);
        if (wave < 2) {
            const int dr = wave; const size_t idx = (size_t)((b * 8 + h) * 2 + dr) * 32 + c;
            const float ig0 = cg0, ig1 = cg1, lf0 = cl0, lf1 = cl1;
            float ps = lf0 + lf1;
#pragma unroll
            for (int o = 1; o < 64; o <<= 1) { const float t = __shfl_up(ps, o); if (lane >= o) ps += t; }
            const float total = __shfl(ps, 63);
            float cum0, cum1;
            if (dr == 0) { cum1 = ps; cum0 = ps - lf1; } else { cum0 = total - (ps - lf1 - lf0); cum1 = total - (ps - lf1); }
            const float a0 = ig0 - cum0, a1 = ig1 - cum1;
            float am0, am1;
            if (dr == 0) { float pm = fmaxf(a0, a1);
#pragma unroll
                for (int o = 1; o < 64; o <<= 1) { const float t = __shfl_up(pm, o); if (lane >= o) pm = fmaxf(pm, t); }
                float prev = __shfl_up(pm, 1); if (lane == 0) prev = -1e30f; am0 = fmaxf(prev, a0); am1 = pm;
            } else { float pm = fmaxf(a0, a1);
#pragma unroll
                for (int o = 1; o < 64; o <<= 1) { const float t = __shfl_down(pm, o); if (lane + o < 64) pm = fmaxf(pm, t); }
                float nxt = __shfl_down(pm, 1); if (lane == 63) nxt = -1e30f; am0 = pm; am1 = fmaxf(nxt, a1);
            }
            const float mp = cmp_;
            const float mx0 = fmaxf(mp, am0), mx1 = fmaxf(mp, am1);
            LAS float* ar = arr + dr * 576;
            ar[2 * lane] = a0; ar[2 * lane + 1] = a1;
            ar[128 + 2 * lane] = -mx0; ar[128 + 2 * lane + 1] = -mx1;
            ar[256 + 2 * lane] = __expf(mp - mx0); ar[256 + 2 * lane + 1] = __expf(mp - mx1);
            ar[384 + 2 * lane] = __expf(-(cum0 + mx0)); ar[384 + 2 * lane + 1] = __expf(-(cum1 + mx1));
            ar[512 + lane] = cnp;
        }
        __syncthreads();
        const int tq = row0 + 16 * wave + fr; const int iq = 16 * wave + fr;
        u32x2 cow[8];
#pragma unroll
        for (int d = 0; d < 8; ++d) cow[d] = *(const u32x2*)(QKVO + (size_t)tq * LDQ1 + 2048 + h * 128 + 16 * d + 4 * g);
        float qv[16];
        { float t8[8]; unpack8(__builtin_bit_cast(u32x4, qf[0]), t8);
#pragma unroll
          for (int e = 0; e < 8; ++e) qv[e] = t8[e];
          unpack8(__builtin_bit_cast(u32x4, qf[1]), t8);
#pragma unroll
          for (int e = 0; e < 8; ++e) qv[8 + e] = t8[e]; }
        f32x4 hsum[8];
#pragma unroll
        for (int d = 0; d < 8; ++d) hsum[d] = (f32x4){0.f, 0.f, 0.f, 0.f};
#pragma unroll
        for (int dr = 0; dr < 2; ++dr) {
            const LAS float* ar = arr + dr * 576;
            const float bmq = ar[128 + iq], inter = ar[256 + iq], emq = ar[384 + iq];
            float qn = 0.f;
#pragma unroll
            for (int e = 0; e < 8; ++e) { qn += qv[e] * ar[512 + 8 * g + e]; qn += qv[8 + e] * ar[512 + 32 + 8 * g + e]; }
            qn += __shfl_xor(qn, 16); qn += __shfl_xor(qn, 32);
            bf16x8 qs[2];
            { float t8[8];
#pragma unroll
              for (int e = 0; e < 8; ++e) t8[e] = qv[e] * inter;
              qs[0] = __builtin_bit_cast(bf16x8, pack8f(t8));
#pragma unroll
              for (int e = 0; e < 8; ++e) t8[e] = qv[8 + e] * inter;
              qs[1] = __builtin_bit_cast(bf16x8, pack8f(t8)); }
            f32x4 acc[8];
            const LAS char* lsd = ls + dr * 17408;
#pragma unroll
            for (int d = 0; d < 8; ++d) { acc[d] = (f32x4){0.f, 0.f, 0.f, 0.f};
#pragma unroll
                for (int ks = 0; ks < 2; ++ks) { const int rb = (32 * ks + 8 * g + q4) * OVS + (16 * d + 4 * p4) * 2;
                    acc[d] = MFMA16(cat44(trread(lsd + rb), trread(lsd + rb + 4 * OVS)), qs[ks], acc[d]); } }
            float psum = 0.f;
            const int jlo = dr == 0 ? 0 : (wave >> 1), jhi = dr == 0 ? (wave >> 1) : 3;
            for (int jp = jlo; jp <= jhi; ++jp) {
                float pv[8];
#pragma unroll
                for (int jj = 0; jj < 2; ++jj) { const int jb = 2 * jp + jj;
                    const LAS char* kp = lk + (16 * jb + fr) * SKS + 8 * g * 2;
                    f32x4 st = MFMA16(*(const LAS bf16x8*)kp, qf[0], ((f32x4){0.f, 0.f, 0.f, 0.f})); st = MFMA16(*(const LAS bf16x8*)(kp + 64), qf[1], st);
                    const f32x4 av = *(const LAS f32x4*)(ar + 16 * jb + 4 * g);
#pragma unroll
                    for (int e = 0; e < 4; ++e) { const int j = 16 * jb + 4 * g + e; const bool valid = dr == 0 ? (j <= iq) : (j >= iq);
                        const float wgt = valid ? __expf(bmq + av[e]) : 0.f; const float pe = wgt * st[e]; pv[jj * 4 + e] = pe; psum += pe; } }
                const bf16x8 pf = __builtin_bit_cast(bf16x8, pack8f(pv));
#pragma unroll
                for (int d = 0; d < 8; ++d) { const int rb0 = (32 * jp + 4 * g + q4) * OVS + (16 * d + 4 * p4) * 2;
                    acc[d] = MFMA16(cat44(trread(lv + rb0), trread(lv + rb0 + 16 * OVS)), pf, acc[d]); }
            }
            psum += __shfl_xor(psum, 16); psum += __shfl_xor(psum, 32);
            const float den = inter * qn + psum;
            const float hs = 1.0f / fmaxf(fabsf(den), emq);
#pragma unroll
            for (int d = 0; d < 8; ++d) hsum[d] = hsum[d] + acc[d] * hs;
        }
        float ss = 0.f;
#pragma unroll
        for (int d = 0; d < 8; ++d) ss += (hsum[d][0] * hsum[d][0] + hsum[d][1] * hsum[d][1]) + (hsum[d][2] * hsum[d][2] + hsum[d][3] * hsum[d][3]);
        ss += __shfl_xor(ss, 16); ss += __shfl_xor(ss, 32);
        const float rstd = rsqrtf(ss * (1.f / 128.f) + EPS);
#pragma unroll
        for (int d = 0; d < 8; ++d) { const int col = h * 128 + 16 * d + 4 * g;
            const f32x4 ng = *(const f32x4*)(normg + col); const u32x2 ow = cow[d];
            const float o0 = bflo(ow.x), o1 = bfhi(ow.x), o2 = bflo(ow.y), o3 = bfhi(ow.y);
            u32x2 w; w.x = pk2(hsum[d][0] * rstd * ng[0] * fast_sig(o0), hsum[d][1] * rstd * ng[1] * fast_sig(o1));
            w.y = pk2(hsum[d][2] * rstd * ng[2] * fast_sig(o2), hsum[d][3] * rstd * ng[3] * fast_sig(o3));
            *(u32x2*)(HN + (size_t)tq * D + col) = w; }
        __syncthreads();
    }
}

#define XB_TMO      128
#define XB_XCNT(j)  (256  + 64 * (j))
#define XB_XSUB(j)  (1280 + 64 * (j))
#define XB_XGEN(j)  (2304 + 64 * (j))
#define XB_TOP      3328
#define XB_TOPGEN   3392
#define XCD_BAR_WORDS 3456
#define XB_SPIN_CAP (1u << 18)

__device__ __forceinline__ unsigned xb_ld(unsigned* p)              { return __hip_atomic_load(p, __ATOMIC_RELAXED, __HIP_MEMORY_SCOPE_AGENT); }
__device__ __forceinline__ unsigned xb_add(unsigned* p, unsigned v) { return __hip_atomic_fetch_add(p, v, __ATOMIC_RELAXED, __HIP_MEMORY_SCOPE_AGENT); }
__device__ __forceinline__ unsigned xb_xcc_id() { return (unsigned)__builtin_amdgcn_s_getreg((3 << 11) | 20) & 0xFu; }
#define XB_SPIN(cond, bar) do { unsigned _sp = 0; while (cond) { __builtin_amdgcn_s_sleep(1); \
    if ((++_sp & 255u) == 0u) { if (xb_ld(&(bar)[XB_TMO])) break; if (_sp > XB_SPIN_CAP) { atomicAdd(&(bar)[XB_TMO], 1u); break; } } } } while (0)

struct XcdBarrier {
    unsigned* bar; unsigned x;
    volatile LAS unsigned* st;
};

__device__ __forceinline__ XcdBarrier xcd_barrier_post(unsigned* bar, volatile LAS unsigned* st) {
    XcdBarrier b; b.bar = bar; b.x = xb_xcc_id(); b.st = st;
    if (threadIdx.x == 0) (void)xb_add(&bar[XB_XCNT(b.x)], 1u);
    return b;
}
__device__ __forceinline__ void xcd_barrier_complete(unsigned* bar, unsigned x, unsigned& nloc, unsigned& nx) {
    const unsigned G = gridDim.x * gridDim.y * gridDim.z;
    unsigned sum, cnt, mine, sp = 0u;
    for (;;) {
        sum = 0u; cnt = 0u; mine = 0u;
#pragma unroll
        for (unsigned j = 0; j < 16; ++j) { const unsigned c = xb_ld(&bar[XB_XCNT(j)]); sum += c; cnt += (c > 0u) ? 1u : 0u; mine = (j == x) ? c : mine; }
        if (sum == G) break;
        __builtin_amdgcn_s_sleep(1);
        if ((++sp & 255u) == 0u) { if (xb_ld(&bar[XB_TMO])) break; if (sp > XB_SPIN_CAP) { atomicAdd(&bar[XB_TMO], 1u); break; } }
    }
    nloc = mine > 0u ? mine : 1u; nx = cnt > 0u ? cnt : 1u;
}

__device__ __forceinline__ void xcd_barrier(const XcdBarrier& b) {
    asm volatile("s_waitcnt vmcnt(0)" ::: "memory");
    __syncthreads();
    if (threadIdx.x == 0) {
        unsigned* bar = b.bar;
        __builtin_amdgcn_s_waitcnt(0);
        unsigned nloc = b.st[0], nx = b.st[1];
        if (nloc == 0u) { xcd_barrier_complete(bar, b.x, nloc, nx); b.st[0] = nloc; b.st[1] = nx; }
        const unsigned old = xb_add(&bar[XB_XSUB(b.x)], 1u);
        const unsigned gen = old / nloc;
        if (old + 1u == (gen + 1u) * nloc) {
            __builtin_amdgcn_fence(__ATOMIC_RELEASE, "agent");
            asm volatile("s_waitcnt vmcnt(0)" ::: "memory");
            const unsigned og = xb_add(&bar[XB_TOP], 1u);
            const unsigned tg = og / nx;
            if (og + 1u == (tg + 1u) * nx) xb_add(&bar[XB_TOPGEN], 1u);
            else XB_SPIN(xb_ld(&bar[XB_TOPGEN]) == tg, bar);
            __builtin_amdgcn_fence(__ATOMIC_ACQUIRE, "agent");
            xb_add(&bar[XB_XGEN(b.x)], 1u);
            asm volatile("s_waitcnt vmcnt(0)" ::: "memory");
        } else {
            XB_SPIN(xb_ld(&bar[XB_XGEN(b.x)]) == gen, bar);
            __builtin_amdgcn_fence(__ATOMIC_ACQUIRE, "agent");
            asm volatile("s_waitcnt vmcnt(0)" ::: "memory");
        }
    }
    __syncthreads();
}

__global__ void __launch_bounds__(NTHR) fwd_megakernel(Params p) {
    extern __shared__ __attribute__((aligned(16))) unsigned char lds_raw[];
    LAS unsigned char* lds = (LAS unsigned char*)lds_raw;
    cg::grid_group grid = cg::this_grid();
    const int tid = threadIdx.x, lane = tid & 63, wave = __builtin_amdgcn_readfirstlane(tid >> 6);
    unsigned char* ws = p.ws;
    float* mod = (float*)(ws + WS_MOD);
    bf16* BUFA = (bf16*)(ws + WS_BUFA); bf16* XS = (bf16*)(ws + WS_XS); bf16* QKV = (bf16*)(ws + WS_QKV);
    float* GATES = (float*)(ws + WS_GATES); bf16* CTXQK = (bf16*)(ws + WS_CTXQK); float* NPREV = (float*)(ws + WS_NPREV); float* MPREV = (float*)(ws + WS_MPREV);
    bf16* QKP = (bf16*)p.out;
    bf16* SPREV = (bf16*)((unsigned char*)p.out + 64 * MiB);
    const float* x_in = p.in[0]; const float* ctx_in = p.in[2] - (size_t)MLAT * D;
    const int lo = p.ph_lo, hi = p.ph_hi;
    if (tid < 4) ((LAS unsigned*)(lds + LDS_XB_OFF))[tid] = 0u;
    __syncthreads();
    const XcdBarrier xbar = xcd_barrier_post((unsigned*)(ws + WS_BAR), (volatile LAS unsigned*)(lds + LDS_XB_OFF));
    const int G = gridDim.x, bx = blockIdx.x;
#define RUN(k) (lo <= (k) && (k) < hi)
#define NREP(k) ((((REPMASK) >> (k)) & 1) ? 2 : 1)
#define SIDE(units) const int ex_ = (units) % G; const bool idle_ = ex_ == 0 || bx >= ex_; const int rank_ = ex_ == 0 ? bx : bx - ex_, nblk_ = ex_ == 0 ? G : G - ex_;
#define SYNC(k) do { if (RUN(k) && (k) + 1 < hi) { if (hi > 1000) grid.sync(); else xcd_barrier(xbar); } } while (0)

    if (RUN(0)) for (int rp = 0; rp < NREP(0); ++rp) phase_prologue(p, lds, tid, lane, wave);
    SYNC(0);
    float* RSS = (float*)(ws + WS_RSS); const float* SHW = (const float*)(ws + WS_SHW); const float* GM = (const float*)(ws + WS_GM);
    bf16* AOUT = (bf16*)p.out;
    if (RUN(1)) { phase_aux(p, lds, tid, lane, wave); phase_norm(x_in, ctx_in, p.in[6], mod, 0, 1024, MT, BUFA, lane, wave); }
    SYNC(1);
    if (RUN(2)) { pg8::Gemm g{BUFA, (const bf16*)(ws + WS_W_ABIN), MT, NAB, D}; pg8::StaticOrder S; S.init(MT, NAB, G, bx); pg8::EpiStore E{QKV, LDQ0};
        pg8::gemm_phase<pg8::EpiStore, pg8::StaticOrder, true, true>(lds, g, S, E);
        SIDE((MT / 256) * (NAB / 256)); if (idle_) side_weights(p, 0, rank_, nblk_, lds, tid, lane, wave); }
    SYNC(2);
    if (RUN(4)) { shw_compute(p, 0, bx, G, lds, tid, lane, wave);
        for (int rp = 0; rp < NREP(20); ++rp) phase_conv(QKV, p.in[15], p.in[16], p.in[17], p.in[18], BUFA, lds, tid, lane, wave);
        for (int rp = 0; rp < NREP(4); ++rp) phase_attn(QKV, p.in[14], p.in[12], p.in[13], BUFA, lds, lane, wave); }
    SYNC(4);
    if (RUN(5)) { pg8::Gemm g{BUFA, (const bf16*)(ws + WS_W_ABOUT), MT, D, D}; pg8::StaticOrder S; S.init(MT, D, G, bx); pg8::EpiResid2<false> E{x_in, ctx_in, XS, mod + 2048, GM, AOUT, RSS};
        pg8::gemm_phase<pg8::EpiResid2<false>, pg8::StaticOrder, true, true>(lds, g, S, E);
        SIDE((MT / 256) * (D / 256)); if (idle_) { side_weights(p, 1, rank_, nblk_, lds, tid, lane, wave); side_weights(p, 2, rank_, nblk_, lds, tid, lane, wave); } }
    SYNC(5);
    if (RUN(7)) { pg8::Gemm g{AOUT, (const bf16*)(ws + WS_W_GU0), MT, 2 * DFF, D}; pg8::StaticOrder S; S.init(MT, 2 * DFF, G, bx); pg8::EpiSwiGLU2 E{QKV, DFF, RSS, SHW, 2 * DFF};
        pg8::gemm_phase<pg8::EpiSwiGLU2, pg8::StaticOrder, true, true>(lds, g, S, E);
        SIDE((MT / 256) * (2 * DFF / 256)); if (idle_) shw_compute(p, 1, rank_, nblk_, lds, tid, lane, wave); }
    SYNC(7);
    const float* mod1 = mod + 9 * 6144;
    if (G == 256) {
        if (RUN(8)) { pg8::Gemm g{QKV, (const bf16*)(ws + WS_W_DN0), MT, D, DFF}; pg8::StaticOrder S; S.init(MLAT, D, G, bx); pg8::EpiResid2<true> E{XS, XS, XS, mod + 5120, GM + 9216, BUFA, RSS + MT};
            pg8::gemm_phase<pg8::EpiResid2<true>, pg8::StaticOrder, true, true>(lds, g, S, E); }
        SYNC(8);
        if (RUN(9)) {
            if (bx < 32) { pg8::Gemm g{QKV, (const bf16*)(ws + WS_W_DN0), MT, D, DFF}; pg8::OneUnit S{128 + (bx >> 2), bx & 3, 1}; pg8::EpiResid2<true> E{XS, XS, XS, mod + 5120, GM + 9216, BUFA, RSS + MT};
                pg8::gemm_phase<pg8::EpiResid2<true>, pg8::OneUnit, true, true>(lds, g, S, E); }
            else { pg8::Gemm g{BUFA, (const bf16*)(ws + WS_W_MLIN), MT, NMLP, D}; pg8::XcdPanels S{(bx - 32) & 7, (bx - 32) >> 3, 28, 8, 8, 0, 0, NMLP / 256};
                pg8::EpiMlIn2 E{QKV, GATES, p.in[23], RSS + MT, SHW + 9 * 5632};
                pg8::gemm_phase<pg8::EpiMlIn2, pg8::XcdPanels, true, true>(lds, g, S, E); }
        }
        SYNC(9);
        if (RUN(10)) { pg8::Gemm g{BUFA, (const bf16*)(ws + WS_W_MLIN), MT, NMLP, D}; pg8::XcdPanels S{bx & 7, bx >> 3, 32, 9, 8, 64, 128, NMLP / 256};
            pg8::EpiMlIn2 E{QKV, GATES, p.in[23], RSS + MT, SHW + 9 * 5632};
            pg8::gemm_phase<pg8::EpiMlIn2, pg8::XcdPanels, true, true>(lds, g, S, E); }
        SYNC(10);
    } else {
    if (RUN(8)) { pg8::Gemm g{QKV, (const bf16*)(ws + WS_W_DN0), MT, D, DFF}; pg8::StaticOrder S; S.init(MT, D, G, bx); pg8::EpiResid2<true> E{XS, XS, XS, mod + 5120, GM + 9216, BUFA, RSS + MT};
        pg8::gemm_phase<pg8::EpiResid2<true>, pg8::StaticOrder, true, true>(lds, g, S, E); }
    SYNC(8);
    if (RUN(10)) { pg8::Gemm g{BUFA, (const bf16*)(ws + WS_W_MLIN), MT, NMLP, D}; pg8::StaticOrder S; S.init(MT, NMLP, G, bx); pg8::EpiMlIn2 E{QKV, GATES, p.in[23], RSS + MT, SHW + 9 * 5632};
        pg8::gemm_phase<pg8::EpiMlIn2, pg8::StaticOrder, true, true>(lds, g, S, E); }
    SYNC(10);
    }
    if (RUN(11)) shw_compute(p, 2, bx, G, lds, tid, lane, wave);
    if (RUN(11)) for (int rp = 0; rp < NREP(11); ++rp) phase_mlprep(QKV, p.in[21], p.in[22], QKP, CTXQK, lane, wave);
    SYNC(11);
    if (RUN(12)) for (int rp = 0; rp < NREP(12); ++rp) phase_mlscan(QKV, QKP, CTXQK, GATES, SPREV, NPREV, MPREV, lds, tid, lane, wave);
    SYNC(12);
    if (RUN(13)) for (int rp = 0; rp < NREP(13); ++rp) phase_mlout(QKV, QKP, GATES, SPREV, NPREV, MPREV, p.in[24], BUFA, lds, tid, lane, wave);
    SYNC(13);
    if (RUN(14)) { pg8::Gemm g{BUFA, (const bf16*)(ws + WS_W_MLOUT), MLAT, D, D}; pg8::StaticOrder S; S.init(MLAT, D, G, bx); pg8::EpiResid2<true> E{XS, XS, XS, mod1 + 2048, GM + 2 * 9216, AOUT, RSS + 2 * MT};
        pg8::gemm_phase<pg8::EpiResid2<true>, pg8::StaticOrder, true, true>(lds, g, S, E); }
    SYNC(14);
    if (RUN(16)) { pg8::Gemm g{AOUT, (const bf16*)(ws + WS_W_GU1), MLAT, 2 * DFF, D}; pg8::StaticOrder S; S.init(MLAT, 2 * DFF, G, bx); pg8::EpiSwiGLU2 E{QKV, DFF, RSS + 2 * MT, SHW + 9 * 5632 + 9 * 3328, 2 * DFF};
        pg8::gemm_phase<pg8::EpiSwiGLU2, pg8::StaticOrder, true, true>(lds, g, S, E); }
    SYNC(16);
    if (RUN(17)) { pg8::Gemm g{QKV, (const bf16*)(ws + WS_W_DN1), MLAT, D, DFF}; pg8::StaticOrder S; S.init(MLAT, D, G, bx); pg8::EpiResid E{XS, XS, p.out, mod1 + 5120};
        pg8::gemm_phase<pg8::EpiResid, pg8::StaticOrder, true, true>(lds, g, S, E); }
#undef RUN
#undef SYNC
}

extern "C" void kernel_launch(void* const* d_in, const int* in_sizes, int n_in, void* d_out, int out_size, void* d_ws, size_t ws_size, hipStream_t stream) {
    static int grid = 0;
    if (grid == 0) {
        if (n_in != 26 || out_size != MLAT * D || ws_size < WS_END) { fprintf(stderr, "kernel_launch: unexpected shapes (n_in %d out %d ws %zu)\n", n_in, out_size, ws_size); grid = -1; return; }
        int dev = 0, cus = 0, per_cu = 0;
        hipGetDevice(&dev); hipDeviceGetAttribute(&cus, hipDeviceAttributeMultiprocessorCount, dev);
        hipFuncSetAttribute((const void*)fwd_megakernel, hipFuncAttributeMaxDynamicSharedMemorySize, LDS_BYTES);
        hipOccupancyMaxActiveBlocksPerMultiprocessor(&per_cu, (const void*)fwd_megakernel, NTHR, LDS_BYTES);
        if (per_cu < 1) { fprintf(stderr, "kernel_launch: occupancy query says %d blocks per CU\n", per_cu); per_cu = 1; }
        (void)hipGetLastError();
        grid = cus * per_cu;
    }
    if (grid < 0) return;
    if (hipMemsetAsync((char*)d_ws + WS_BAR, 0, WS_BAR_BYTES, stream) != hipSuccess) { fprintf(stderr, "kernel_launch: memset of barrier words failed\n"); return; }
    Params p{};
    for (int i = 0; i < 26; ++i) p.in[i] = (const float*)d_in[i];
    p.out = (float*)d_out; p.ws = (unsigned char*)d_ws; p.ph_lo = 0; p.ph_hi = 18; p.rep = REPMASK;
    void* args[] = {&p};
    hipError_t e = hipLaunchCooperativeKernel((const void*)fwd_megakernel, dim3(grid), dim3(NTHR), args, LDS_BYTES, stream);
    if (e != hipSuccess) fprintf(stderr, "cooperative launch failed: %s (grid %d)\n", hipGetErrorString(e), grid);
}
```

```cpp
#include <hip/hip_runtime.h>
#include <hip/hip_cooperative_groups.h>
#include <cstdio>
#include <cstdint>
namespace cg = cooperative_groups;
#ifndef REPMASK
#define REPMASK 0
#endif

namespace pg8 {
#define PG8_LAS __attribute__((address_space(3)))
typedef unsigned short bf16_t;
typedef short bf16x8 __attribute__((ext_vector_type(8)));
typedef float f32x4 __attribute__((ext_vector_type(4)));
typedef unsigned u32x4 __attribute__((ext_vector_type(4)));
typedef unsigned u32x2 __attribute__((ext_vector_type(2)));
constexpr int BM = 256, BK = 64, HALF = 128, HTB = HALF * BK * 2  , STAGE_BYTES = 8 * HTB, NXCD = 8, WGM = 4;

__host__ __device__ __forceinline__ int lds_byte(int r, int c) { const int st = (r >> 4) * 2 + (c >> 5), rr = r & 15, cc = c & 31, ob = rr * 64 + cc * 2; return st * 1024 + (ob ^ (((ob >> 9) & 1) << 5)); }
__host__ __device__ __forceinline__ void stage_rc(int b, int& R, int& C) { const int st = b / 1024, sb = b % 1024, swz = sb ^ (((sb >> 9) & 1) << 5); R = (st >> 1) * 16 + swz / 64; C = (st & 1) * 32 + (swz % 64) / 2; }
__host__ __device__ __forceinline__ int perm32(int rho) { const int n = rho >> 4, i = rho & 15; return 8 * (i >> 2) + 4 * n + (i & 3); }

struct Unit { int pm, pn; };
struct Gemm { const bf16_t* A; const bf16_t* Bt; int M, N, K; };

struct StaticOrder {
    int nM, nN, nwg, G, c;
    __host__ __device__ void init(int M, int N, int G_, int c_) { nM = M / BM; nN = N / BM; nwg = nM * nN; G = G_; c = c_; }
    __host__ __device__ bool next(int i, Unit& u) const {
        const long L = (long)i * G + c; if (L >= nwg) return false;
        int wgid = (int)L; { const int q = nwg / NXCD, r = nwg % NXCD, xcd = wgid % NXCD, off = wgid / NXCD; wgid = (xcd < r ? xcd * (q + 1) : r * (q + 1) + (xcd - r) * q) + off; }
        const int nig = WGM * nN, gid = wgid / nig, fm = gid * WGM, gsz = (nM - fm) < WGM ? (nM - fm) : WGM;
        u.pm = fm + ((wgid % nig) % gsz); u.pn = (wgid % nig) / gsz; return true;
    }
    __device__ __forceinline__ void a_ready(const Unit&) const {}
    __device__ __forceinline__ void done(const Unit&) const {}
};


struct OneUnit { int pm, pn, valid;
    __device__ __forceinline__ bool next(int i, Unit& u) const { if (i != 0 || !valid) return false; u.pm = pm; u.pn = pn; return true; }
    __device__ __forceinline__ void a_ready(const Unit&) const {}
    __device__ __forceinline__ void done(const Unit&) const {} };
struct XcdPanels { int x, j, nb, P, PL, pm0, pmx, nN;
    __device__ __forceinline__ bool next(int i, Unit& u) const {
        const int t = i * nb + j; if (j < 0 || t >= P * nN) return false;
        int grp = t / (2 * nN), r = t - grp * 2 * nN; const int gsz = (P - 2 * grp) >= 2 ? 2 : 1;
        const int idx = 2 * grp + (gsz == 2 ? (r & 1) : 0); u.pn = gsz == 2 ? (r >> 1) : r;
        u.pm = idx < PL ? pm0 + x * PL + idx : pmx + x; return true; }
    __device__ __forceinline__ void a_ready(const Unit&) const {}
    __device__ __forceinline__ void done(const Unit&) const {} };

__device__ __forceinline__ unsigned cvt_pk_bf16(float lo, float hi) { unsigned r; asm volatile("v_cvt_pk_bf16_f32 %0, %1, %2" : "=v"(r) : "v"(lo), "v"(hi)); return r; }
__device__ __forceinline__ u32x4 pack8(const f32x4 v0, const f32x4 v1) { u32x4 w; w.x = cvt_pk_bf16(v0[0], v0[1]); w.y = cvt_pk_bf16(v0[2], v0[3]); w.z = cvt_pk_bf16(v1[0], v1[1]); w.w = cvt_pk_bf16(v1[2], v1[3]); return w; }
__device__ __forceinline__ float fast_sigmoid(float x) { return __builtin_amdgcn_rcpf(1.0f + __expf(-x)); }

struct EpiStore {
    static constexpr bool PERM = true, AFTER_DRAIN = false;
    bf16_t* O; int ldc;
    __device__ __forceinline__ void operator()(const f32x4 (&acc)[2][2][4][2], const Unit& u, int wr, int wc, int fr, int fq) const {
        const int row0 = u.pm * BM + wr * 64 + fr, col0 = u.pn * BM + wc * 32 + 8 * fq;
#pragma unroll
        for (int ai = 0; ai < 2; ++ai)
#pragma unroll
            for (int m = 0; m < 4; ++m) { bf16_t* rowp = O + (size_t)(row0 + ai * HALF + m * 16) * ldc + col0;
#pragma unroll
                for (int bj = 0; bj < 2; ++bj) *(u32x4*)(rowp + bj * HALF) = pack8(acc[ai][bj][m][0], acc[ai][bj][m][1]); }
    }
};
struct EpiResid {
    static constexpr bool PERM = true, AFTER_DRAIN = false;
    const bf16_t* res_lat; const bf16_t* res_ctx; const float* rgm; float* out; const float* gate;
    __device__ __forceinline__ void operator()(const f32x4 (&acc)[2][2][4][2], const Unit& u, int wr, int wc, int fr, int fq) const {
        const int base = u.pm * BM; const int bb = base < 32768 ? (base >> 12) : 8; const bf16_t* res = base < 32768 ? res_lat : res_ctx;
        const int row0 = base + wr * 64 + fr, col0 = u.pn * BM + wc * 32 + 8 * fq;
        f32x4 gv[2][2], rgv[2][2];
#pragma unroll
        for (int bj = 0; bj < 2; ++bj)
#pragma unroll
            for (int n = 0; n < 2; ++n) { gv[bj][n] = *(const f32x4*)(gate + (size_t)bb * 6144 + col0 + bj * HALF + 4 * n); rgv[bj][n] = *(const f32x4*)(rgm + (size_t)bb * 1024 + col0 + bj * HALF + 4 * n); }
#pragma unroll
        for (int ai = 0; ai < 2; ++ai)
#pragma unroll
            for (int m = 0; m < 4; ++m) { const size_t ro = (size_t)(row0 + ai * HALF + m * 16) * 1024 + col0;
#pragma unroll
                for (int bj = 0; bj < 2; ++bj)
#pragma unroll
                    for (int n = 0; n < 2; ++n) { const size_t ix = ro + bj * HALF + 4 * n; const u32x2 rw = *(const u32x2*)(res + ix);
                        const f32x4 r = {__builtin_bit_cast(float, rw.x << 16), __builtin_bit_cast(float, rw.x & 0xffff0000u), __builtin_bit_cast(float, rw.y << 16), __builtin_bit_cast(float, rw.y & 0xffff0000u)};
                        *(f32x4*)(out + ix) = r * rgv[bj][n] + gv[bj][n] * acc[ai][bj][m][n]; } }
    }
};
struct EpiSwiGLU {
    static constexpr bool PERM = true, AFTER_DRAIN = false;
    bf16_t* O; int ldc;
    __device__ __forceinline__ void operator()(const f32x4 (&acc)[2][2][4][2], const Unit& u, int wr, int wc, int fr, int fq) const {
        const int row0 = u.pm * BM + wr * 64 + fr, col0 = u.pn * HALF + wc * 32 + 8 * fq;
#pragma unroll
        for (int ai = 0; ai < 2; ++ai)
#pragma unroll
            for (int m = 0; m < 4; ++m) {
                f32x4 o[2];
#pragma unroll
                for (int n = 0; n < 2; ++n)
#pragma unroll
                    for (int e = 0; e < 4; ++e) { const float g = acc[ai][0][m][n][e], up = acc[ai][1][m][n][e]; o[n][e] = g * fast_sigmoid(g) * up; }
                *(u32x4*)(O + (size_t)(row0 + ai * HALF + m * 16) * ldc + col0) = pack8(o[0], o[1]);
            }
    }
};
struct EpiMlIn {
    static constexpr bool PERM = true, AFTER_DRAIN = false;
    bf16_t* O; float* gates; const float* gate_b;
    __device__ __forceinline__ void operator()(const f32x4 (&acc)[2][2][4][2], const Unit& u, int wr, int wc, int fr, int fq) const {
        const int row0 = u.pm * BM + wr * 64 + fr;
        if (u.pn < 12) {
            const int col0 = u.pn * BM + wc * 32 + 8 * fq;
#pragma unroll
            for (int ai = 0; ai < 2; ++ai)
#pragma unroll
                for (int m = 0; m < 4; ++m) { bf16_t* rowp = O + (size_t)(row0 + ai * HALF + m * 16) * 3072 + col0;
#pragma unroll
                    for (int bj = 0; bj < 2; ++bj) *(u32x4*)(rowp + bj * HALF) = pack8(acc[ai][bj][m][0], acc[ai][bj][m][1]); }
        } else if (wc == 0) {
            const int col0 = 8 * fq;
#pragma unroll
            for (int ai = 0; ai < 2; ++ai)
#pragma unroll
                for (int m = 0; m < 4; ++m)
#pragma unroll
                    for (int n = 0; n < 2; ++n) { f32x4 v = acc[ai][0][m][n] + *(const f32x4*)(gate_b + col0 + 4 * n);
                        if (col0 >= 16) {
#pragma unroll
                            for (int e = 0; e < 4; ++e) { const float x = v[e]; v[e] = fminf(x, 0.f) - log1pf(__expf(-fabsf(x))); } }
                        *(f32x4*)(gates + (size_t)(row0 + ai * HALF + m * 16) * 32 + col0 + 4 * n) = v; }
        }
    }
};


template <bool RES_SCALED> struct EpiResid2 {
    static constexpr bool PERM = true, AFTER_DRAIN = false;
    const void* res_lat; const void* res_ctx; const float* rgm; const float* gate; const float* gm; bf16_t* A2; float* rss;
    __device__ __forceinline__ void operator()(const f32x4 (&acc)[2][2][4][2], const Unit& u, int wr, int wc, int fr, int fq) const {
        const int base = u.pm * BM; const int bb = base < 32768 ? (base >> 12) : 8; const void* res = base < 32768 ? res_lat : res_ctx;
        const int row0 = base + wr * 64 + fr, col0 = u.pn * BM + wc * 32 + 8 * fq;
        f32x4 gv[2][2], gmv[2][2], rgv[2][2];
#pragma unroll
        for (int bj = 0; bj < 2; ++bj)
#pragma unroll
            for (int n = 0; n < 2; ++n) { gv[bj][n] = *(const f32x4*)(gate + (size_t)bb * 6144 + col0 + bj * HALF + 4 * n); gmv[bj][n] = *(const f32x4*)(gm + (size_t)bb * 1024 + col0 + bj * HALF + 4 * n);
                if constexpr (RES_SCALED) rgv[bj][n] = *(const f32x4*)(rgm + (size_t)bb * 1024 + col0 + bj * HALF + 4 * n); else rgv[bj][n] = (f32x4){1.f, 1.f, 1.f, 1.f}; }
#pragma unroll
        for (int ai = 0; ai < 2; ++ai)
#pragma unroll
            for (int m = 0; m < 4; ++m) { const int row = row0 + ai * HALF + m * 16; const size_t ro = (size_t)row * 1024 + col0; float ss = 0.f;
#pragma unroll
                for (int bj = 0; bj < 2; ++bj) { f32x4 r[2];
                    if constexpr (RES_SCALED) { const u32x4 rw = *(const u32x4*)((const bf16_t*)res + ro + bj * HALF);
                        r[0] = (f32x4){__builtin_bit_cast(float, rw.x << 16), __builtin_bit_cast(float, rw.x & 0xffff0000u), __builtin_bit_cast(float, rw.y << 16), __builtin_bit_cast(float, rw.y & 0xffff0000u)} * rgv[bj][0];
                        r[1] = (f32x4){__builtin_bit_cast(float, rw.z << 16), __builtin_bit_cast(float, rw.z & 0xffff0000u), __builtin_bit_cast(float, rw.w << 16), __builtin_bit_cast(float, rw.w & 0xffff0000u)} * rgv[bj][1]; }
                    else { r[0] = *(const f32x4*)((const float*)res + ro + bj * HALF); r[1] = *(const f32x4*)((const float*)res + ro + bj * HALF + 4); }
                    f32x4 o[2];
#pragma unroll
                    for (int n = 0; n < 2; ++n) { o[n] = r[n] + gv[bj][n] * acc[ai][bj][m][n]; ss += (o[n][0] * o[n][0] + o[n][1] * o[n][1]) + (o[n][2] * o[n][2] + o[n][3] * o[n][3]); }
                    *(u32x4*)(A2 + ro + bj * HALF) = pack8(o[0] * gmv[bj][0], o[1] * gmv[bj][1]); }
                ss += __shfl_xor(ss, 16); ss += __shfl_xor(ss, 32);
                if (fq == 0) (void)__hip_atomic_fetch_add(rss + row, ss, __ATOMIC_RELAXED, __HIP_MEMORY_SCOPE_AGENT); }
    }
};
struct EpiSwiGLU2 {
    static constexpr bool PERM = true, AFTER_DRAIN = false;
    bf16_t* O; int ldc; const float* rss; const float* shw; int ldn;
    __device__ __forceinline__ void operator()(const f32x4 (&acc)[2][2][4][2], const Unit& u, int wr, int wc, int fr, int fq) const {
        const int base = u.pm * BM; const int bb = base < 32768 ? (base >> 12) : 8;
        const int row0 = base + wr * 64 + fr, col0 = u.pn * HALF + wc * 32 + 8 * fq, bcol0 = u.pn * BM + wc * 32 + 8 * fq;
        f32x4 sg[2], su[2];
#pragma unroll
        for (int n = 0; n < 2; ++n) { sg[n] = *(const f32x4*)(shw + (size_t)bb * ldn + bcol0 + 4 * n); su[n] = *(const f32x4*)(shw + (size_t)bb * ldn + bcol0 + HALF + 4 * n); }
#pragma unroll
        for (int ai = 0; ai < 2; ++ai)
#pragma unroll
            for (int m = 0; m < 4; ++m) { const int row = row0 + ai * HALF + m * 16; const float rstd = rsqrtf(rss[row] * (1.f / 1024.f) + 1e-6f);
                f32x4 o[2];
#pragma unroll
                for (int n = 0; n < 2; ++n)
#pragma unroll
                    for (int e = 0; e < 4; ++e) { const float g = acc[ai][0][m][n][e] * rstd + sg[n][e], up = acc[ai][1][m][n][e] * rstd + su[n][e]; o[n][e] = g * fast_sigmoid(g) * up; }
                *(u32x4*)(O + (size_t)row * ldc + col0) = pack8(o[0], o[1]);
            }
    }
};
struct EpiMlIn2 {
    static constexpr bool PERM = true, AFTER_DRAIN = false;
    bf16_t* O; float* gates; const float* gate_b; const float* rss; const float* shw;
    __device__ __forceinline__ void operator()(const f32x4 (&acc)[2][2][4][2], const Unit& u, int wr, int wc, int fr, int fq) const {
        const int base = u.pm * BM; const int bb = base < 32768 ? (base >> 12) : 8;
        const int row0 = base + wr * 64 + fr;
        if (u.pn < 12) {
            const int col0 = u.pn * BM + wc * 32 + 8 * fq;
            f32x4 sv[2][2];
#pragma unroll
            for (int bj = 0; bj < 2; ++bj)
#pragma unroll
                for (int n = 0; n < 2; ++n) sv[bj][n] = *(const f32x4*)(shw + (size_t)bb * 3328 + col0 + bj * HALF + 4 * n);
#pragma unroll
            for (int ai = 0; ai < 2; ++ai)
#pragma unroll
                for (int m = 0; m < 4; ++m) { const int row = row0 + ai * HALF + m * 16; const float rstd = rsqrtf(rss[row] * (1.f / 1024.f) + 1e-6f); bf16_t* rowp = O + (size_t)row * 3072 + col0;
#pragma unroll
                    for (int bj = 0; bj < 2; ++bj) *(u32x4*)(rowp + bj * HALF) = pack8(acc[ai][bj][m][0] * rstd + sv[bj][0], acc[ai][bj][m][1] * rstd + sv[bj][1]); }
        } else if (wc == 0) {
            const int col0 = 8 * fq;
#pragma unroll
            for (int ai = 0; ai < 2; ++ai)
#pragma unroll
                for (int m = 0; m < 4; ++m) { const int row = row0 + ai * HALF + m * 16; const float rstd = rsqrtf(rss[row] * (1.f / 1024.f) + 1e-6f);
#pragma unroll
                    for (int n = 0; n < 2; ++n) { f32x4 v = acc[ai][0][m][n] * rstd + *(const f32x4*)(shw + (size_t)bb * 3328 + 3072 + col0 + 4 * n) + *(const f32x4*)(gate_b + col0 + 4 * n);
                        if (col0 >= 16) {
#pragma unroll
                            for (int e = 0; e < 4; ++e) { const float x = v[e]; v[e] = fminf(x, 0.f) - log1pf(__expf(-fabsf(x))); } }
                        *(f32x4*)(gates + (size_t)row * 32 + col0 + 4 * n) = v; } }
        }
    }
};

template <class Epi, class Sched, bool ALIGN_EPI = false, bool SP2 = false>
__device__ __forceinline__ void gemm_phase(PG8_LAS unsigned char* lds, const Gemm g, const Sched& S, const Epi& E) {
    const int tid = threadIdx.x, wid = __builtin_amdgcn_readfirstlane(tid >> 6), lane = tid & 63, wr = wid >> 2, wc = wid & 3, fr = lane & 15, fq = lane >> 4;
    const int K = g.K, nt = K / BK;
    unsigned voffA[2], voffB[2];
#pragma unroll
    for (int i = 0; i < 2; ++i) { int R, C; stage_rc(tid * 16 + i * 8192, R, C); const int Rb = Epi::PERM ? ((R & ~31) + perm32(R & 31)) : R;
        voffA[i] = (unsigned)(R * K + C) * 2u; voffB[i] = (unsigned)(Rb * K + C) * 2u; }
    const size_t kstep = (size_t)(BK * 2);
    const size_t hstep = (size_t)HALF * K * 2;
    const size_t tstep = 2 * hstep;
    const unsigned ldsw = (unsigned)wid * 1024u;
    const int aoff = lds_byte(wr * 64 + fr, fq * 8), boff = lds_byte(wc * 32 + fr, fq * 8);
#define PG8_SA(b, h) (((b) * 2 + (h)) * HTB)
#define PG8_SB(b, h) ((4 + (b) * 2 + (h)) * HTB)
#define PG8_STAGE(bufoff, gbase, voff) do { _Pragma("unroll") for (int _i = 0; _i < 2; ++_i) \
        __builtin_amdgcn_global_load_lds((const unsigned*)((const char*)(gbase) + (voff)[_i]), (PG8_LAS unsigned*)(lds + (bufoff) + ldsw + _i * 8192), 16, 0, 0); } while (0)
#define PG8_LDA(dst, b, h) do { _Pragma("unroll") for (int m = 0; m < 4; ++m) _Pragma("unroll") for (int k = 0; k < 2; ++k) dst[m][k] = *(const PG8_LAS bf16x8*)(lds + PG8_SA(b, h) + aoff + m * 2048 + k * 1024); } while (0)
#define PG8_LDB(dst, b, h) do { _Pragma("unroll") for (int n = 0; n < 2; ++n) _Pragma("unroll") for (int k = 0; k < 2; ++k) dst[n][k] = *(const PG8_LAS bf16x8*)(lds + PG8_SB(b, h) + boff + n * 2048 + k * 1024); } while (0)
#define PG8_MMA(ai, bj, At, Bt) do { __builtin_amdgcn_s_setprio(1); _Pragma("unroll") for (int m = 0; m < 4; ++m) _Pragma("unroll") for (int n = 0; n < 2; ++n) _Pragma("unroll") for (int k = 0; k < 2; ++k) \
        acc[ai][bj][m][n] = __builtin_amdgcn_mfma_f32_16x16x32_bf16(Bt[n][k], At[m][k], acc[ai][bj][m][n], 0, 0, 0); __builtin_amdgcn_s_setprio(0); } while (0)
#define PG8_WAIT_V(n) asm volatile("s_waitcnt vmcnt(" #n ")" ::: "memory")
#define PG8_WAIT_L(n) asm volatile("s_waitcnt lgkmcnt(" #n ")" ::: "memory")
#define PG8_BAR __builtin_amdgcn_s_barrier()
#define PG8_SCHED __builtin_amdgcn_sched_barrier(0)
    Unit cur, nxt; int ui = 0;
    if (!S.next(0, cur)) return;
    f32x4 acc[2][2][4][2];
#pragma unroll
    for (int a = 0; a < 2; ++a)
#pragma unroll
        for (int b = 0; b < 2; ++b)
#pragma unroll
            for (int m = 0; m < 4; ++m)
#pragma unroll
                for (int n = 0; n < 2; ++n) acc[a][b][m][n] = (f32x4){0.f, 0.f, 0.f, 0.f};
    bf16x8 At[4][2], B0[2][2], B1[2][2];
    const char* cA = (const char*)g.A + (size_t)cur.pm * tstep; const char* cB = (const char*)g.Bt + (size_t)cur.pn * tstep;
    S.a_ready(cur);
    if constexpr (SP2) {
        PG8_STAGE(PG8_SB(0, 0), cB, voffB); PG8_STAGE(PG8_SB(0, 1), cB + hstep, voffB); PG8_STAGE(PG8_SA(0, 0), cA, voffA); PG8_STAGE(PG8_SA(0, 1), cA + hstep, voffA);
        if (wr == 1) PG8_BAR;
        PG8_WAIT_V(2); PG8_BAR;
        PG8_STAGE(PG8_SB(1, 0), cB + kstep, voffB); PG8_STAGE(PG8_SA(1, 0), cA + kstep, voffA); PG8_STAGE(PG8_SB(1, 1), cB + hstep + kstep, voffB);
        PG8_WAIT_V(6); PG8_BAR;
    } else {
        PG8_STAGE(PG8_SB(0, 0), cB, voffB); PG8_STAGE(PG8_SA(0, 0), cA, voffA); PG8_STAGE(PG8_SB(0, 1), cB + hstep, voffB); PG8_STAGE(PG8_SA(0, 1), cA + hstep, voffA);
        if (wr == 1) PG8_BAR;
        PG8_WAIT_V(4); PG8_BAR;
        PG8_STAGE(PG8_SB(1, 0), cB + kstep, voffB); PG8_STAGE(PG8_SA(1, 0), cA + kstep, voffA); PG8_STAGE(PG8_SB(1, 1), cB + hstep + kstep, voffB);
        PG8_WAIT_V(6); PG8_BAR;
    }
    for (;;) {
        const bool has_next = S.next(ui + 1, nxt);
        const char* nA = has_next ? (const char*)g.A + (size_t)nxt.pm * tstep : cA; const char* nB = has_next ? (const char*)g.Bt + (size_t)nxt.pn * tstep : cB;
        for (int t = 0; t < nt; t += 2) {
            const bool last = (t == nt - 2);
            const char* a1 = cA + (size_t)(t + 1) * kstep;
            const char* a2 = last ? nA : cA + (size_t)(t + 2) * kstep; const char* b2 = last ? nB : cB + (size_t)(t + 2) * kstep;
            const char* a3 = a2 + kstep; const char* b3 = b2 + kstep;
            if (last && has_next) S.a_ready(nxt);
            if constexpr (SP2) {
            PG8_LDB(B0, 0, 0); PG8_LDB(B1, 0, 1); PG8_SCHED; PG8_LDA(At, 0, 0); PG8_STAGE(PG8_SA(1, 1), a1 + hstep, voffA);
            PG8_WAIT_V(8); PG8_WAIT_L(0); PG8_BAR; PG8_MMA(0, 0, At, B0); PG8_MMA(0, 1, At, B1); PG8_BAR; PG8_SCHED;
            PG8_LDA(At, 0, 1); PG8_STAGE(PG8_SB(0, 0), b2, voffB); PG8_STAGE(PG8_SB(0, 1), b2 + hstep, voffB); PG8_STAGE(PG8_SA(0, 0), a2, voffA);
            PG8_WAIT_V(8); PG8_WAIT_L(0); PG8_BAR; PG8_MMA(1, 0, At, B0); PG8_MMA(1, 1, At, B1); PG8_BAR; PG8_SCHED;
            PG8_LDB(B0, 1, 0); PG8_LDB(B1, 1, 1); PG8_SCHED; PG8_LDA(At, 1, 0); PG8_STAGE(PG8_SA(0, 1), a2 + hstep, voffA);
            PG8_WAIT_V(8); PG8_WAIT_L(0); PG8_BAR; PG8_MMA(0, 0, At, B0); PG8_MMA(0, 1, At, B1); PG8_BAR; PG8_SCHED;
            PG8_LDA(At, 1, 1); PG8_STAGE(PG8_SB(1, 0), b3, voffB); PG8_STAGE(PG8_SB(1, 1), b3 + hstep, voffB); PG8_STAGE(PG8_SA(1, 0), a3, voffA);
            PG8_WAIT_V(8); PG8_WAIT_L(0); PG8_BAR; PG8_MMA(1, 0, At, B0); PG8_MMA(1, 1, At, B1); PG8_BAR; PG8_SCHED;
            } else {
            PG8_LDB(B0, 0, 0); PG8_SCHED; PG8_LDA(At, 0, 0); PG8_STAGE(PG8_SA(1, 1), a1 + hstep, voffA);
            PG8_WAIT_L(8); PG8_BAR; PG8_WAIT_L(0); PG8_MMA(0, 0, At, B0); PG8_BAR; PG8_SCHED;
            PG8_LDB(B1, 0, 1); PG8_STAGE(PG8_SB(0, 0), b2, voffB);
            PG8_BAR; PG8_WAIT_L(0); PG8_MMA(0, 1, At, B1); PG8_BAR;
            PG8_LDA(At, 0, 1); PG8_STAGE(PG8_SA(0, 0), a2, voffA);
            PG8_BAR; PG8_WAIT_L(0); PG8_MMA(1, 0, At, B0); PG8_BAR; PG8_SCHED;
            PG8_STAGE(PG8_SB(0, 1), b2 + hstep, voffB);
            PG8_WAIT_V(6); PG8_BAR; PG8_MMA(1, 1, At, B1); PG8_BAR;
            PG8_LDB(B0, 1, 0); PG8_SCHED; PG8_LDA(At, 1, 0); PG8_STAGE(PG8_SA(0, 1), a2 + hstep, voffA);
            PG8_WAIT_L(8); PG8_BAR; PG8_WAIT_L(0); PG8_MMA(0, 0, At, B0); PG8_BAR; PG8_SCHED;
            PG8_LDB(B1, 1, 1); PG8_STAGE(PG8_SB(1, 0), b3, voffB);
            PG8_BAR; PG8_WAIT_L(0); PG8_MMA(0, 1, At, B1); PG8_BAR;
            PG8_LDA(At, 1, 1); PG8_STAGE(PG8_SA(1, 0), a3, voffA);
            PG8_BAR; PG8_WAIT_L(0); PG8_MMA(1, 0, At, B0); PG8_BAR; PG8_SCHED;
            PG8_STAGE(PG8_SB(1, 1), b3 + hstep, voffB);
            PG8_WAIT_V(6); PG8_BAR; PG8_MMA(1, 1, At, B1); PG8_BAR;
            }
        }
        if constexpr (ALIGN_EPI) { if (wr == 0) PG8_BAR; }
        if constexpr (!Epi::AFTER_DRAIN) { E(acc, cur, wr, wc, fr, fq); S.done(cur); }
        if (!has_next) break;
#pragma unroll
        for (int a = 0; a < 2; ++a)
#pragma unroll
            for (int b = 0; b < 2; ++b)
#pragma unroll
                for (int m = 0; m < 4; ++m)
#pragma unroll
                    for (int n = 0; n < 2; ++n) acc[a][b][m][n] = (f32x4){0.f, 0.f, 0.f, 0.f};
        cur = nxt; cA = nA; cB = nB; ++ui;
        if constexpr (ALIGN_EPI) { if (wr == 1) PG8_BAR; }
    }
    PG8_WAIT_V(0);
    if constexpr (!ALIGN_EPI) { if (wr == 0) PG8_BAR; }
    PG8_BAR;
    if constexpr (Epi::AFTER_DRAIN) { E.fused(acc, cur, wr, wc, fr, fq, lds, wid, lane); S.done(cur); }
#undef PG8_SA
#undef PG8_SB
#undef PG8_STAGE
#undef PG8_LDA
#undef PG8_LDB
#undef PG8_MMA
#undef PG8_WAIT_V
#undef PG8_WAIT_L
#undef PG8_BAR
#undef PG8_SCHED
}
}

constexpr int D = 1024, NB = 8, TL = 4096, NCTX = 256, MLAT = NB * TL, MCTX = NB * NCTX, MT = MLAT + MCTX;
constexpr int DFF = 2816, NAB = 2560, NML = 3104, NMLP = 3328, LDQ0 = 2560, LDQ1 = 3072;
constexpr int NTHR = 512, NWAVES = 8;
constexpr float EPS = 1e-6f;
constexpr size_t MiB = 1u << 20;
constexpr size_t WS_MOD = 0;
constexpr size_t WS_W_ABIN = 1 * MiB, WS_W_ABOUT = 6 * MiB, WS_W_GU0 = 8 * MiB, WS_W_GU1 = 19 * MiB, WS_W_DN0 = 30 * MiB, WS_W_DN1 = 36 * MiB, WS_W_MLIN = 42 * MiB, WS_W_MLOUT = 49 * MiB;
constexpr size_t WS_BUFA = 52 * MiB;
constexpr size_t WS_XS = 120 * MiB;
constexpr size_t WS_QKV = 256 * MiB;
constexpr size_t WS_GATES = 460 * MiB;
constexpr size_t WS_CTXQK = 466 * MiB;
constexpr size_t WS_NPREV = 471 * MiB;
constexpr size_t WS_MPREV = 473 * MiB;
constexpr size_t WS_RSS = 474 * MiB;
constexpr size_t WS_SHW = 475 * MiB;
constexpr size_t WS_GM = 476 * MiB;
constexpr size_t WS_END = 477 * MiB;
constexpr size_t WS_BAR = 512 * 1024;
constexpr size_t WS_BAR_BYTES = 16384;
constexpr int LDS_BYTES = 147456;
constexpr int LDS_XB_OFF = 131072 + 256;

#define LAS __attribute__((address_space(3)))
typedef unsigned short bf16;
typedef short bf16x8 __attribute__((ext_vector_type(8)));
typedef short s16x4 __attribute__((ext_vector_type(4)));
typedef float f32x4 __attribute__((ext_vector_type(4)));
typedef unsigned u32x4 __attribute__((ext_vector_type(4)));
typedef unsigned u32x2 __attribute__((ext_vector_type(2)));

__device__ __forceinline__ float bf2f(unsigned h) { return __builtin_bit_cast(float, h << 16); }
__device__ __forceinline__ float bflo(unsigned w) { return __builtin_bit_cast(float, w << 16); }
__device__ __forceinline__ float bfhi(unsigned w) { return __builtin_bit_cast(float, w & 0xffff0000u); }
__device__ __forceinline__ unsigned f2bf(float f) { unsigned u = __builtin_bit_cast(unsigned, f); return (u + 0x7fffu + ((u >> 16) & 1u)) >> 16; }
typedef float f32x2_t __attribute__((ext_vector_type(2))); typedef __bf16 bf16x2_t __attribute__((ext_vector_type(2)));
__device__ __forceinline__ unsigned pk2(float lo, float hi) { const f32x2_t v = {lo, hi}; const bf16x2_t b = __builtin_convertvector(v, bf16x2_t); return __builtin_bit_cast(unsigned, b); }
__device__ __forceinline__ float wave_sum(float v) {
#pragma unroll
    for (int o = 1; o < 64; o <<= 1) v += __shfl_xor(v, o);
    return v;
}
__device__ __forceinline__ float wave_max(float v) {
#pragma unroll
    for (int o = 1; o < 64; o <<= 1) v = fmaxf(v, __shfl_xor(v, o));
    return v;
}
__device__ __forceinline__ float fast_sig(float x) { return __builtin_amdgcn_rcpf(1.0f + __expf(-x)); }
__device__ __forceinline__ float silu_f(float x) { return x * __builtin_amdgcn_rcpf(1.0f + __expf(-x)); }
__device__ __forceinline__ void unpack8(const u32x4 w, float (&f)[8]) { f[0] = bflo(w.x); f[1] = bfhi(w.x); f[2] = bflo(w.y); f[3] = bfhi(w.y); f[4] = bflo(w.z); f[5] = bfhi(w.z); f[6] = bflo(w.w); f[7] = bfhi(w.w); }
__device__ __forceinline__ u32x4 pack8f(const float (&f)[8]) { u32x4 w; w.x = pk2(f[0], f[1]); w.y = pk2(f[2], f[3]); w.z = pk2(f[4], f[5]); w.w = pk2(f[6], f[7]); return w; }
typedef short v4i16_t __attribute__((ext_vector_type(4)));
__device__ __forceinline__ s16x4 trread(const LAS char* p) { return __builtin_bit_cast(s16x4, __builtin_amdgcn_ds_read_tr16_b64_v4i16((LAS v4i16_t*)p)); }
__device__ __forceinline__ bf16x8 cat44(const s16x4 a, const s16x4 b) { bf16x8 r; r[0] = a[0]; r[1] = a[1]; r[2] = a[2]; r[3] = a[3]; r[4] = b[0]; r[5] = b[1]; r[6] = b[2]; r[7] = b[3]; return r; }
#define MFMA16(a, b, c) __builtin_amdgcn_mfma_f32_16x16x32_bf16((a), (b), (c), 0, 0, 0)

struct Params {
    const float* in[26]; float* out; unsigned char* ws; int ph_lo, ph_hi; int rep, pad;
};

__device__ __forceinline__ void transpose_matrix(const float* W, int K, int N, bf16* WT, int kind, LAS float* scr, int gw, int NGW, int lane, int& start) {
    const int nblk = N / 32, items = nblk * (K / 64);
    int first = gw - start; if (first < 0) first += NGW;
    for (int it = first; it < items; it += NGW) {
        const int kb = it / nblk, nb = it % nblk, k0 = 64 * kb, n0 = 32 * nb;
        { const int kr = lane >> 3, nc = lane & 7; f32x4 v[8];
#pragma unroll
          for (int i = 0; i < 8; ++i) v[i] = *(const f32x4*)(W + (size_t)(k0 + 8 * i + kr) * N + n0 + 4 * nc);
#pragma unroll
          for (int i = 0; i < 8; ++i) { LAS float* sp = scr + (8 * i + kr) * 33 + 4 * nc; sp[0] = v[i][0]; sp[1] = v[i][1]; sp[2] = v[i][2]; sp[3] = v[i][3]; } }
        asm volatile("s_waitcnt lgkmcnt(0)" ::: "memory");
        const int drow0 = kind == 0 ? n0 : ((n0 >> 7) * 256 + (kind == 2 ? 128 : 0) + (n0 & 127));
        const int c = lane & 7;
#pragma unroll
        for (int j = 0; j < 4; ++j) { const int n = (lane >> 3) + 8 * j; const LAS float* s = scr + (8 * c) * 33 + n;
            u32x4 o; o.x = pk2(s[0 * 33], s[1 * 33]); o.y = pk2(s[2 * 33], s[3 * 33]); o.z = pk2(s[4 * 33], s[5 * 33]); o.w = pk2(s[6 * 33], s[7 * 33]);
            *(u32x4*)(WT + (size_t)(drow0 + n) * K + k0 + 8 * c) = o; }
        asm volatile("s_waitcnt lgkmcnt(0)" ::: "memory");
    }
    start = (start + items) % NGW;
}

__device__ __forceinline__ void phase_prologue(const Params& p, LAS unsigned char* lds, int tid, int lane, int wave) {
    unsigned char* ws = p.ws;
    const int gw = blockIdx.x * NWAVES + wave, NGW = gridDim.x * NWAVES;
    LAS float* scr = (LAS float*)(lds + wave * 8704);
    int start = 0;
    transpose_matrix(p.in[11], D, NAB, (bf16*)(ws + WS_W_ABIN), 0, scr, gw, NGW, lane, start);
    __syncthreads();
    LAS float* sv = (LAS float*)lds;
    LAS float* part = (LAS float*)(lds + 40960);
    for (int i = tid; i < 9 * 1024; i += NTHR) { const float c = i < 8192 ? p.in[1][i] : p.in[3][i - 8192]; sv[i] = silu_f(c); }
    __syncthreads();
    float* mod = (float*)(ws + WS_MOD);
    for (int item = blockIdx.x; item < 192; item += gridDim.x) {
        const int l = item / 96, cgp = item % 96, col = cgp * 64 + lane;
        const float* W = p.in[4] + (size_t)l * D * 6144 + col;
        float a[9];
#pragma unroll
        for (int b = 0; b < 9; ++b) a[b] = 0.f;
#pragma unroll 16
        for (int k = wave * 128; k < wave * 128 + 128; ++k) { const float wv = W[(size_t)k * 6144];
#pragma unroll
            for (int b = 0; b < 9; ++b) a[b] += sv[b * 1024 + k] * wv; }
#pragma unroll
        for (int b = 0; b < 9; ++b) part[(wave * 9 + b) * 64 + lane] = a[b];
        __syncthreads();
        for (int i = tid; i < 576; i += NTHR) { const int b = i >> 6, ln = i & 63; float s = 0.f;
#pragma unroll
            for (int w = 0; w < 8; ++w) s += part[(w * 9 + b) * 64 + ln];
            mod[(size_t)(l * 9 + b) * 6144 + cgp * 64 + ln] = s + p.in[5][l * 6144 + cgp * 64 + ln]; }
        __syncthreads();
    }
}


__device__ __forceinline__ void phase_aux(const Params& p, LAS unsigned char* lds, int tid, int lane, int wave) {
    unsigned char* ws = p.ws; const float* mod = (const float*)(ws + WS_MOD);
    const int gt = blockIdx.x * NTHR + tid, NGT = gridDim.x * NTHR;
    const int gw = blockIdx.x * NWAVES + wave, NGW = gridDim.x * NWAVES;
    float* rss = (float*)(ws + WS_RSS); for (int i = gt; i < 3 * MT; i += NGT) rss[i] = 0.f;
    float* gm = (float*)(ws + WS_GM);
    for (int i = gt; i < 3 * 9 * 1024; i += NGT) { const int s = i / 9216, r = i % 9216, bb = r >> 10, k = r & 1023;
        const float* ng = s == 1 ? p.in[6] + D : (s == 0 ? p.in[7] : p.in[7] + D); const int l = s == 0 ? 0 : 1; const int sc_off = s == 1 ? 1024 : 4096;
        const float gmv_ = ng[k] * (1.0f + mod[(size_t)(l * 9 + bb) * 6144 + sc_off + k]); gm[i] = gmv_; gm[3 * 9216 + i] = fabsf(gmv_) > 1e-30f ? 1.0f / gmv_ : 0.f; }
    __syncthreads();
}
__device__ __forceinline__ void shw_compute(const Params& p, int s, int rank, int nblk, LAS unsigned char* lds, int tid, int lane, int wave) {
    unsigned char* ws = p.ws; const float* mod = (const float*)(ws + WS_MOD);
    const int gw = rank * NWAVES + wave, NGW = nblk * NWAVES;
    LAS float* shl = (LAS float*)lds;
    float* shw = (float*)(ws + WS_SHW);
    const int l = s == 0 ? 0 : 1, sh_off = s == 1 ? 0 : 3072, N = s == 1 ? NMLP : 2 * DFF;
    const bf16* Wt = (const bf16*)(ws + (s == 0 ? WS_W_GU0 : (s == 1 ? WS_W_MLIN : WS_W_GU1)));
    float* dst = shw + (s == 0 ? 0 : (s == 1 ? 9 * 5632 : 9 * 5632 + 9 * 3328));
    __syncthreads();
    for (int i = tid; i < 9 * 1024; i += NTHR) shl[i] = mod[(size_t)(l * 9 + (i >> 10)) * 6144 + sh_off + (i & 1023)];
    __syncthreads();
    for (int n = gw; n < N; n += NGW) {
        float w[16]; { const u32x4* wp = (const u32x4*)(Wt + (size_t)n * D + lane * 16); float t8[8]; unpack8(wp[0], t8);
#pragma unroll
            for (int e = 0; e < 8; ++e) w[e] = t8[e];
            unpack8(wp[1], t8);
#pragma unroll
            for (int e = 0; e < 8; ++e) w[8 + e] = t8[e]; }
        float res = 0.f;
#pragma unroll
        for (int bb = 0; bb < 9; ++bb) { float a = 0.f; const LAS f32x4* sp = (const LAS f32x4*)(shl + bb * 1024 + lane * 16);
#pragma unroll
            for (int j = 0; j < 4; ++j) { const f32x4 sv = sp[j]; a += (w[4 * j] * sv[0] + w[4 * j + 1] * sv[1]) + (w[4 * j + 2] * sv[2] + w[4 * j + 3] * sv[3]); }
            a = wave_sum(a); if (lane == bb) res = a; }
        if (lane < 9) dst[(size_t)lane * N + n] = res;
    }
    __syncthreads();
}
__device__ __forceinline__ void side_weights(const Params& p, int set, int rank, int nblk, LAS unsigned char* lds, int tid, int lane, int wave) {
    unsigned char* ws = p.ws;
    const int gw = rank * NWAVES + wave, NGW = nblk * NWAVES;
    LAS float* scr = (LAS float*)(lds + wave * 8704);
    int start = 0;
    if (set == 0) {
        transpose_matrix(p.in[19], D, D, (bf16*)(ws + WS_W_ABOUT), 0, scr, gw, NGW, lane, start);
        transpose_matrix(p.in[8], D, DFF, (bf16*)(ws + WS_W_GU0), 1, scr, gw, NGW, lane, start);
        transpose_matrix(p.in[9], D, DFF, (bf16*)(ws + WS_W_GU0), 2, scr, gw, NGW, lane, start);
    } else if (set == 1) {
        transpose_matrix(p.in[10], DFF, D, (bf16*)(ws + WS_W_DN0), 0, scr, gw, NGW, lane, start);
        transpose_matrix(p.in[20], D, NML, (bf16*)(ws + WS_W_MLIN), 0, scr, gw, NGW, lane, start);
        u32x4* z = (u32x4*)(ws + WS_W_MLIN + (size_t)NML * D * 2); const int n16 = (NMLP - NML) * D * 2 / 16;
        for (int i = rank * NTHR + tid; i < n16; i += nblk * NTHR) z[i] = (u32x4){0u, 0u, 0u, 0u};
    } else {
        transpose_matrix(p.in[25], D, D, (bf16*)(ws + WS_W_MLOUT), 0, scr, gw, NGW, lane, start);
        transpose_matrix(p.in[8] + (size_t)D * DFF, D, DFF, (bf16*)(ws + WS_W_GU1), 1, scr, gw, NGW, lane, start);
        transpose_matrix(p.in[9] + (size_t)D * DFF, D, DFF, (bf16*)(ws + WS_W_GU1), 2, scr, gw, NGW, lane, start);
        transpose_matrix(p.in[10] + (size_t)DFF * D, DFF, D, (bf16*)(ws + WS_W_DN1), 0, scr, gw, NGW, lane, start);
    }
    __syncthreads();
}

__device__ __forceinline__ void phase_norm(const float* __restrict__ src_lat, const float* __restrict__ src_ctx, const float* __restrict__ g, const float* __restrict__ modl, int sh_off, int sc_off, int Mrows, bf16* __restrict__ H, int lane, int wave) {
    const int gw = blockIdx.x * NWAVES + wave, NGW = gridDim.x * NWAVES;
    f32x4 gv[4];
#pragma unroll
    for (int j = 0; j < 4; ++j) gv[j] = ((const f32x4*)g)[lane + 64 * j];
#pragma unroll 2
    for (int row = gw; row < Mrows; row += NGW) {
        const float* src = row < MLAT ? src_lat : src_ctx; const int bb = row < MLAT ? (row >> 12) : 8;
        const f32x4* xr = (const f32x4*)(src + (size_t)row * D) + lane;
        f32x4 v[4]; float ss = 0.f;
#pragma unroll
        for (int j = 0; j < 4; ++j) { v[j] = xr[64 * j]; ss += (v[j].x * v[j].x + v[j].y * v[j].y) + (v[j].z * v[j].z + v[j].w * v[j].w); }
        const float rstd = rsqrtf(wave_sum(ss) * (1.f / D) + EPS);
        const f32x4* sc = (const f32x4*)(modl + (size_t)bb * 6144 + sc_off) + lane; const f32x4* sh = (const f32x4*)(modl + (size_t)bb * 6144 + sh_off) + lane;
        u32x2* o = (u32x2*)(H + (size_t)row * D) + lane;
#pragma unroll
        for (int j = 0; j < 4; ++j) { const f32x4 y = v[j] * rstd * gv[j] * (sc[64 * j] + 1.0f) + sh[64 * j]; u32x2 w; w.x = pk2(y.x, y.y); w.y = pk2(y.z, y.w); o[64 * j] = w; }
    }
}

__device__ __forceinline__ void phase_qknorm(bf16* QKV, const float* qg, const float* kg, int lane, int wave) {
    const int gw = blockIdx.x * NWAVES + wave, NGW = gridDim.x * NWAVES;
    float gq[8], gk[8];
#pragma unroll
    for (int e = 0; e < 8; ++e) { gq[e] = qg[(lane & 7) * 8 + e] * 0.125f; gk[e] = kg[(lane & 7) * 8 + e]; }
    for (int item = gw; item < MT * 2; item += NGW) {
        const int row = item >> 1, half = item & 1;
        u32x4* ptr = (u32x4*)(QKV + (size_t)row * LDQ0 + half * 512) + lane;
        float f[8]; unpack8(*ptr, f);
        float ss = 0.f;
#pragma unroll
        for (int e = 0; e < 8; ++e) ss += f[e] * f[e];
        ss += __shfl_xor(ss, 1); ss += __shfl_xor(ss, 2); ss += __shfl_xor(ss, 4);
        const float rstd = rsqrtf(ss * (1.f / 64.f) + EPS);
#pragma unroll
        for (int e = 0; e < 8; ++e) f[e] = f[e] * rstd * (half ? gk[e] : gq[e]);
        *ptr = pack8f(f);
    }
}

__device__ __forceinline__ void phase_conv(const bf16* QKV, const float* cw, const float* cb, const float* lng, const float* lnb, bf16* ATT, LAS unsigned char* lds, int tid, int lane, int wave) {
    LAS unsigned short* glu = (LAS unsigned short*)lds;
    LAS float* ybuf = (LAS float*)(lds + 65536);
    float w[31];
#pragma unroll
    for (int i = 0; i < 31; ++i) w[i] = cw[i * 512 + tid];
    const float bias = cb[tid];
    float lg[8], lb[8];
#pragma unroll
    for (int e = 0; e < 8; ++e) { lg[e] = lng[lane * 8 + e]; lb[e] = lnb[lane * 8 + e]; }
    u32x4 ru[8], rgt[8];
#define CONV_LOAD(it_) do { int sb_, sl_, t0_; if ((it_) < 1024) { sb_ = ((it_) >> 7) * TL; sl_ = TL; t0_ = ((it_) & 127) * 32; } else { const int j_ = (it_) - 1024; sb_ = MLAT + (j_ >> 3) * NCTX; sl_ = NCTX; t0_ = (j_ & 7) * 32; } \
        _Pragma("unroll") for (int ps_ = 0; ps_ < 8; ++ps_) { const int i_ = ps_ * 8 + (tid >> 6); const int t_ = t0_ - 15 + i_; ru[ps_] = (u32x4){0u, 0u, 0u, 0u}; rgt[ps_] = ru[ps_]; \
            if (i_ < 62 && t_ >= 0 && t_ < sl_) { const bf16* rp_ = QKV + (size_t)(sb_ + t_) * LDQ0 + 1536 + lane * 8; ru[ps_] = *(const u32x4*)rp_; rgt[ps_] = *(const u32x4*)(rp_ + 512); } } } while (0)
    if ((int)blockIdx.x < 1088) CONV_LOAD((int)blockIdx.x);
    for (int it = blockIdx.x; it < 1088; it += gridDim.x) {
        int seq_base, t0;
        if (it < 1024) { seq_base = (it >> 7) * TL; t0 = (it & 127) * 32; } else { const int j = it - 1024; seq_base = MLAT + (j >> 3) * NCTX; t0 = (j & 7) * 32; }
#pragma unroll
        for (int ps = 0; ps < 8; ++ps) { const int i = ps * 8 + (tid >> 6);
            if (i < 62) { float u[8], gt[8]; unpack8(ru[ps], u); unpack8(rgt[ps], gt);
#pragma unroll
                for (int e = 0; e < 8; ++e) u[e] = u[e] * __builtin_amdgcn_rcpf(1.0f + __expf(-gt[e]));
                *(LAS u32x4*)(glu + i * 512 + lane * 8) = pack8f(u); } }
        if (it + (int)gridDim.x < 1088) CONV_LOAD(it + (int)gridDim.x);
        __syncthreads();
        for (int tg = 0; tg < 4; ++tg) {
            float v[38];
#pragma unroll
            for (int j = 0; j < 38; ++j) v[j] = bf2f(glu[(tg * 8 + j) * 512 + tid]);
#pragma unroll
            for (int t = 0; t < 8; ++t) { float a = bias;
#pragma unroll
                for (int k = 0; k < 31; ++k) a += v[t + k] * w[k];
                ybuf[(tg * 8 + t) * 512 + tid] = a; }
        }
        __syncthreads();
#pragma unroll
        for (int q = 0; q < 4; ++q) { const int t = wave * 4 + q; const LAS f32x4* yp = (const LAS f32x4*)(ybuf + t * 512 + lane * 8);
            const f32x4 a = yp[0], b = yp[1]; float f[8] = {a.x, a.y, a.z, a.w, b.x, b.y, b.z, b.w};
            float s = 0.f;
#pragma unroll
            for (int e = 0; e < 8; ++e) s += f[e];
            const float mu = wave_sum(s) * (1.f / 512.f); float s2 = 0.f;
#pragma unroll
            for (int e = 0; e < 8; ++e) { f[e] -= mu; s2 += f[e] * f[e]; }
            const float rstd = rsqrtf(wave_sum(s2) * (1.f / 512.f) + EPS);
#pragma unroll
            for (int e = 0; e < 8; ++e) f[e] = silu_f(f[e] * rstd * lg[e] + lb[e]);
            *(u32x4*)(ATT + (size_t)(seq_base + t0 + t) * D + 512 + lane * 8) = pack8f(f); }
    }
    __syncthreads();
}

constexpr int AVS = 144;
template <int NQR>
__device__ __forceinline__ void attn_wave(const bf16* QKV, int tq0, int h, int krlo, int nkr, int tkloc0, int tkctx0, const LAS float* rpbh, int rbase, int qc0, int kc0, bf16* ATT, LAS char* vl, int lane, const LAS float* gqk) {
    const int fr = lane & 15, g = lane >> 4, q4 = (lane & 15) >> 2, p4 = lane & 3;
    bf16x8 qf[NQR][2]; f32x4 oacc[NQR][4]; float lrun[NQR]; int r0q[NQR];
    const float sref = __builtin_bit_cast(float, __builtin_amdgcn_readfirstlane(__builtin_bit_cast(int, gqk[64])));
#pragma unroll
    for (int qr = 0; qr < NQR; ++qr) {
        const bf16* qp = QKV + (size_t)(tq0 + 64 * qr + fr) * LDQ0 + h * 64 + 8 * g;
        { float a8[8], b8[8]; unpack8(*(const u32x4*)qp, a8); unpack8(*(const u32x4*)(qp + 32), b8); float ss = 0.f;
#pragma unroll
          for (int e = 0; e < 8; ++e) ss += a8[e] * a8[e] + b8[e] * b8[e];
          ss += __shfl_xor(ss, 16); ss += __shfl_xor(ss, 32); const float rq = rsqrtf(ss * (1.f / 64.f) + EPS);
#pragma unroll
          for (int e = 0; e < 8; ++e) { a8[e] *= rq * gqk[8 * g + e]; b8[e] *= rq * gqk[32 + 8 * g + e]; }
          qf[qr][0] = __builtin_bit_cast(bf16x8, pack8f(a8)); qf[qr][1] = __builtin_bit_cast(bf16x8, pack8f(b8)); }
#pragma unroll
        for (int c = 0; c < 4; ++c) oacc[qr][c] = (f32x4){0.f, 0.f, 0.f, 0.f};
        lrun[qr] = 0.f; r0q[qr] = min(max(rbase + qr - 4, 0), 56);
    }
    const int ns = nkr + 8;
    const int qcol = qc0 + fr; const int lo = min(max(qcol - 8, 0), 48);
    bf16x8 kf[4]; u32x4 vv[4];
    {
        const int tk0 = nkr > 0 ? tkloc0 : tkctx0;
        const bf16* kp = QKV + (size_t)(tk0 + fr) * LDQ0 + 512 + h * 64 + 8 * g;
        kf[0] = *(const bf16x8*)kp; kf[1] = *(const bf16x8*)(kp + 32); kf[2] = *(const bf16x8*)(kp + 16 * LDQ0); kf[3] = *(const bf16x8*)(kp + 16 * LDQ0 + 32);
#pragma unroll
        for (int i = 0; i < 4; ++i) { const int c = lane + 64 * i; vv[i] = *(const u32x4*)(QKV + (size_t)(tk0 + (c >> 3)) * LDQ0 + 1024 + h * 64 + (c & 7) * 8); }
    }
    for (int s = 0; s < ns; ++s) {
        bf16x8 kn[4]; u32x4 vn[4];
        if (s + 1 < ns) {
            const int tk0 = (s + 1) < nkr ? tkloc0 + (s + 1) * 64 : tkctx0 + (s + 1 - nkr) * 32;
            const bf16* kp = QKV + (size_t)(tk0 + fr) * LDQ0 + 512 + h * 64 + 8 * g;
            kn[0] = *(const bf16x8*)kp; kn[1] = *(const bf16x8*)(kp + 32); kn[2] = *(const bf16x8*)(kp + 16 * LDQ0); kn[3] = *(const bf16x8*)(kp + 16 * LDQ0 + 32);
#pragma unroll
            for (int i = 0; i < 4; ++i) { const int c = lane + 64 * i; vn[i] = *(const u32x4*)(QKV + (size_t)(tk0 + (c >> 3)) * LDQ0 + 1024 + h * 64 + (c & 7) * 8); }
        } else {
#pragma unroll
            for (int i = 0; i < 4; ++i) { kn[i] = kf[i]; vn[i] = vv[i]; }
        }
#pragma unroll
        for (int i = 0; i < 4; ++i) { const int c = lane + 64 * i; *(LAS u32x4*)(vl + (c >> 3) * AVS + (c & 7) * 16) = vv[i]; }
        asm volatile("s_waitcnt lgkmcnt(0)" ::: "memory");
        bf16x8 vfr[4];
#pragma unroll
        for (int c = 0; c < 4; ++c) vfr[c] = cat44(trread(vl + (4 * g + q4) * AVS + (16 * c + 4 * p4) * 2), trread(vl + (16 + 4 * g + q4) * AVS + (16 * c + 4 * p4) * 2));
        asm volatile("s_waitcnt lgkmcnt(0)" ::: "memory");
        const bool local = s < nkr; const int kr = krlo + s;
#pragma unroll
        for (int jb = 0; jb < 2; ++jb) { float a8[8], b8[8]; unpack8(__builtin_bit_cast(u32x4, kf[2 * jb]), a8); unpack8(__builtin_bit_cast(u32x4, kf[2 * jb + 1]), b8); float ss = 0.f;
#pragma unroll
            for (int e = 0; e < 8; ++e) ss += a8[e] * a8[e] + b8[e] * b8[e];
            ss += __shfl_xor(ss, 16); ss += __shfl_xor(ss, 32); const float rk = rsqrtf(ss * (1.f / 64.f) + EPS);
#pragma unroll
            for (int e = 0; e < 8; ++e) { a8[e] *= rk; b8[e] *= rk; }
            kf[2 * jb] = __builtin_bit_cast(bf16x8, pack8f(a8)); kf[2 * jb + 1] = __builtin_bit_cast(bf16x8, pack8f(b8)); }
#pragma unroll
        for (int qr = 0; qr < NQR; ++qr) {
            if (!local || (kr >= r0q[qr] && kr < r0q[qr] + 8)) {
                f32x4 st[2];
#pragma unroll
                for (int jb = 0; jb < 2; ++jb) { st[jb] = MFMA16(kf[2 * jb], qf[qr][0], ((f32x4){0.f, 0.f, 0.f, 0.f})); st[jb] = MFMA16(kf[2 * jb + 1], qf[qr][1], st[jb]); }
                float ps = 0.f; float pv[8];
                if (local) {
                    const LAS float* rrow = rpbh + (kr - (rbase + qr) + 7) * 31;
#pragma unroll
                    for (int jb = 0; jb < 2; ++jb)
#pragma unroll
                        for (int e = 0; e < 4; ++e) { const int kcol = kc0 + 16 * jb + 4 * g + e; const bool valid = (kcol >= lo) && (kcol < lo + 16);
                            const int rel = min(max(kcol - qcol + 15, 0), 30); const float bv = valid ? rrow[rel] : -1e30f;
                            const float pe = __builtin_amdgcn_exp2f(st[jb][e] + bv); pv[jb * 4 + e] = pe; ps += pe; }
                } else {
#pragma unroll
                    for (int jb = 0; jb < 2; ++jb)
#pragma unroll
                        for (int e = 0; e < 4; ++e) { const float pe = __builtin_amdgcn_exp2f(st[jb][e] - sref); pv[jb * 4 + e] = pe; ps += pe; }
                }
                lrun[qr] += ps;
                const bf16x8 pf = __builtin_bit_cast(bf16x8, pack8f(pv));
#pragma unroll
                for (int c = 0; c < 4; ++c) oacc[qr][c] = MFMA16(vfr[c], pf, oacc[qr][c]);
            }
        }
#pragma unroll
        for (int i = 0; i < 4; ++i) { kf[i] = kn[i]; vv[i] = vn[i]; }
    }
#pragma unroll
    for (int qr = 0; qr < NQR; ++qr) {
        float lt = lrun[qr]; lt += __shfl_xor(lt, 16); lt += __shfl_xor(lt, 32);
        const float inv = 1.0f / lt;
        bf16* op = ATT + (size_t)(tq0 + 64 * qr + fr) * D + h * 64 + 4 * g;
#pragma unroll
        for (int c = 0; c < 4; ++c) { u32x2 w; w.x = pk2(oacc[qr][c][0] * inv, oacc[qr][c][1] * inv); w.y = pk2(oacc[qr][c][2] * inv, oacc[qr][c][3] * inv); *(u32x2*)(op + 16 * c) = w; }
    }
}

__device__ __forceinline__ void phase_attn(const bf16* QKV, const float* rpb, const float* qg, const float* kg, bf16* ATT, LAS unsigned char* lds, int lane, int wave) {
    const int gw = blockIdx.x * NWAVES + wave, NGW = gridDim.x * NWAVES;
    LAS char* vl = (LAS char*)lds + wave * 4608;
    LAS float* rpbl = (LAS float*)(lds + 40960);
    LAS float* gqk = (LAS float*)(lds + 57344);
    if (threadIdx.x < 64) { const float gv = qg[threadIdx.x] * kg[threadIdx.x] * (0.125f * 1.44269504f); gqk[threadIdx.x] = gv;
        const float bnd = 64.0f * wave_max(fabsf(gv)); if (threadIdx.x == 0) gqk[64] = bnd; }
    __syncthreads();
    { const float bnd = gqk[64]; for (int i = threadIdx.x; i < 8 * 15 * 31; i += NTHR) rpbl[i] = rpb[i] * 1.44269504f - bnd; }
    __syncthreads();
    for (int item = gw; item < 4096; item += NGW) {
        const int cgp = item & 3, h = (item >> 2) & 7, rg = (item >> 5) & 15, b = item >> 9;
        const int rbase = 4 * rg; const int krlo = min(max(rbase - 4, 0), 56); const int krhi = min(max(rbase + 3 - 4, 0), 56) + 8;
        const int kc0 = cgp == 0 ? 0 : (cgp == 1 ? 8 : (cgp == 2 ? 24 : 32));
        attn_wave<4>(QKV, b * TL + rbase * 64 + 16 * cgp, h, krlo, krhi - krlo, b * TL + krlo * 64 + kc0, MLAT + b * NCTX, rpbl + h * 15 * 31, rbase, 16 * cgp, kc0, ATT, vl, lane, gqk);
    }
    for (int item = (gw + NGW / 2) % NGW; item < 1024; item += NGW) {
        const int qg = item & 15, h = (item >> 4) & 7, b = item >> 7;
        attn_wave<1>(QKV, MLAT + b * NCTX + 16 * qg, h, 0, 0, 0, MLAT + b * NCTX, rpbl, 0, 0, 0, ATT, vl, lane, gqk);
    }
}

__device__ __forceinline__ void phase_mlprep(const bf16* __restrict__ QKVO, const float* __restrict__ cw, const float* __restrict__ cb, bf16* __restrict__ QKP, bf16* __restrict__ CTXQK, int lane, int wave) {
    const int gw = blockIdx.x * NWAVES + wave, NGW = gridDim.x * NWAVES;
    for (int half = 0; half < 2; ++half) {
        const int cbase = half * 512 + lane * 8;
        float w[5][8], bias[8];
#pragma unroll
        for (int k = 0; k < 5; ++k)
#pragma unroll
            for (int e = 0; e < 8; ++e) w[k][e] = cw[k * 1024 + cbase + e];
#pragma unroll
        for (int e = 0; e < 8; ++e) bias[e] = cb[cbase + e];
        float inv[8];
#pragma unroll
        for (int e = 0; e < 8; ++e) inv[e] = exp2f(-(float)((lane & 1) * 8 + e) * (13.287712379549449f / 16.f));
        const int mrows = half == 0 ? MLAT : MT;
#pragma unroll 2
        for (int row = gw; row < mrows; row += NGW) {
            int t, len; if (row < MLAT) { t = row & (TL - 1); len = TL; } else { t = (row - MLAT) & (NCTX - 1); len = NCTX; }
            float a[8];
#pragma unroll
            for (int e = 0; e < 8; ++e) a[e] = bias[e];
#pragma unroll
            for (int k = 0; k < 5; ++k) { const int tt = t + k - 2;
                if (tt >= 0 && tt < len) { float f[8]; unpack8(*(const u32x4*)(QKVO + (size_t)(row + k - 2) * LDQ1 + cbase), f);
#pragma unroll
                    for (int e = 0; e < 8; ++e) a[e] += f[e] * w[k][e]; } }
            const float qs = half == 0 ? 0.125f : 1.0f;
#pragma unroll
            for (int e = 0; e < 8; ++e) a[e] = silu_f(a[e]) * qs;
            if (row < MLAT) {
                const float pos = (float)((lane & 4) ? (t & 63) : (t >> 6));
#pragma unroll
                for (int e = 0; e < 8; ++e) { const float ang = pos * inv[e]; const float cs = __cosf(ang), sn = __sinf(ang); const float other = __shfl_xor(a[e], 2);
                    a[e] = (lane & 2) ? (other * sn + a[e] * cs) : (a[e] * cs - other * sn); }
                *(u32x4*)(QKP + (size_t)row * D + cbase) = pack8f(a);
            } else {
                *(u32x4*)(CTXQK + (size_t)(row - MLAT) * D + cbase) = pack8f(a);
            }
        }
    }
}

constexpr int SKS = 144;
__device__ __forceinline__ void phase_mlscan(const bf16* QKVO, const bf16* QKP, const bf16* CTXQK, const float* GATES, bf16* SPREV, float* NPREV, float* MPREV, LAS unsigned char* lds, int tid, int lane, int wave) {
    LAS char* tb = (LAS char*)lds;
    LAS float* lnb = (LAS float*)(lds + 73728);
    LAS float* weT = (LAS float*)(lds + 77824);
    LAS float* totT = (LAS float*)(lds + 95232);
    LAS float* mlocT = totT + 64;
    LAS float* mbefT = totT + 128;
    LAS float* mnewT = totT + 192;
    LAS float* decT = totT + 256;
    const int g = lane >> 4, fr = lane & 15, q4 = (lane & 15) >> 2, p4 = lane & 3;
    const int dvb = wave >> 1, dkb0 = 2 * (wave & 1);
    for (int item = blockIdx.x; item < 256; item += gridDim.x) {
        const int vh = item & 1, dir = (item >> 1) & 1, h = (item >> 2) & 7, b = item >> 5;
#define SCAN_ROW0(st) ((st) < 2 ? MLAT + b * NCTX + (dir ? 1 - (st) : (st)) * 128 : b * TL + (dir ? 31 - ((st) - 2) : (st) - 2) * 128)
#pragma unroll 1
        for (int st = wave; st < 34; st += 8) {
            const int r0 = SCAN_ROW0(st);
            const float* gp = GATES + (size_t)(r0 + 2 * lane) * 32 + dir * 8 + h;
            const float ig0 = gp[0], ig1 = gp[32], lf0 = gp[16], lf1 = gp[48];
            float ps = lf0 + lf1;
#pragma unroll
            for (int o = 1; o < 64; o <<= 1) { const float t = __shfl_up(ps, o); if (lane >= o) ps += t; }
            const float total = __shfl(ps, 63); const float cum1 = ps, cum0 = ps - lf1;
            float we0, we1;
            if (dir == 0) { we0 = total - cum0 + ig0; we1 = total - cum1 + ig1; } else { we0 = (cum0 - lf0) + ig0; we1 = (cum1 - lf1) + ig1; }
            const float mloc = wave_max(fmaxf(we0, we1));
            weT[st * 128 + 2 * lane] = we0; weT[st * 128 + 2 * lane + 1] = we1;
            if (lane == 0) { totT[st] = total; mlocT[st] = mloc; }
        }
        __syncthreads();
        if (wave == 0) {
            float m = 0.f;
#pragma unroll 1
            for (int st = 0; st < 34; ++st) { const float total = totT[st], mloc = mlocT[st]; const float mnew = fmaxf(total + m, mloc); const float dec = __expf(total + m - mnew);
                if (lane == 0) { mbefT[st] = m; mnewT[st] = mnew; decT[st] = dec; } m = mnew; }
        }
        __syncthreads();
        u32x4 nk[2], nv[2];
#define SCAN_LOAD(st) do { const bool ic_ = (st) < 2; const int r0_ = SCAN_ROW0(st); \
            _Pragma("unroll") for (int i_ = 0; i_ < 2; ++i_) { const int id_ = tid + 512 * i_; const int l_ = id_ >> 3, c_ = id_ & 7; \
                const bf16* kp_ = ic_ ? CTXQK + (size_t)(r0_ - MLAT + l_) * D + 512 + h * 64 + c_ * 8 : QKP + (size_t)(r0_ + l_) * D + 512 + h * 64 + c_ * 8; \
                nk[i_] = *(const u32x4*)kp_; nv[i_] = *(const u32x4*)(QKVO + (size_t)(r0_ + l_) * LDQ1 + 1024 + h * 128 + vh * 64 + c_ * 8); } } while (0)
#define SCAN_STAGE(st) do { LAS char* lk_ = tb + ((st) & 1) * 36864; LAS char* lv_ = lk_ + 18432; const float mn_ = mnewT[st]; \
            _Pragma("unroll") for (int i_ = 0; i_ < 2; ++i_) { const int id_ = tid + 512 * i_; const int l_ = id_ >> 3, c_ = id_ & 7; \
                float f_[8]; unpack8(nk[i_], f_); const float wl_ = __expf(weT[(st) * 128 + l_] - mn_); \
                _Pragma("unroll") for (int e_ = 0; e_ < 8; ++e_) f_[e_] *= wl_; \
                *(LAS u32x4*)(lk_ + l_ * SKS + c_ * 16) = pack8f(f_); *(LAS u32x4*)(lv_ + l_ * SKS + c_ * 16) = nv[i_]; } } while (0)
        SCAN_LOAD(0); SCAN_STAGE(0); SCAN_LOAD(1);
        __syncthreads();
        f32x4 acc[2]; acc[0] = (f32x4){0.f, 0.f, 0.f, 0.f}; acc[1] = acc[0];
        float nst = 0.f;
#pragma unroll 1
        for (int step = 0; step < 34; ++step) {
            if (step >= 2) {
                const int cc = dir ? 31 - (step - 2) : step - 2;
                const size_t idx = (size_t)((b * 8 + h) * 2 + dir) * 32 + cc;
#pragma unroll
                for (int t = 0; t < 2; ++t) { u32x2 w; w.x = pk2(acc[t][0], acc[t][1]); w.y = pk2(acc[t][2], acc[t][3]);
                    *(u32x2*)(SPREV + (idx * 64 + 16 * (dkb0 + t) + fr) * 128 + vh * 64 + 16 * dvb + 4 * g) = w; }
                if (vh == 0 && tid < 64) NPREV[idx * 64 + tid] = nst;
                if (vh == 0 && tid == 0) MPREV[idx] = mbefT[step];
            }
            if (step + 1 < 34) { SCAN_STAGE(step + 1); if (step + 2 < 34) SCAN_LOAD(step + 2); }
            const LAS char* lk = tb + (step & 1) * 36864; const LAS char* lv = lk + 18432;
            const float decay = decT[step];
            acc[0] = acc[0] * decay; acc[1] = acc[1] * decay;
#pragma unroll
            for (int s4 = 0; s4 < 4; ++s4) {
                const int rb = (32 * s4 + 8 * g + q4) * SKS;
                const bf16x8 af = cat44(trread(lv + rb + (16 * dvb + 4 * p4) * 2), trread(lv + rb + 4 * SKS + (16 * dvb + 4 * p4) * 2));
#pragma unroll
                for (int t = 0; t < 2; ++t) { const bf16x8 bfr = cat44(trread(lk + rb + (16 * (dkb0 + t) + 4 * p4) * 2), trread(lk + rb + 4 * SKS + (16 * (dkb0 + t) + 4 * p4) * 2));
                    acc[t] = MFMA16(af, bfr, acc[t]); }
            }
            { const int dk = tid & 63, part = tid >> 6; float s = 0.f;
#pragma unroll
              for (int l = 0; l < 16; ++l) s += bf2f(*(const LAS unsigned short*)(lk + (part * 16 + l) * SKS + dk * 2));
              lnb[(step & 1) * 512 + part * 64 + dk] = s; }
            __syncthreads();
            if (tid < 64) { float s = 0.f;
#pragma unroll
                for (int pt = 0; pt < 8; ++pt) s += lnb[(step & 1) * 512 + pt * 64 + tid];
                nst = decay * nst + s; }
        }
        __syncthreads();
#undef SCAN_ROW0
#undef SCAN_LOAD
#undef SCAN_STAGE
    }
}

constexpr int OVS = 272;
__device__ __forceinline__ void phase_mlout(const bf16* QKVO, const bf16* QKP, const float* GATES, const bf16* SPREV, const float* NPREV, const float* MPREV, const float* normg, bf16* HN,
                                            LAS unsigned char* lds, int tid, int lane, int wave) {
    LAS char* lk = (LAS char*)lds; LAS char* lv = (LAS char*)lds + 18432; LAS char* ls = (LAS char*)lds + 53248;
    LAS float* arr = (LAS float*)(lds + 88064);
    const int g = lane >> 4, fr = lane & 15, q4 = (lane & 15) >> 2, p4 = lane & 3;
    u32x4 pvv[4], pss[4]; float pg0 = 0.f, pg1 = 0.f, pl0 = 0.f, pl1 = 0.f, pmp = 0.f, pnp = 0.f; bf16x8 pq[2];
#define MLOUT_LOAD(it_) do { const int c_ = (it_) & 31, h_ = ((it_) >> 5) & 7, b_ = (it_) >> 8; const int r0_ = b_ * TL + c_ * 128; \
        _Pragma("unroll") for (int i_ = 0; i_ < 4; ++i_) { const int id_ = tid + 512 * i_; pvv[i_] = *(const u32x4*)(QKVO + (size_t)(r0_ + (id_ >> 4)) * LDQ1 + 1024 + h_ * 128 + (id_ & 15) * 8); } \
        _Pragma("unroll") for (int i_ = 0; i_ < 4; ++i_) { const int id_ = tid + 512 * i_; const int dr_ = id_ >> 10, rem_ = id_ & 1023; \
            const size_t ix_ = (size_t)((b_ * 8 + h_) * 2 + dr_) * 32 + c_; pss[i_] = *(const u32x4*)(SPREV + (ix_ * 64 + (rem_ >> 4)) * 128 + (rem_ & 15) * 8); } \
        { const int tq_ = r0_ + 16 * wave + fr; const bf16* qp_ = QKP + (size_t)tq_ * D + h_ * 64 + 8 * g; pq[0] = *(const bf16x8*)qp_; pq[1] = *(const bf16x8*)(qp_ + 32); } \
        if (wave < 2) { const size_t ix_ = (size_t)((b_ * 8 + h_) * 2 + wave) * 32 + c_; const float* gp_ = GATES + (size_t)(r0_ + 2 * lane) * 32 + wave * 8 + h_; \
            pg0 = gp_[0]; pg1 = gp_[32]; pl0 = gp_[16]; pl1 = gp_[48]; pmp = MPREV[ix_]; pnp = NPREV[ix_ * 64 + lane]; } } while (0)
    if ((int)blockIdx.x < 2048) MLOUT_LOAD((int)blockIdx.x);
    for (int item = blockIdx.x; item < 2048; item += gridDim.x) {
        const int c = item & 31, h = (item >> 5) & 7, b = item >> 8;
        const int row0 = b * TL + c * 128;
#pragma unroll
        for (int i = 0; i < 2; ++i) { const int id = tid + 512 * i; const int l = id >> 3, c16 = id & 7; *(LAS u32x4*)(lk + l * SKS + c16 * 16) = *(const u32x4*)(QKP + (size_t)(row0 + l) * D + 512 + h * 64 + c16 * 8); }
#pragma unroll
        for (int i = 0; i < 4; ++i) { const int id = tid + 512 * i; const int l = id >> 4, c16 = id & 15; *(LAS u32x4*)(lv + l * OVS + c16 * 16) = pvv[i]; }
#pragma unroll
        for (int i = 0; i < 4; ++i) { const int id = tid + 512 * i; const int dr = id >> 10, rem = id & 1023; const int l = rem >> 4, c16 = rem & 15; *(LAS u32x4*)(ls + dr * 17408 + l * OVS + c16 * 16) = pss[i]; }
        const float cg0 = pg0, cg1 = pg1, cl0 = pl0, cl1 = pl1, cmp_ = pmp, cnp = pnp; bf16x8 qf[2]; qf[0] = pq[0]; qf[1] = pq[1];
        if (item + (int)gridDim.x < 2048) MLOUT_LOAD(item + (int)gridDim.x);
        if (wave < 2) {
            const int dr = wave; const size_t idx = (size_t)((b * 8 + h) * 2 + dr) * 32 + c;
            const float ig0 = cg0, ig1 = cg1, lf0 = cl0, lf1 = cl1;
            float ps = lf0 + lf1;
#pragma unroll
            for (int o = 1; o < 64; o <<= 1) { const float t = __shfl_up(ps, o); if (lane >= o) ps += t; }
            const float total = __shfl(ps, 63);
            float cum0, cum1;
            if (dr == 0) { cum1 = ps; cum0 = ps - lf1; } else { cum0 = total - (ps - lf1 - lf0); cum1 = total - (ps - lf1); }
            const float a0 = ig0 - cum0, a1 = ig1 - cum1;
            float am0, am1;
            if (dr == 0) { float pm = fmaxf(a0, a1);
#pragma unroll
                for (int o = 1; o < 64; o <<= 1) { const float t = __shfl_up(pm, o); if (lane >= o) pm = fmaxf(pm, t); }
                float prev = __shfl_up(pm, 1); if (lane == 0) prev = -1e30f; am0 = fmaxf(prev, a0); am1 = pm;
            } else { float pm = fmaxf(a0, a1);
#pragma unroll
                for (int o = 1; o < 64; o <<= 1) { const float t = __shfl_down(pm, o); if (lane + o < 64) pm = fmaxf(pm, t); }
                float nxt = __shfl_down(pm, 1); if (lane == 63) nxt = -1e30f; am0 = pm; am1 = fmaxf(nxt, a1);
            }
            const float mp = cmp_;
            const float mx0 = fmaxf(mp, am0), mx1 = fmaxf(mp, am1);
            LAS float* ar = arr + dr * 576;
            ar[2 * lane] = a0; ar[2 * lane + 1] = a1;
            ar[128 + 2 * lane] = -mx0; ar[128 + 2 * lane + 1] = -mx1;
            ar[256 + 2 * lane] = __expf(mp - mx0); ar[256 + 2 * lane + 1] = __expf(mp - mx1);
            ar[384 + 2 * lane] = __expf(-(cum0 + mx0)); ar[384 + 2 * lane + 1] = __expf(-(cum1 + mx1));
            ar[512 + lane] = cnp;
        }
        __syncthreads();
        const int tq = row0 + 16 * wave + fr; const int iq = 16 * wave + fr;
        u32x2 cow[8];
#pragma unroll
        for (int d = 0; d < 8; ++d) cow[d] = *(const u32x2*)(QKVO + (size_t)tq * LDQ1 + 2048 + h * 128 + 16 * d + 4 * g);
        float qv[16];
        { float t8[8]; unpack8(__builtin_bit_cast(u32x4, qf[0]), t8);
#pragma unroll
          for (int e = 0; e < 8; ++e) qv[e] = t8[e];
          unpack8(__builtin_bit_cast(u32x4, qf[1]), t8);
#pragma unroll
          for (int e = 0; e < 8; ++e) qv[8 + e] = t8[e]; }
        f32x4 hsum[8];
#pragma unroll
        for (int d = 0; d < 8; ++d) hsum[d] = (f32x4){0.f, 0.f, 0.f, 0.f};
#pragma unroll
        for (int dr = 0; dr < 2; ++dr) {
            const LAS float* ar = arr + dr * 576;
            const float bmq = ar[128 + iq], inter = ar[256 + iq], emq = ar[384 + iq];
            float qn = 0.f;
#pragma unroll
            for (int e = 0; e < 8; ++e) { qn += qv[e] * ar[512 + 8 * g + e]; qn += qv[8 + e] * ar[512 + 32 + 8 * g + e]; }
            qn += __shfl_xor(qn, 16); qn += __shfl_xor(qn, 32);
            bf16x8 qs[2];
            { float t8[8];
#pragma unroll
              for (int e = 0; e < 8; ++e) t8[e] = qv[e] * inter;
              qs[0] = __builtin_bit_cast(bf16x8, pack8f(t8));
#pragma unroll
              for (int e = 0; e < 8; ++e) t8[e] = qv[8 + e] * inter;
              qs[1] = __builtin_bit_cast(bf16x8, pack8f(t8)); }
            f32x4 acc[8];
            const LAS char* lsd = ls + dr * 17408;
#pragma unroll
            for (int d = 0; d < 8; ++d) { acc[d] = (f32x4){0.f, 0.f, 0.f, 0.f};
#pragma unroll
                for (int ks = 0; ks < 2; ++ks) { const int rb = (32 * ks + 8 * g + q4) * OVS + (16 * d + 4 * p4) * 2;
                    acc[d] = MFMA16(cat44(trread(lsd + rb), trread(lsd + rb + 4 * OVS)), qs[ks], acc[d]); } }
            float psum = 0.f;
            const int jlo = dr == 0 ? 0 : (wave >> 1), jhi = dr == 0 ? (wave >> 1) : 3;
            for (int jp = jlo; jp <= jhi; ++jp) {
                float pv[8];
#pragma unroll
                for (int jj = 0; jj < 2; ++jj) { const int jb = 2 * jp + jj;
                    const LAS char* kp = lk + (16 * jb + fr) * SKS + 8 * g * 2;
                    f32x4 st = MFMA16(*(const LAS bf16x8*)kp, qf[0], ((f32x4){0.f, 0.f, 0.f, 0.f})); st = MFMA16(*(const LAS bf16x8*)(kp + 64), qf[1], st);
                    const f32x4 av = *(const LAS f32x4*)(ar + 16 * jb + 4 * g);
#pragma unroll
                    for (int e = 0; e < 4; ++e) { const int j = 16 * jb + 4 * g + e; const bool valid = dr == 0 ? (j <= iq) : (j >= iq);
                        const float wgt = valid ? __expf(bmq + av[e]) : 0.f; const float pe = wgt * st[e]; pv[jj * 4 + e] = pe; psum += pe; } }
                const bf16x8 pf = __builtin_bit_cast(bf16x8, pack8f(pv));
#pragma unroll
                for (int d = 0; d < 8; ++d) { const int rb0 = (32 * jp + 4 * g + q4) * OVS + (16 * d + 4 * p4) * 2;
                    acc[d] = MFMA16(cat44(trread(lv + rb0), trread(lv + rb0 + 16 * OVS)), pf, acc[d]); }
            }
            psum += __shfl_xor(psum, 16); psum += __shfl_xor(psum, 32);
            const float den = inter * qn + psum;
            const float hs = 1.0f / fmaxf(fabsf(den), emq);
#pragma unroll
            for (int d = 0; d < 8; ++d) hsum[d] = hsum[d] + acc[d] * hs;
        }
        float ss = 0.f;
#pragma unroll
        for (int d = 0; d < 8; ++d) ss += (hsum[d][0] * hsum[d][0] + hsum[d][1] * hsum[d][1]) + (hsum[d][2] * hsum[d][2] + hsum[d][3] * hsum[d][3]);
        ss += __shfl_xor(ss, 16); ss += __shfl_xor(ss, 32);
        const float rstd = rsqrtf(ss * (1.f / 128.f) + EPS);
#pragma unroll
        for (int d = 0; d < 8; ++d) { const int col = h * 128 + 16 * d + 4 * g;
            const f32x4 ng = *(const f32x4*)(normg + col); const u32x2 ow = cow[d];
            const float o0 = bflo(ow.x), o1 = bfhi(ow.x), o2 = bflo(ow.y), o3 = bfhi(ow.y);
            u32x2 w; w.x = pk2(hsum[d][0] * rstd * ng[0] * fast_sig(o0), hsum[d][1] * rstd * ng[1] * fast_sig(o1));
            w.y = pk2(hsum[d][2] * rstd * ng[2] * fast_sig(o2), hsum[d][3] * rstd * ng[3] * fast_sig(o3));
            *(u32x2*)(HN + (size_t)tq * D + col) = w; }
        __syncthreads();
    }
}

#define XB_TMO      128
#define XB_XCNT(j)  (256  + 64 * (j))
#define XB_XSUB(j)  (1280 + 64 * (j))
#define XB_XGEN(j)  (2304 + 64 * (j))
#define XB_TOP      3328
#define XB_TOPGEN   3392
#define XCD_BAR_WORDS 3456
#define XB_SPIN_CAP (1u << 18)

__device__ __forceinline__ unsigned xb_ld(unsigned* p)              { return __hip_atomic_load(p, __ATOMIC_RELAXED, __HIP_MEMORY_SCOPE_AGENT); }
__device__ __forceinline__ unsigned xb_add(unsigned* p, unsigned v) { return __hip_atomic_fetch_add(p, v, __ATOMIC_RELAXED, __HIP_MEMORY_SCOPE_AGENT); }
__device__ __forceinline__ unsigned xb_xcc_id() { return (unsigned)__builtin_amdgcn_s_getreg((3 << 11) | 20) & 0xFu; }
#define XB_SPIN(cond, bar) do { unsigned _sp = 0; while (cond) { __builtin_amdgcn_s_sleep(1); \
    if ((++_sp & 255u) == 0u) { if (xb_ld(&(bar)[XB_TMO])) break; if (_sp > XB_SPIN_CAP) { atomicAdd(&(bar)[XB_TMO], 1u); break; } } } } while (0)

struct XcdBarrier {
    unsigned* bar; unsigned x;
    volatile LAS unsigned* st;
};

__device__ __forceinline__ XcdBarrier xcd_barrier_post(unsigned* bar, volatile LAS unsigned* st) {
    XcdBarrier b; b.bar = bar; b.x = xb_xcc_id(); b.st = st;
    if (threadIdx.x == 0) (void)xb_add(&bar[XB_XCNT(b.x)], 1u);
    return b;
}
__device__ __forceinline__ void xcd_barrier_complete(unsigned* bar, unsigned x, unsigned& nloc, unsigned& nx) {
    const unsigned G = gridDim.x * gridDim.y * gridDim.z;
    unsigned sum, cnt, mine, sp = 0u;
    for (;;) {
        sum = 0u; cnt = 0u; mine = 0u;
#pragma unroll
        for (unsigned j = 0; j < 16; ++j) { const unsigned c = xb_ld(&bar[XB_XCNT(j)]); sum += c; cnt += (c > 0u) ? 1u : 0u; mine = (j == x) ? c : mine; }
        if (sum == G) break;
        __builtin_amdgcn_s_sleep(1);
        if ((++sp & 255u) == 0u) { if (xb_ld(&bar[XB_TMO])) break; if (sp > XB_SPIN_CAP) { atomicAdd(&bar[XB_TMO], 1u); break; } }
    }
    nloc = mine > 0u ? mine : 1u; nx = cnt > 0u ? cnt : 1u;
}

__device__ __forceinline__ void xcd_barrier(const XcdBarrier& b) {
    asm volatile("s_waitcnt vmcnt(0)" ::: "memory");
    __syncthreads();
    if (threadIdx.x == 0) {
        unsigned* bar = b.bar;
        __builtin_amdgcn_s_waitcnt(0);
        unsigned nloc = b.st[0], nx = b.st[1];
        if (nloc == 0u) { xcd_barrier_complete(bar, b.x, nloc, nx); b.st[0] = nloc; b.st[1] = nx; }
        const unsigned old = xb_add(&bar[XB_XSUB(b.x)], 1u);
        const unsigned gen = old / nloc;
        if (old + 1u == (gen + 1u) * nloc) {
            __builtin_amdgcn_fence(__ATOMIC_RELEASE, "agent");
            asm volatile("s_waitcnt vmcnt(0)" ::: "memory");
            const unsigned og = xb_add(&bar[XB_TOP], 1u);
            const unsigned tg = og / nx;
            if (og + 1u == (tg + 1u) * nx) xb_add(&bar[XB_TOPGEN], 1u);
            else XB_SPIN(xb_ld(&bar[XB_TOPGEN]) == tg, bar);
            __builtin_amdgcn_fence(__ATOMIC_ACQUIRE, "agent");
            xb_add(&bar[XB_XGEN(b.x)], 1u);
            asm volatile("s_waitcnt vmcnt(0)" ::: "memory");
        } else {
            XB_SPIN(xb_ld(&bar[XB_XGEN(b.x)]) == gen, bar);
            __builtin_amdgcn_fence(__ATOMIC_ACQUIRE, "agent");
            asm volatile("s_waitcnt vmcnt(0)" ::: "memory");
        }
    }
    __syncthreads();
}

__global__ void __launch_bounds__(NTHR) fwd_megakernel(Params p) {
    extern __shared__ __attribute__((aligned(16))) unsigned char lds_raw[];
    LAS unsigned char* lds = (LAS unsigned char*)lds_raw;
    cg::grid_group grid = cg::this_grid();
    const int tid = threadIdx.x, lane = tid & 63, wave = __builtin_amdgcn_readfirstlane(tid >> 6);
    unsigned char* ws = p.ws;
    float* mod = (float*)(ws + WS_MOD);
    bf16* BUFA = (bf16*)(ws + WS_BUFA); bf16* XSA = (bf16*)(ws + WS_XS); bf16* XSB = (bf16*)(ws + WS_XS + 68 * MiB);     bf16* QKV = (bf16*)(ws + WS_QKV);
    float* GATES = (float*)(ws + WS_GATES); bf16* CTXQK = (bf16*)(ws + WS_CTXQK); float* NPREV = (float*)(ws + WS_NPREV); float* MPREV = (float*)(ws + WS_MPREV);
    bf16* QKP = (bf16*)p.out;
    bf16* SPREV = (bf16*)((unsigned char*)p.out + 64 * MiB);
    const float* x_in = p.in[0]; const float* ctx_in = p.in[2] - (size_t)MLAT * D;
    const int lo = p.ph_lo, hi = p.ph_hi;
    if (tid < 4) ((LAS unsigned*)(lds + LDS_XB_OFF))[tid] = 0u;
    __syncthreads();
    const XcdBarrier xbar = xcd_barrier_post((unsigned*)(ws + WS_BAR), (volatile LAS unsigned*)(lds + LDS_XB_OFF));
    const int G = gridDim.x, bx = blockIdx.x;
#define RUN(k) (lo <= (k) && (k) < hi)
#define NREP(k) ((((REPMASK) >> (k)) & 1) ? 2 : 1)
#define SIDE(units) const int ex_ = (units) % G; const bool idle_ = ex_ == 0 || bx >= ex_; const int rank_ = ex_ == 0 ? bx : bx - ex_, nblk_ = ex_ == 0 ? G : G - ex_;
#define SYNC(k) do { if (RUN(k) && (k) + 1 < hi) { if (hi > 1000) grid.sync(); else xcd_barrier(xbar); } } while (0)

    if (RUN(0)) for (int rp = 0; rp < NREP(0); ++rp) phase_prologue(p, lds, tid, lane, wave);
    SYNC(0);
    float* RSS = (float*)(ws + WS_RSS); const float* SHW = (const float*)(ws + WS_SHW); const float* GM = (const float*)(ws + WS_GM); const float* GMI = GM + 3 * 9216;
    bf16* AOUT = (bf16*)p.out;
    if (RUN(1)) { phase_aux(p, lds, tid, lane, wave); phase_norm(x_in, ctx_in, p.in[6], mod, 0, 1024, MT, BUFA, lane, wave); }
    SYNC(1);
    if (RUN(2)) { pg8::Gemm g{BUFA, (const bf16*)(ws + WS_W_ABIN), MT, NAB, D}; pg8::StaticOrder S; S.init(MT, NAB, G, bx); pg8::EpiStore E{QKV, LDQ0};
        pg8::gemm_phase<pg8::EpiStore, pg8::StaticOrder, true, true>(lds, g, S, E);
        SIDE((MT / 256) * (NAB / 256)); if (idle_) side_weights(p, 0, rank_, nblk_, lds, tid, lane, wave); }
    SYNC(2);
    if (RUN(4)) { shw_compute(p, 0, bx, G, lds, tid, lane, wave);
        for (int rp = 0; rp < NREP(20); ++rp) phase_conv(QKV, p.in[15], p.in[16], p.in[17], p.in[18], BUFA, lds, tid, lane, wave);
        for (int rp = 0; rp < NREP(4); ++rp) phase_attn(QKV, p.in[14], p.in[12], p.in[13], BUFA, lds, lane, wave); }
    SYNC(4);
    if (RUN(5)) { pg8::Gemm g{BUFA, (const bf16*)(ws + WS_W_ABOUT), MT, D, D}; pg8::StaticOrder S; S.init(MT, D, G, bx); pg8::EpiResid2<false> E{x_in, ctx_in, nullptr, mod + 2048, GM, AOUT, RSS};
        pg8::gemm_phase<pg8::EpiResid2<false>, pg8::StaticOrder, true, true>(lds, g, S, E);
        SIDE((MT / 256) * (D / 256)); if (idle_) { side_weights(p, 1, rank_, nblk_, lds, tid, lane, wave); side_weights(p, 2, rank_, nblk_, lds, tid, lane, wave); } }
    SYNC(5);
    if (RUN(7)) { pg8::Gemm g{AOUT, (const bf16*)(ws + WS_W_GU0), MT, 2 * DFF, D}; pg8::StaticOrder S; S.init(MT, 2 * DFF, G, bx); pg8::EpiSwiGLU2 E{QKV, DFF, RSS, SHW, 2 * DFF};
        pg8::gemm_phase<pg8::EpiSwiGLU2, pg8::StaticOrder, true, true>(lds, g, S, E);
        SIDE((MT / 256) * (2 * DFF / 256)); if (idle_) shw_compute(p, 1, rank_, nblk_, lds, tid, lane, wave); }
    SYNC(7);
    const float* mod1 = mod + 9 * 6144;
    if (G == 256) {
        if (RUN(8)) { pg8::Gemm g{QKV, (const bf16*)(ws + WS_W_DN0), MT, D, DFF}; pg8::StaticOrder S; S.init(MLAT, D, G, bx); pg8::EpiResid2<true> E{AOUT, AOUT, GMI, mod + 5120, GM + 9216, XSB, RSS + MT};
            pg8::gemm_phase<pg8::EpiResid2<true>, pg8::StaticOrder, true, true>(lds, g, S, E); }
        SYNC(8);
        if (RUN(9)) {
            if (bx < 32) { pg8::Gemm g{QKV, (const bf16*)(ws + WS_W_DN0), MT, D, DFF}; pg8::OneUnit S{128 + (bx >> 2), bx & 3, 1}; pg8::EpiResid2<true> E{AOUT, AOUT, GMI, mod + 5120, GM + 9216, XSB, RSS + MT};
                pg8::gemm_phase<pg8::EpiResid2<true>, pg8::OneUnit, true, true>(lds, g, S, E); }
            else { pg8::Gemm g{XSB, (const bf16*)(ws + WS_W_MLIN), MT, NMLP, D}; pg8::XcdPanels S{(bx - 32) & 7, (bx - 32) >> 3, 28, 8, 8, 0, 0, NMLP / 256};
                pg8::EpiMlIn2 E{QKV, GATES, p.in[23], RSS + MT, SHW + 9 * 5632};
                pg8::gemm_phase<pg8::EpiMlIn2, pg8::XcdPanels, true, true>(lds, g, S, E); }
        }
        SYNC(9);
        if (RUN(10)) { pg8::Gemm g{XSB, (const bf16*)(ws + WS_W_MLIN), MT, NMLP, D}; pg8::XcdPanels S{bx & 7, bx >> 3, 32, 9, 8, 64, 128, NMLP / 256};
            pg8::EpiMlIn2 E{QKV, GATES, p.in[23], RSS + MT, SHW + 9 * 5632};
            pg8::gemm_phase<pg8::EpiMlIn2, pg8::XcdPanels, true, true>(lds, g, S, E); }
        SYNC(10);
    } else {
    if (RUN(8)) { pg8::Gemm g{QKV, (const bf16*)(ws + WS_W_DN0), MT, D, DFF}; pg8::StaticOrder S; S.init(MT, D, G, bx); pg8::EpiResid2<true> E{AOUT, AOUT, GMI, mod + 5120, GM + 9216, XSB, RSS + MT};
        pg8::gemm_phase<pg8::EpiResid2<true>, pg8::StaticOrder, true, true>(lds, g, S, E); }
    SYNC(8);
    if (RUN(10)) { pg8::Gemm g{XSB, (const bf16*)(ws + WS_W_MLIN), MT, NMLP, D}; pg8::StaticOrder S; S.init(MT, NMLP, G, bx); pg8::EpiMlIn2 E{QKV, GATES, p.in[23], RSS + MT, SHW + 9 * 5632};
        pg8::gemm_phase<pg8::EpiMlIn2, pg8::StaticOrder, true, true>(lds, g, S, E); }
    SYNC(10);
    }
    if (RUN(11)) shw_compute(p, 2, bx, G, lds, tid, lane, wave);
    if (RUN(11)) for (int rp = 0; rp < NREP(11); ++rp) phase_mlprep(QKV, p.in[21], p.in[22], QKP, CTXQK, lane, wave);
    SYNC(11);
    if (RUN(12)) for (int rp = 0; rp < NREP(12); ++rp) phase_mlscan(QKV, QKP, CTXQK, GATES, SPREV, NPREV, MPREV, lds, tid, lane, wave);
    SYNC(12);
    if (RUN(13)) for (int rp = 0; rp < NREP(13); ++rp) phase_mlout(QKV, QKP, GATES, SPREV, NPREV, MPREV, p.in[24], BUFA, lds, tid, lane, wave);
    SYNC(13);
    if (RUN(14)) { pg8::Gemm g{BUFA, (const bf16*)(ws + WS_W_MLOUT), MLAT, D, D}; pg8::StaticOrder S; S.init(MLAT, D, G, bx); pg8::EpiResid2<true> E{XSB, XSB, GMI + 9216, mod1 + 2048, GM + 2 * 9216, XSA, RSS + 2 * MT};
        pg8::gemm_phase<pg8::EpiResid2<true>, pg8::StaticOrder, true, true>(lds, g, S, E); }
    SYNC(14);
    if (RUN(16)) { pg8::Gemm g{XSA, (const bf16*)(ws + WS_W_GU1), MLAT, 2 * DFF, D}; pg8::StaticOrder S; S.init(MLAT, 2 * DFF, G, bx); pg8::EpiSwiGLU2 E{QKV, DFF, RSS + 2 * MT, SHW + 9 * 5632 + 9 * 3328, 2 * DFF};
        pg8::gemm_phase<pg8::EpiSwiGLU2, pg8::StaticOrder, true, true>(lds, g, S, E); }
    SYNC(16);
    if (RUN(17)) { pg8::Gemm g{QKV, (const bf16*)(ws + WS_W_DN1), MLAT, D, DFF}; pg8::StaticOrder S; S.init(MLAT, D, G, bx); pg8::EpiResid E{XSA, XSA, GMI + 2 * 9216, p.out, mod1 + 5120};
        pg8::gemm_phase<pg8::EpiResid, pg8::StaticOrder, true, true>(lds, g, S, E); }
#undef RUN
#undef SYNC
}

extern "C" void kernel_launch(void* const* d_in, const int* in_sizes, int n_in, void* d_out, int out_size, void* d_ws, size_t ws_size, hipStream_t stream) {
    static int grid = 0;
    if (grid == 0) {
        if (n_in != 26 || out_size != MLAT * D || ws_size < WS_END) { fprintf(stderr, "kernel_launch: unexpected shapes (n_in %d out %d ws %zu)\n", n_in, out_size, ws_size); grid = -1; return; }
        int dev = 0, cus = 0, per_cu = 0;
        hipGetDevice(&dev); hipDeviceGetAttribute(&cus, hipDeviceAttributeMultiprocessorCount, dev);
        hipFuncSetAttribute((const void*)fwd_megakernel, hipFuncAttributeMaxDynamicSharedMemorySize, LDS_BYTES);
        hipOccupancyMaxActiveBlocksPerMultiprocessor(&per_cu, (const void*)fwd_megakernel, NTHR, LDS_BYTES);
        if (per_cu < 1) { fprintf(stderr, "kernel_launch: occupancy query says %d blocks per CU\n", per_cu); per_cu = 1; }
        (void)hipGetLastError();
        grid = cus * per_cu;
    }
    if (grid < 0) return;
    if (hipMemsetAsync((char*)d_ws + WS_BAR, 0, WS_BAR_BYTES, stream) != hipSuccess) { fprintf(stderr, "kernel_launch: memset of barrier words failed\n"); return; }
    Params p{};
    for (int i = 0; i < 26; ++i) p.in[i] = (const float*)d_in[i];
    p.out = (float*)d_out; p.ws = (unsigned char*)d_ws; p.ph_lo = 0; p.ph_hi = 18; p.rep = REPMASK;
    void* args[] = {&p};
    hipError_t e = hipLaunchCooperativeKernel((const void*)fwd_megakernel, dim3(grid), dim3(NTHR), args, LDS_BYTES, stream);
    if (e != hipSuccess) fprintf(stderr, "cooperative launch failed: %s (grid %d)\n", hipGetErrorString(e), grid);
}
```

```cpp
#include <hip/hip_runtime.h>
#include <hip/hip_cooperative_groups.h>
#include <cstdio>
#include <cstdint>
namespace cg = cooperative_groups;
#ifndef REPMASK
#define REPMASK 0
#endif

namespace pg8 {
#define PG8_LAS __attribute__((address_space(3)))
typedef unsigned short bf16_t;
typedef short bf16x8 __attribute__((ext_vector_type(8)));
typedef float f32x4 __attribute__((ext_vector_type(4)));
typedef unsigned u32x4 __attribute__((ext_vector_type(4)));
typedef unsigned u32x2 __attribute__((ext_vector_type(2)));
constexpr int BM = 256, BK = 64, HALF = 128, HTB = HALF * BK * 2  , STAGE_BYTES = 8 * HTB, NXCD = 8, WGM = 4;

__host__ __device__ __forceinline__ int lds_byte(int r, int c) { const int st = (r >> 4) * 2 + (c >> 5), rr = r & 15, cc = c & 31, ob = rr * 64 + cc * 2; return st * 1024 + (ob ^ (((ob >> 9) & 1) << 5)); }
__host__ __device__ __forceinline__ void stage_rc(int b, int& R, int& C) { const int st = b / 1024, sb = b % 1024, swz = sb ^ (((sb >> 9) & 1) << 5); R = (st >> 1) * 16 + swz / 64; C = (st & 1) * 32 + (swz % 64) / 2; }
__host__ __device__ __forceinline__ int perm32(int rho) { const int n = rho >> 4, i = rho & 15; return 8 * (i >> 2) + 4 * n + (i & 3); }

struct Unit { int pm, pn; };
struct Gemm { const bf16_t* A; const bf16_t* Bt; int M, N, K; };

struct StaticOrder {
    int nM, nN, nwg, G, c;
    __host__ __device__ void init(int M, int N, int G_, int c_) { nM = M / BM; nN = N / BM; nwg = nM * nN; G = G_; c = c_; }
    __host__ __device__ bool next(int i, Unit& u) const {
        const long L = (long)i * G + c; if (L >= nwg) return false;
        int wgid = (int)L; { const int q = nwg / NXCD, r = nwg % NXCD, xcd = wgid % NXCD, off = wgid / NXCD; wgid = (xcd < r ? xcd * (q + 1) : r * (q + 1) + (xcd - r) * q) + off; }
        const int nig = WGM * nN, gid = wgid / nig, fm = gid * WGM, gsz = (nM - fm) < WGM ? (nM - fm) : WGM;
        u.pm = fm + ((wgid % nig) % gsz); u.pn = (wgid % nig) / gsz; return true;
    }
    __device__ __forceinline__ void a_ready(const Unit&) const {}
    __device__ __forceinline__ void done(const Unit&) const {}
};


struct OneUnit { int pm, pn, valid;
    __device__ __forceinline__ bool next(int i, Unit& u) const { if (i != 0 || !valid) return false; u.pm = pm; u.pn = pn; return true; }
    __device__ __forceinline__ void a_ready(const Unit&) const {}
    __device__ __forceinline__ void done(const Unit&) const {} };
struct XcdPanels { int x, j, nb, P, PL, pm0, pmx, nN;
    __device__ __forceinline__ bool next(int i, Unit& u) const {
        const int t = i * nb + j; if (j < 0 || t >= P * nN) return false;
        int grp = t / (2 * nN), r = t - grp * 2 * nN; const int gsz = (P - 2 * grp) >= 2 ? 2 : 1;
        const int idx = 2 * grp + (gsz == 2 ? (r & 1) : 0); u.pn = gsz == 2 ? (r >> 1) : r;
        u.pm = idx < PL ? pm0 + x * PL + idx : pmx + x; return true; }
    __device__ __forceinline__ void a_ready(const Unit&) const {}
    __device__ __forceinline__ void done(const Unit&) const {} };

__device__ __forceinline__ unsigned cvt_pk_bf16(float lo, float hi) { unsigned r; asm volatile("v_cvt_pk_bf16_f32 %0, %1, %2" : "=v"(r) : "v"(lo), "v"(hi)); return r; }
__device__ __forceinline__ u32x4 pack8(const f32x4 v0, const f32x4 v1) { u32x4 w; w.x = cvt_pk_bf16(v0[0], v0[1]); w.y = cvt_pk_bf16(v0[2], v0[3]); w.z = cvt_pk_bf16(v1[0], v1[1]); w.w = cvt_pk_bf16(v1[2], v1[3]); return w; }
__device__ __forceinline__ float fast_sigmoid(float x) { return __builtin_amdgcn_rcpf(1.0f + __expf(-x)); }

struct EpiStore {
    static constexpr bool PERM = true, AFTER_DRAIN = false;
    bf16_t* O; int ldc;
    __device__ __forceinline__ void operator()(const f32x4 (&acc)[2][2][4][2], const Unit& u, int wr, int wc, int fr, int fq) const {
        const int row0 = u.pm * BM + wr * 64 + fr, col0 = u.pn * BM + wc * 32 + 8 * fq;
#pragma unroll
        for (int ai = 0; ai < 2; ++ai)
#pragma unroll
            for (int m = 0; m < 4; ++m) { bf16_t* rowp = O + (size_t)(row0 + ai * HALF + m * 16) * ldc + col0;
#pragma unroll
                for (int bj = 0; bj < 2; ++bj) *(u32x4*)(rowp + bj * HALF) = pack8(acc[ai][bj][m][0], acc[ai][bj][m][1]); }
    }
};
struct EpiStoreGLU {
    static constexpr bool PERM = true, AFTER_DRAIN = false;
    bf16_t* O; int ldc;
    __device__ __forceinline__ void operator()(const f32x4 (&acc)[2][2][4][2], const Unit& u, int wr, int wc, int fr, int fq) const {
        const int row0 = u.pm * BM + wr * 64 + fr;
        if (u.pn < 6) {
            const int col0 = u.pn * BM + wc * 32 + 8 * fq;
#pragma unroll
            for (int ai = 0; ai < 2; ++ai)
#pragma unroll
                for (int m = 0; m < 4; ++m) { bf16_t* rowp = O + (size_t)(row0 + ai * HALF + m * 16) * ldc + col0;
#pragma unroll
                    for (int bj = 0; bj < 2; ++bj) *(u32x4*)(rowp + bj * HALF) = pack8(acc[ai][bj][m][0], acc[ai][bj][m][1]); }
        } else {
            const int col0 = 1536 + (u.pn - 6) * HALF + wc * 32 + 8 * fq;
#pragma unroll
            for (int ai = 0; ai < 2; ++ai)
#pragma unroll
                for (int m = 0; m < 4; ++m) { f32x4 o[2];
#pragma unroll
                    for (int n = 0; n < 2; ++n)
#pragma unroll
                        for (int e = 0; e < 4; ++e) o[n][e] = acc[ai][0][m][n][e] * fast_sigmoid(acc[ai][1][m][n][e]);
                    *(u32x4*)(O + (size_t)(row0 + ai * HALF + m * 16) * ldc + col0) = pack8(o[0], o[1]); }
        }
    }
};
struct EpiResid {
    static constexpr bool PERM = true, AFTER_DRAIN = false;
    const bf16_t* res_lat; const bf16_t* res_ctx; const float* rgm; float* out; const float* gate;
    __device__ __forceinline__ void operator()(const f32x4 (&acc)[2][2][4][2], const Unit& u, int wr, int wc, int fr, int fq) const {
        const int base = u.pm * BM; const int bb = base < 32768 ? (base >> 12) : 8; const bf16_t* res = base < 32768 ? res_lat : res_ctx;
        const int row0 = base + wr * 64 + fr, col0 = u.pn * BM + wc * 32 + 8 * fq;
        f32x4 gv[2][2], rgv[2][2];
#pragma unroll
        for (int bj = 0; bj < 2; ++bj)
#pragma unroll
            for (int n = 0; n < 2; ++n) { gv[bj][n] = *(const f32x4*)(gate + (size_t)bb * 6144 + col0 + bj * HALF + 4 * n); rgv[bj][n] = *(const f32x4*)(rgm + (size_t)bb * 1024 + col0 + bj * HALF + 4 * n); }
#pragma unroll
        for (int ai = 0; ai < 2; ++ai)
#pragma unroll
            for (int m = 0; m < 4; ++m) { const size_t ro = (size_t)(row0 + ai * HALF + m * 16) * 1024 + col0;
#pragma unroll
                for (int bj = 0; bj < 2; ++bj)
#pragma unroll
                    for (int n = 0; n < 2; ++n) { const size_t ix = ro + bj * HALF + 4 * n; const u32x2 rw = *(const u32x2*)(res + ix);
                        const f32x4 r = {__builtin_bit_cast(float, rw.x << 16), __builtin_bit_cast(float, rw.x & 0xffff0000u), __builtin_bit_cast(float, rw.y << 16), __builtin_bit_cast(float, rw.y & 0xffff0000u)};
                        *(f32x4*)(out + ix) = r * rgv[bj][n] + gv[bj][n] * acc[ai][bj][m][n]; } }
    }
};
struct EpiSwiGLU {
    static constexpr bool PERM = true, AFTER_DRAIN = false;
    bf16_t* O; int ldc;
    __device__ __forceinline__ void operator()(const f32x4 (&acc)[2][2][4][2], const Unit& u, int wr, int wc, int fr, int fq) const {
        const int row0 = u.pm * BM + wr * 64 + fr, col0 = u.pn * HALF + wc * 32 + 8 * fq;
#pragma unroll
        for (int ai = 0; ai < 2; ++ai)
#pragma unroll
            for (int m = 0; m < 4; ++m) {
                f32x4 o[2];
#pragma unroll
                for (int n = 0; n < 2; ++n)
#pragma unroll
                    for (int e = 0; e < 4; ++e) { const float g = acc[ai][0][m][n][e], up = acc[ai][1][m][n][e]; o[n][e] = g * fast_sigmoid(g) * up; }
                *(u32x4*)(O + (size_t)(row0 + ai * HALF + m * 16) * ldc + col0) = pack8(o[0], o[1]);
            }
    }
};
struct EpiMlIn {
    static constexpr bool PERM = true, AFTER_DRAIN = false;
    bf16_t* O; float* gates; const float* gate_b;
    __device__ __forceinline__ void operator()(const f32x4 (&acc)[2][2][4][2], const Unit& u, int wr, int wc, int fr, int fq) const {
        const int row0 = u.pm * BM + wr * 64 + fr;
        if (u.pn < 12) {
            const int col0 = u.pn * BM + wc * 32 + 8 * fq;
#pragma unroll
            for (int ai = 0; ai < 2; ++ai)
#pragma unroll
                for (int m = 0; m < 4; ++m) { bf16_t* rowp = O + (size_t)(row0 + ai * HALF + m * 16) * 3072 + col0;
#pragma unroll
                    for (int bj = 0; bj < 2; ++bj) *(u32x4*)(rowp + bj * HALF) = pack8(acc[ai][bj][m][0], acc[ai][bj][m][1]); }
        } else if (wc == 0) {
            const int col0 = 8 * fq;
#pragma unroll
            for (int ai = 0; ai < 2; ++ai)
#pragma unroll
                for (int m = 0; m < 4; ++m)
#pragma unroll
                    for (int n = 0; n < 2; ++n) { f32x4 v = acc[ai][0][m][n] + *(const f32x4*)(gate_b + col0 + 4 * n);
                        if (col0 >= 16) {
#pragma unroll
                            for (int e = 0; e < 4; ++e) { const float x = v[e]; v[e] = fminf(x, 0.f) - log1pf(__expf(-fabsf(x))); } }
                        *(f32x4*)(gates + (size_t)(row0 + ai * HALF + m * 16) * 32 + col0 + 4 * n) = v; }
        }
    }
};


template <bool RES_SCALED> struct EpiResid2 {
    static constexpr bool PERM = true, AFTER_DRAIN = false;
    const void* res_lat; const void* res_ctx; const float* rgm; const float* gate; const float* gm; bf16_t* A2; float* rss;
    __device__ __forceinline__ void operator()(const f32x4 (&acc)[2][2][4][2], const Unit& u, int wr, int wc, int fr, int fq) const {
        const int base = u.pm * BM; const int bb = base < 32768 ? (base >> 12) : 8; const void* res = base < 32768 ? res_lat : res_ctx;
        const int row0 = base + wr * 64 + fr, col0 = u.pn * BM + wc * 32 + 8 * fq;
        f32x4 gv[2][2], gmv[2][2], rgv[2][2];
#pragma unroll
        for (int bj = 0; bj < 2; ++bj)
#pragma unroll
            for (int n = 0; n < 2; ++n) { gv[bj][n] = *(const f32x4*)(gate + (size_t)bb * 6144 + col0 + bj * HALF + 4 * n); gmv[bj][n] = *(const f32x4*)(gm + (size_t)bb * 1024 + col0 + bj * HALF + 4 * n);
                if constexpr (RES_SCALED) rgv[bj][n] = *(const f32x4*)(rgm + (size_t)bb * 1024 + col0 + bj * HALF + 4 * n); else rgv[bj][n] = (f32x4){1.f, 1.f, 1.f, 1.f}; }
#pragma unroll
        for (int ai = 0; ai < 2; ++ai)
#pragma unroll
            for (int m = 0; m < 4; ++m) { const int row = row0 + ai * HALF + m * 16; const size_t ro = (size_t)row * 1024 + col0; float ss = 0.f;
#pragma unroll
                for (int bj = 0; bj < 2; ++bj) { f32x4 r[2];
                    if constexpr (RES_SCALED) { const u32x4 rw = *(const u32x4*)((const bf16_t*)res + ro + bj * HALF);
                        r[0] = (f32x4){__builtin_bit_cast(float, rw.x << 16), __builtin_bit_cast(float, rw.x & 0xffff0000u), __builtin_bit_cast(float, rw.y << 16), __builtin_bit_cast(float, rw.y & 0xffff0000u)} * rgv[bj][0];
                        r[1] = (f32x4){__builtin_bit_cast(float, rw.z << 16), __builtin_bit_cast(float, rw.z & 0xffff0000u), __builtin_bit_cast(float, rw.w << 16), __builtin_bit_cast(float, rw.w & 0xffff0000u)} * rgv[bj][1]; }
                    else { r[0] = *(const f32x4*)((const float*)res + ro + bj * HALF); r[1] = *(const f32x4*)((const float*)res + ro + bj * HALF + 4); }
                    f32x4 o[2];
#pragma unroll
                    for (int n = 0; n < 2; ++n) { o[n] = r[n] + gv[bj][n] * acc[ai][bj][m][n]; ss += (o[n][0] * o[n][0] + o[n][1] * o[n][1]) + (o[n][2] * o[n][2] + o[n][3] * o[n][3]); }
                    *(u32x4*)(A2 + ro + bj * HALF) = pack8(o[0] * gmv[bj][0], o[1] * gmv[bj][1]); }
                ss += __shfl_xor(ss, 16); ss += __shfl_xor(ss, 32);
                if (fq == 0) (void)__hip_atomic_fetch_add(rss + row, ss, __ATOMIC_RELAXED, __HIP_MEMORY_SCOPE_AGENT); }
    }
};
struct EpiSwiGLU2 {
    static constexpr bool PERM = true, AFTER_DRAIN = false;
    bf16_t* O; int ldc; const float* rss; const float* shw; int ldn;
    __device__ __forceinline__ void operator()(const f32x4 (&acc)[2][2][4][2], const Unit& u, int wr, int wc, int fr, int fq) const {
        const int base = u.pm * BM; const int bb = base < 32768 ? (base >> 12) : 8;
        const int row0 = base + wr * 64 + fr, col0 = u.pn * HALF + wc * 32 + 8 * fq, bcol0 = u.pn * BM + wc * 32 + 8 * fq;
        f32x4 sg[2], su[2];
#pragma unroll
        for (int n = 0; n < 2; ++n) { sg[n] = *(const f32x4*)(shw + (size_t)bb * ldn + bcol0 + 4 * n); su[n] = *(const f32x4*)(shw + (size_t)bb * ldn + bcol0 + HALF + 4 * n); }
#pragma unroll
        for (int ai = 0; ai < 2; ++ai)
#pragma unroll
            for (int m = 0; m < 4; ++m) { const int row = row0 + ai * HALF + m * 16; const float rstd = rsqrtf(rss[row] * (1.f / 1024.f) + 1e-6f);
                f32x4 o[2];
#pragma unroll
                for (int n = 0; n < 2; ++n)
#pragma unroll
                    for (int e = 0; e < 4; ++e) { const float g = acc[ai][0][m][n][e] * rstd + sg[n][e], up = acc[ai][1][m][n][e] * rstd + su[n][e]; o[n][e] = g * fast_sigmoid(g) * up; }
                *(u32x4*)(O + (size_t)row * ldc + col0) = pack8(o[0], o[1]);
            }
    }
};
struct EpiMlIn2 {
    static constexpr bool PERM = true, AFTER_DRAIN = false;
    bf16_t* O; float* gates; const float* gate_b; const float* rss; const float* shw;
    __device__ __forceinline__ void operator()(const f32x4 (&acc)[2][2][4][2], const Unit& u, int wr, int wc, int fr, int fq) const {
        const int base = u.pm * BM; const int bb = base < 32768 ? (base >> 12) : 8;
        const int row0 = base + wr * 64 + fr;
        if (u.pn < 12) {
            const int col0 = u.pn * BM + wc * 32 + 8 * fq;
            f32x4 sv[2][2];
#pragma unroll
            for (int bj = 0; bj < 2; ++bj)
#pragma unroll
                for (int n = 0; n < 2; ++n) sv[bj][n] = *(const f32x4*)(shw + (size_t)bb * 3328 + col0 + bj * HALF + 4 * n);
#pragma unroll
            for (int ai = 0; ai < 2; ++ai)
#pragma unroll
                for (int m = 0; m < 4; ++m) { const int row = row0 + ai * HALF + m * 16; const float rstd = rsqrtf(rss[row] * (1.f / 1024.f) + 1e-6f); bf16_t* rowp = O + (size_t)row * 3072 + col0;
#pragma unroll
                    for (int bj = 0; bj < 2; ++bj) *(u32x4*)(rowp + bj * HALF) = pack8(acc[ai][bj][m][0] * rstd + sv[bj][0], acc[ai][bj][m][1] * rstd + sv[bj][1]); }
        } else if (wc == 0) {
            const int col0 = 8 * fq;
#pragma unroll
            for (int ai = 0; ai < 2; ++ai)
#pragma unroll
                for (int m = 0; m < 4; ++m) { const int row = row0 + ai * HALF + m * 16; const float rstd = rsqrtf(rss[row] * (1.f / 1024.f) + 1e-6f);
#pragma unroll
                    for (int n = 0; n < 2; ++n) { f32x4 v = acc[ai][0][m][n] * rstd + *(const f32x4*)(shw + (size_t)bb * 3328 + 3072 + col0 + 4 * n) + *(const f32x4*)(gate_b + col0 + 4 * n);
                        if (col0 >= 16) {
#pragma unroll
                            for (int e = 0; e < 4; ++e) { const float x = v[e]; v[e] = fminf(x, 0.f) - log1pf(__expf(-fabsf(x))); } }
                        *(f32x4*)(gates + (size_t)row * 32 + col0 + 4 * n) = v; } }
        }
    }
};

template <class Epi, class Sched, bool ALIGN_EPI = false, bool SP2 = false>
__device__ __forceinline__ void gemm_phase(PG8_LAS unsigned char* lds, const Gemm g, const Sched& S, const Epi& E) {
    const int tid = threadIdx.x, wid = __builtin_amdgcn_readfirstlane(tid >> 6), lane = tid & 63, wr = wid >> 2, wc = wid & 3, fr = lane & 15, fq = lane >> 4;
    const int K = g.K, nt = K / BK;
    unsigned voffA[2], voffB[2];
#pragma unroll
    for (int i = 0; i < 2; ++i) { int R, C; stage_rc(tid * 16 + i * 8192, R, C); const int Rb = Epi::PERM ? ((R & ~31) + perm32(R & 31)) : R;
        voffA[i] = (unsigned)(R * K + C) * 2u; voffB[i] = (unsigned)(Rb * K + C) * 2u; }
    const size_t kstep = (size_t)(BK * 2);
    const size_t hstep = (size_t)HALF * K * 2;
    const size_t tstep = 2 * hstep;
    const unsigned ldsw = (unsigned)wid * 1024u;
    const int aoff = lds_byte(wr * 64 + fr, fq * 8), boff = lds_byte(wc * 32 + fr, fq * 8);
#define PG8_SA(b, h) (((b) * 2 + (h)) * HTB)
#define PG8_SB(b, h) ((4 + (b) * 2 + (h)) * HTB)
#define PG8_STAGE(bufoff, gbase, voff) do { _Pragma("unroll") for (int _i = 0; _i < 2; ++_i) \
        __builtin_amdgcn_global_load_lds((const unsigned*)((const char*)(gbase) + (voff)[_i]), (PG8_LAS unsigned*)(lds + (bufoff) + ldsw + _i * 8192), 16, 0, 0); } while (0)
#define PG8_LDA(dst, b, h) do { _Pragma("unroll") for (int m = 0; m < 4; ++m) _Pragma("unroll") for (int k = 0; k < 2; ++k) dst[m][k] = *(const PG8_LAS bf16x8*)(lds + PG8_SA(b, h) + aoff + m * 2048 + k * 1024); } while (0)
#define PG8_LDB(dst, b, h) do { _Pragma("unroll") for (int n = 0; n < 2; ++n) _Pragma("unroll") for (int k = 0; k < 2; ++k) dst[n][k] = *(const PG8_LAS bf16x8*)(lds + PG8_SB(b, h) + boff + n * 2048 + k * 1024); } while (0)
#define PG8_MMA(ai, bj, At, Bt) do { __builtin_amdgcn_s_setprio(1); _Pragma("unroll") for (int m = 0; m < 4; ++m) _Pragma("unroll") for (int n = 0; n < 2; ++n) _Pragma("unroll") for (int k = 0; k < 2; ++k) \
        acc[ai][bj][m][n] = __builtin_amdgcn_mfma_f32_16x16x32_bf16(Bt[n][k], At[m][k], acc[ai][bj][m][n], 0, 0, 0); __builtin_amdgcn_s_setprio(0); } while (0)
#define PG8_WAIT_V(n) asm volatile("s_waitcnt vmcnt(" #n ")" ::: "memory")
#define PG8_WAIT_L(n) asm volatile("s_waitcnt lgkmcnt(" #n ")" ::: "memory")
#define PG8_BAR __builtin_amdgcn_s_barrier()
#define PG8_SCHED __builtin_amdgcn_sched_barrier(0)
    Unit cur, nxt; int ui = 0;
    if (!S.next(0, cur)) return;
    f32x4 acc[2][2][4][2];
#pragma unroll
    for (int a = 0; a < 2; ++a)
#pragma unroll
        for (int b = 0; b < 2; ++b)
#pragma unroll
            for (int m = 0; m < 4; ++m)
#pragma unroll
                for (int n = 0; n < 2; ++n) acc[a][b][m][n] = (f32x4){0.f, 0.f, 0.f, 0.f};
    bf16x8 At[4][2], B0[2][2], B1[2][2];
    const char* cA = (const char*)g.A + (size_t)cur.pm * tstep; const char* cB = (const char*)g.Bt + (size_t)cur.pn * tstep;
    S.a_ready(cur);
    if constexpr (SP2) {
        PG8_STAGE(PG8_SB(0, 0), cB, voffB); PG8_STAGE(PG8_SB(0, 1), cB + hstep, voffB); PG8_STAGE(PG8_SA(0, 0), cA, voffA); PG8_STAGE(PG8_SA(0, 1), cA + hstep, voffA);
        if (wr == 1) PG8_BAR;
        PG8_WAIT_V(2); PG8_BAR;
        PG8_STAGE(PG8_SB(1, 0), cB + kstep, voffB); PG8_STAGE(PG8_SA(1, 0), cA + kstep, voffA); PG8_STAGE(PG8_SB(1, 1), cB + hstep + kstep, voffB);
        PG8_WAIT_V(6); PG8_BAR;
    } else {
        PG8_STAGE(PG8_SB(0, 0), cB, voffB); PG8_STAGE(PG8_SA(0, 0), cA, voffA); PG8_STAGE(PG8_SB(0, 1), cB + hstep, voffB); PG8_STAGE(PG8_SA(0, 1), cA + hstep, voffA);
        if (wr == 1) PG8_BAR;
        PG8_WAIT_V(4); PG8_BAR;
        PG8_STAGE(PG8_SB(1, 0), cB + kstep, voffB); PG8_STAGE(PG8_SA(1, 0), cA + kstep, voffA); PG8_STAGE(PG8_SB(1, 1), cB + hstep + kstep, voffB);
        PG8_WAIT_V(6); PG8_BAR;
    }
    for (;;) {
        const bool has_next = S.next(ui + 1, nxt);
        const char* nA = has_next ? (const char*)g.A + (size_t)nxt.pm * tstep : cA; const char* nB = has_next ? (const char*)g.Bt + (size_t)nxt.pn * tstep : cB;
        for (int t = 0; t < nt; t += 2) {
            const bool last = (t == nt - 2);
            const char* a1 = cA + (size_t)(t + 1) * kstep;
            const char* a2 = last ? nA : cA + (size_t)(t + 2) * kstep; const char* b2 = last ? nB : cB + (size_t)(t + 2) * kstep;
            const char* a3 = a2 + kstep; const char* b3 = b2 + kstep;
            if (last && has_next) S.a_ready(nxt);
            if constexpr (SP2) {
            PG8_LDB(B0, 0, 0); PG8_LDB(B1, 0, 1); PG8_SCHED; PG8_LDA(At, 0, 0); PG8_STAGE(PG8_SA(1, 1), a1 + hstep, voffA);
            PG8_WAIT_V(8); PG8_WAIT_L(0); PG8_BAR; PG8_MMA(0, 0, At, B0); PG8_MMA(0, 1, At, B1); PG8_BAR; PG8_SCHED;
            PG8_LDA(At, 0, 1); PG8_STAGE(PG8_SB(0, 0), b2, voffB); PG8_STAGE(PG8_SB(0, 1), b2 + hstep, voffB); PG8_STAGE(PG8_SA(0, 0), a2, voffA);
            PG8_WAIT_V(8); PG8_WAIT_L(0); PG8_BAR; PG8_MMA(1, 0, At, B0); PG8_MMA(1, 1, At, B1); PG8_BAR; PG8_SCHED;
            PG8_LDB(B0, 1, 0); PG8_LDB(B1, 1, 1); PG8_SCHED; PG8_LDA(At, 1, 0); PG8_STAGE(PG8_SA(0, 1), a2 + hstep, voffA);
            PG8_WAIT_V(8); PG8_WAIT_L(0); PG8_BAR; PG8_MMA(0, 0, At, B0); PG8_MMA(0, 1, At, B1); PG8_BAR; PG8_SCHED;
            PG8_LDA(At, 1, 1); PG8_STAGE(PG8_SB(1, 0), b3, voffB); PG8_STAGE(PG8_SB(1, 1), b3 + hstep, voffB); PG8_STAGE(PG8_SA(1, 0), a3, voffA);
            PG8_WAIT_V(8); PG8_WAIT_L(0); PG8_BAR; PG8_MMA(1, 0, At, B0); PG8_MMA(1, 1, At, B1); PG8_BAR; PG8_SCHED;
            } else {
            PG8_LDB(B0, 0, 0); PG8_SCHED; PG8_LDA(At, 0, 0); PG8_STAGE(PG8_SA(1, 1), a1 + hstep, voffA);
            PG8_WAIT_L(8); PG8_BAR; PG8_WAIT_L(0); PG8_MMA(0, 0, At, B0); PG8_BAR; PG8_SCHED;
            PG8_LDB(B1, 0, 1); PG8_STAGE(PG8_SB(0, 0), b2, voffB);
            PG8_BAR; PG8_WAIT_L(0); PG8_MMA(0, 1, At, B1); PG8_BAR;
            PG8_LDA(At, 0, 1); PG8_STAGE(PG8_SA(0, 0), a2, voffA);
            PG8_BAR; PG8_WAIT_L(0); PG8_MMA(1, 0, At, B0); PG8_BAR; PG8_SCHED;
            PG8_STAGE(PG8_SB(0, 1), b2 + hstep, voffB);
            PG8_WAIT_V(6); PG8_BAR; PG8_MMA(1, 1, At, B1); PG8_BAR;
            PG8_LDB(B0, 1, 0); PG8_SCHED; PG8_LDA(At, 1, 0); PG8_STAGE(PG8_SA(0, 1), a2 + hstep, voffA);
            PG8_WAIT_L(8); PG8_BAR; PG8_WAIT_L(0); PG8_MMA(0, 0, At, B0); PG8_BAR; PG8_SCHED;
            PG8_LDB(B1, 1, 1); PG8_STAGE(PG8_SB(1, 0), b3, voffB);
            PG8_BAR; PG8_WAIT_L(0); PG8_MMA(0, 1, At, B1); PG8_BAR;
            PG8_LDA(At, 1, 1); PG8_STAGE(PG8_SA(1, 0), a3, voffA);
            PG8_BAR; PG8_WAIT_L(0); PG8_MMA(1, 0, At, B0); PG8_BAR; PG8_SCHED;
            PG8_STAGE(PG8_SB(1, 1), b3 + hstep, voffB);
            PG8_WAIT_V(6); PG8_BAR; PG8_MMA(1, 1, At, B1); PG8_BAR;
            }
        }
        if constexpr (ALIGN_EPI) { if (wr == 0) PG8_BAR; }
        if constexpr (!Epi::AFTER_DRAIN) { E(acc, cur, wr, wc, fr, fq); S.done(cur); }
        if (!has_next) break;
#pragma unroll
        for (int a = 0; a < 2; ++a)
#pragma unroll
            for (int b = 0; b < 2; ++b)
#pragma unroll
                for (int m = 0; m < 4; ++m)
#pragma unroll
                    for (int n = 0; n < 2; ++n) acc[a][b][m][n] = (f32x4){0.f, 0.f, 0.f, 0.f};
        cur = nxt; cA = nA; cB = nB; ++ui;
        if constexpr (ALIGN_EPI) { if (wr == 1) PG8_BAR; }
    }
    PG8_WAIT_V(0);
    if constexpr (!ALIGN_EPI) { if (wr == 0) PG8_BAR; }
    PG8_BAR;
    if constexpr (Epi::AFTER_DRAIN) { E.fused(acc, cur, wr, wc, fr, fq, lds, wid, lane); S.done(cur); }
#undef PG8_SA
#undef PG8_SB
#undef PG8_STAGE
#undef PG8_LDA
#undef PG8_LDB
#undef PG8_MMA
#undef PG8_WAIT_V
#undef PG8_WAIT_L
#undef PG8_BAR
#undef PG8_SCHED
}
}

constexpr int D = 1024, NB = 8, TL = 4096, NCTX = 256, MLAT = NB * TL, MCTX = NB * NCTX, MT = MLAT + MCTX;
constexpr int DFF = 2816, NAB = 2560, NML = 3104, NMLP = 3328, LDQ0 = 2048, LDQ1 = 3072;
constexpr int NTHR = 512, NWAVES = 8;
constexpr float EPS = 1e-6f;
constexpr size_t MiB = 1u << 20;
constexpr size_t WS_MOD = 0;
constexpr size_t WS_W_ABIN = 1 * MiB, WS_W_ABOUT = 6 * MiB, WS_W_GU0 = 8 * MiB, WS_W_GU1 = 19 * MiB, WS_W_DN0 = 30 * MiB, WS_W_DN1 = 36 * MiB, WS_W_MLIN = 42 * MiB, WS_W_MLOUT = 49 * MiB;
constexpr size_t WS_BUFA = 52 * MiB;
constexpr size_t WS_XS = 120 * MiB;
constexpr size_t WS_QKV = 256 * MiB;
constexpr size_t WS_GATES = 460 * MiB;
constexpr size_t WS_CTXQK = 466 * MiB;
constexpr size_t WS_NPREV = 471 * MiB;
constexpr size_t WS_MPREV = 473 * MiB;
constexpr size_t WS_RSS = 474 * MiB;
constexpr size_t WS_SHW = 475 * MiB;
constexpr size_t WS_GM = 476 * MiB;
constexpr size_t WS_END = 477 * MiB;
constexpr size_t WS_BAR = 512 * 1024;
constexpr size_t WS_BAR_BYTES = 16384;
constexpr int LDS_BYTES = 147456;
constexpr int LDS_XB_OFF = 131072 + 256;

#define LAS __attribute__((address_space(3)))
typedef unsigned short bf16;
typedef short bf16x8 __attribute__((ext_vector_type(8)));
typedef short s16x4 __attribute__((ext_vector_type(4)));
typedef float f32x4 __attribute__((ext_vector_type(4)));
typedef unsigned u32x4 __attribute__((ext_vector_type(4)));
typedef unsigned u32x2 __attribute__((ext_vector_type(2)));

__device__ __forceinline__ float bf2f(unsigned h) { return __builtin_bit_cast(float, h << 16); }
__device__ __forceinline__ float bflo(unsigned w) { return __builtin_bit_cast(float, w << 16); }
__device__ __forceinline__ float bfhi(unsigned w) { return __builtin_bit_cast(float, w & 0xffff0000u); }
__device__ __forceinline__ unsigned f2bf(float f) { unsigned u = __builtin_bit_cast(unsigned, f); return (u + 0x7fffu + ((u >> 16) & 1u)) >> 16; }
typedef float f32x2_t __attribute__((ext_vector_type(2))); typedef __bf16 bf16x2_t __attribute__((ext_vector_type(2)));
__device__ __forceinline__ unsigned pk2(float lo, float hi) { const f32x2_t v = {lo, hi}; const bf16x2_t b = __builtin_convertvector(v, bf16x2_t); return __builtin_bit_cast(unsigned, b); }
__device__ __forceinline__ float wave_sum(float v) {
#pragma unroll
    for (int o = 1; o < 64; o <<= 1) v += __shfl_xor(v, o);
    return v;
}
__device__ __forceinline__ float wave_max(float v) {
#pragma unroll
    for (int o = 1; o < 64; o <<= 1) v = fmaxf(v, __shfl_xor(v, o));
    return v;
}
__device__ __forceinline__ float fast_sig(float x) { return __builtin_amdgcn_rcpf(1.0f + __expf(-x)); }
__device__ __forceinline__ float silu_f(float x) { return x * __builtin_amdgcn_rcpf(1.0f + __expf(-x)); }
__device__ __forceinline__ void unpack8(const u32x4 w, float (&f)[8]) { f[0] = bflo(w.x); f[1] = bfhi(w.x); f[2] = bflo(w.y); f[3] = bfhi(w.y); f[4] = bflo(w.z); f[5] = bfhi(w.z); f[6] = bflo(w.w); f[7] = bfhi(w.w); }
__device__ __forceinline__ u32x4 pack8f(const float (&f)[8]) { u32x4 w; w.x = pk2(f[0], f[1]); w.y = pk2(f[2], f[3]); w.z = pk2(f[4], f[5]); w.w = pk2(f[6], f[7]); return w; }
typedef short v4i16_t __attribute__((ext_vector_type(4)));
__device__ __forceinline__ s16x4 trread(const LAS char* p) { return __builtin_bit_cast(s16x4, __builtin_amdgcn_ds_read_tr16_b64_v4i16((LAS v4i16_t*)p)); }
__device__ __forceinline__ bf16x8 cat44(const s16x4 a, const s16x4 b) { bf16x8 r; r[0] = a[0]; r[1] = a[1]; r[2] = a[2]; r[3] = a[3]; r[4] = b[0]; r[5] = b[1]; r[6] = b[2]; r[7] = b[3]; return r; }
#define MFMA16(a, b, c) __builtin_amdgcn_mfma_f32_16x16x32_bf16((a), (b), (c), 0, 0, 0)

struct Params {
    const float* in[26]; float* out; unsigned char* ws; int ph_lo, ph_hi; int rep, pad;
};

__device__ __forceinline__ void transpose_matrix(const float* W, int K, int N, bf16* WT, int kind, LAS float* scr, int gw, int NGW, int lane, int& start) {
    const int nblk = N / 32, items = nblk * (K / 64);
    int first = gw - start; if (first < 0) first += NGW;
    for (int it = first; it < items; it += NGW) {
        const int kb = it / nblk, nb = it % nblk, k0 = 64 * kb, n0 = 32 * nb;
        { const int kr = lane >> 3, nc = lane & 7; f32x4 v[8];
#pragma unroll
          for (int i = 0; i < 8; ++i) v[i] = *(const f32x4*)(W + (size_t)(k0 + 8 * i + kr) * N + n0 + 4 * nc);
#pragma unroll
          for (int i = 0; i < 8; ++i) { LAS float* sp = scr + (8 * i + kr) * 33 + 4 * nc; sp[0] = v[i][0]; sp[1] = v[i][1]; sp[2] = v[i][2]; sp[3] = v[i][3]; } }
        asm volatile("s_waitcnt lgkmcnt(0)" ::: "memory");
        const int drow0 = kind == 0 ? n0 : (kind == 3 ? (n0 < 1536 ? n0 : (n0 < 2048 ? 1536 + ((n0 - 1536) >> 7) * 256 + ((n0 - 1536) & 127) : 1536 + ((n0 - 2048) >> 7) * 256 + 128 + ((n0 - 2048) & 127)))
                                                  : ((n0 >> 7) * 256 + (kind == 2 ? 128 : 0) + (n0 & 127)));
        const int c = lane & 7;
#pragma unroll
        for (int j = 0; j < 4; ++j) { const int n = (lane >> 3) + 8 * j; const LAS float* s = scr + (8 * c) * 33 + n;
            u32x4 o; o.x = pk2(s[0 * 33], s[1 * 33]); o.y = pk2(s[2 * 33], s[3 * 33]); o.z = pk2(s[4 * 33], s[5 * 33]); o.w = pk2(s[6 * 33], s[7 * 33]);
            *(u32x4*)(WT + (size_t)(drow0 + n) * K + k0 + 8 * c) = o; }
        asm volatile("s_waitcnt lgkmcnt(0)" ::: "memory");
    }
    start = (start + items) % NGW;
}

__device__ __forceinline__ void phase_prologue(const Params& p, LAS unsigned char* lds, int tid, int lane, int wave) {
    unsigned char* ws = p.ws;
    const int gw = blockIdx.x * NWAVES + wave, NGW = gridDim.x * NWAVES;
    LAS float* scr = (LAS float*)(lds + wave * 8704);
    int start = 0;
    transpose_matrix(p.in[11], D, NAB, (bf16*)(ws + WS_W_ABIN), 3, scr, gw, NGW, lane, start);
    __syncthreads();
    LAS float* sv = (LAS float*)lds;
    LAS float* part = (LAS float*)(lds + 40960);
    for (int i = tid; i < 9 * 1024; i += NTHR) { const float c = i < 8192 ? p.in[1][i] : p.in[3][i - 8192]; sv[i] = silu_f(c); }
    __syncthreads();
    float* mod = (float*)(ws + WS_MOD);
    for (int item = blockIdx.x; item < 192; item += gridDim.x) {
        const int l = item / 96, cgp = item % 96, col = cgp * 64 + lane;
        const float* W = p.in[4] + (size_t)l * D * 6144 + col;
        float a[9];
#pragma unroll
        for (int b = 0; b < 9; ++b) a[b] = 0.f;
#pragma unroll 16
        for (int k = wave * 128; k < wave * 128 + 128; ++k) { const float wv = W[(size_t)k * 6144];
#pragma unroll
            for (int b = 0; b < 9; ++b) a[b] += sv[b * 1024 + k] * wv; }
#pragma unroll
        for (int b = 0; b < 9; ++b) part[(wave * 9 + b) * 64 + lane] = a[b];
        __syncthreads();
        for (int i = tid; i < 576; i += NTHR) { const int b = i >> 6, ln = i & 63; float s = 0.f;
#pragma unroll
            for (int w = 0; w < 8; ++w) s += part[(w * 9 + b) * 64 + ln];
            mod[(size_t)(l * 9 + b) * 6144 + cgp * 64 + ln] = s + p.in[5][l * 6144 + cgp * 64 + ln]; }
        __syncthreads();
    }
}


__device__ __forceinline__ void phase_aux(const Params& p, LAS unsigned char* lds, int tid, int lane, int wave) {
    unsigned char* ws = p.ws; const float* mod = (const float*)(ws + WS_MOD);
    const int gt = blockIdx.x * NTHR + tid, NGT = gridDim.x * NTHR;
    const int gw = blockIdx.x * NWAVES + wave, NGW = gridDim.x * NWAVES;
    float* rss = (float*)(ws + WS_RSS); for (int i = gt; i < 3 * MT; i += NGT) rss[i] = 0.f;
    float* gm = (float*)(ws + WS_GM);
    for (int i = gt; i < 3 * 9 * 1024; i += NGT) { const int s = i / 9216, r = i % 9216, bb = r >> 10, k = r & 1023;
        const float* ng = s == 1 ? p.in[6] + D : (s == 0 ? p.in[7] : p.in[7] + D); const int l = s == 0 ? 0 : 1; const int sc_off = s == 1 ? 1024 : 4096;
        const float gmv_ = ng[k] * (1.0f + mod[(size_t)(l * 9 + bb) * 6144 + sc_off + k]); gm[i] = gmv_; gm[3 * 9216 + i] = fabsf(gmv_) > 1e-30f ? 1.0f / gmv_ : 0.f; }
    __syncthreads();
}
__device__ __forceinline__ void shw_compute(const Params& p, int s, int rank, int nblk, LAS unsigned char* lds, int tid, int lane, int wave) {
    unsigned char* ws = p.ws; const float* mod = (const float*)(ws + WS_MOD);
    const int gw = rank * NWAVES + wave, NGW = nblk * NWAVES;
    LAS float* shl = (LAS float*)lds;
    float* shw = (float*)(ws + WS_SHW);
    const int l = s == 0 ? 0 : 1, sh_off = s == 1 ? 0 : 3072, N = s == 1 ? NMLP : 2 * DFF;
    const bf16* Wt = (const bf16*)(ws + (s == 0 ? WS_W_GU0 : (s == 1 ? WS_W_MLIN : WS_W_GU1)));
    float* dst = shw + (s == 0 ? 0 : (s == 1 ? 9 * 5632 : 9 * 5632 + 9 * 3328));
    __syncthreads();
    for (int i = tid; i < 9 * 1024; i += NTHR) shl[i] = mod[(size_t)(l * 9 + (i >> 10)) * 6144 + sh_off + (i & 1023)];
    __syncthreads();
    for (int n = gw; n < N; n += NGW) {
        float w[16]; { const u32x4* wp = (const u32x4*)(Wt + (size_t)n * D + lane * 16); float t8[8]; unpack8(wp[0], t8);
#pragma unroll
            for (int e = 0; e < 8; ++e) w[e] = t8[e];
            unpack8(wp[1], t8);
#pragma unroll
            for (int e = 0; e < 8; ++e) w[8 + e] = t8[e]; }
        float res = 0.f;
#pragma unroll
        for (int bb = 0; bb < 9; ++bb) { float a = 0.f; const LAS f32x4* sp = (const LAS f32x4*)(shl + bb * 1024 + lane * 16);
#pragma unroll
            for (int j = 0; j < 4; ++j) { const f32x4 sv = sp[j]; a += (w[4 * j] * sv[0] + w[4 * j + 1] * sv[1]) + (w[4 * j + 2] * sv[2] + w[4 * j + 3] * sv[3]); }
            a = wave_sum(a); if (lane == bb) res = a; }
        if (lane < 9) dst[(size_t)lane * N + n] = res;
    }
    __syncthreads();
}
__device__ __forceinline__ void side_weights(const Params& p, int set, int rank, int nblk, LAS unsigned char* lds, int tid, int lane, int wave) {
    unsigned char* ws = p.ws;
    const int gw = rank * NWAVES + wave, NGW = nblk * NWAVES;
    LAS float* scr = (LAS float*)(lds + wave * 8704);
    int start = 0;
    if (set == 0) {
        transpose_matrix(p.in[19], D, D, (bf16*)(ws + WS_W_ABOUT), 0, scr, gw, NGW, lane, start);
        transpose_matrix(p.in[8], D, DFF, (bf16*)(ws + WS_W_GU0), 1, scr, gw, NGW, lane, start);
        transpose_matrix(p.in[9], D, DFF, (bf16*)(ws + WS_W_GU0), 2, scr, gw, NGW, lane, start);
    } else if (set == 1) {
        transpose_matrix(p.in[10], DFF, D, (bf16*)(ws + WS_W_DN0), 0, scr, gw, NGW, lane, start);
        transpose_matrix(p.in[20], D, NML, (bf16*)(ws + WS_W_MLIN), 0, scr, gw, NGW, lane, start);
        u32x4* z = (u32x4*)(ws + WS_W_MLIN + (size_t)NML * D * 2); const int n16 = (NMLP - NML) * D * 2 / 16;
        for (int i = rank * NTHR + tid; i < n16; i += nblk * NTHR) z[i] = (u32x4){0u, 0u, 0u, 0u};
    } else {
        transpose_matrix(p.in[25], D, D, (bf16*)(ws + WS_W_MLOUT), 0, scr, gw, NGW, lane, start);
        transpose_matrix(p.in[8] + (size_t)D * DFF, D, DFF, (bf16*)(ws + WS_W_GU1), 1, scr, gw, NGW, lane, start);
        transpose_matrix(p.in[9] + (size_t)D * DFF, D, DFF, (bf16*)(ws + WS_W_GU1), 2, scr, gw, NGW, lane, start);
        transpose_matrix(p.in[10] + (size_t)DFF * D, DFF, D, (bf16*)(ws + WS_W_DN1), 0, scr, gw, NGW, lane, start);
    }
    __syncthreads();
}

__device__ __forceinline__ void phase_norm(const float* __restrict__ src_lat, const float* __restrict__ src_ctx, const float* __restrict__ g, const float* __restrict__ modl, int sh_off, int sc_off, int Mrows, bf16* __restrict__ H, int lane, int wave) {
    const int gw = blockIdx.x * NWAVES + wave, NGW = gridDim.x * NWAVES;
    f32x4 gv[4];
#pragma unroll
    for (int j = 0; j < 4; ++j) gv[j] = ((const f32x4*)g)[lane + 64 * j];
#pragma unroll 2
    for (int row = gw; row < Mrows; row += NGW) {
        const float* src = row < MLAT ? src_lat : src_ctx; const int bb = row < MLAT ? (row >> 12) : 8;
        const f32x4* xr = (const f32x4*)(src + (size_t)row * D) + lane;
        f32x4 v[4]; float ss = 0.f;
#pragma unroll
        for (int j = 0; j < 4; ++j) { v[j] = xr[64 * j]; ss += (v[j].x * v[j].x + v[j].y * v[j].y) + (v[j].z * v[j].z + v[j].w * v[j].w); }
        const float rstd = rsqrtf(wave_sum(ss) * (1.f / D) + EPS);
        const f32x4* sc = (const f32x4*)(modl + (size_t)bb * 6144 + sc_off) + lane; const f32x4* sh = (const f32x4*)(modl + (size_t)bb * 6144 + sh_off) + lane;
        u32x2* o = (u32x2*)(H + (size_t)row * D) + lane;
#pragma unroll
        for (int j = 0; j < 4; ++j) { const f32x4 y = v[j] * rstd * gv[j] * (sc[64 * j] + 1.0f) + sh[64 * j]; u32x2 w; w.x = pk2(y.x, y.y); w.y = pk2(y.z, y.w); o[64 * j] = w; }
    }
}

__device__ __forceinline__ void phase_qknorm(bf16* QKV, const float* qg, const float* kg, int lane, int wave) {
    const int gw = blockIdx.x * NWAVES + wave, NGW = gridDim.x * NWAVES;
    float gq[8], gk[8];
#pragma unroll
    for (int e = 0; e < 8; ++e) { gq[e] = qg[(lane & 7) * 8 + e] * 0.125f; gk[e] = kg[(lane & 7) * 8 + e]; }
    for (int item = gw; item < MT * 2; item += NGW) {
        const int row = item >> 1, half = item & 1;
        u32x4* ptr = (u32x4*)(QKV + (size_t)row * LDQ0 + half * 512) + lane;
        float f[8]; unpack8(*ptr, f);
        float ss = 0.f;
#pragma unroll
        for (int e = 0; e < 8; ++e) ss += f[e] * f[e];
        ss += __shfl_xor(ss, 1); ss += __shfl_xor(ss, 2); ss += __shfl_xor(ss, 4);
        const float rstd = rsqrtf(ss * (1.f / 64.f) + EPS);
#pragma unroll
        for (int e = 0; e < 8; ++e) f[e] = f[e] * rstd * (half ? gk[e] : gq[e]);
        *ptr = pack8f(f);
    }
}

__device__ __forceinline__ void phase_conv(const bf16* QKV, const float* cw, const float* cb, const float* lng, const float* lnb, bf16* ATT, LAS unsigned char* lds, int tid, int lane, int wave) {
    LAS unsigned short* glu = (LAS unsigned short*)lds;
    LAS float* ybuf = (LAS float*)(lds + 65536);
    float w[31];
#pragma unroll
    for (int i = 0; i < 31; ++i) w[i] = cw[i * 512 + tid];
    const float bias = cb[tid];
    float lg[8], lb[8];
#pragma unroll
    for (int e = 0; e < 8; ++e) { lg[e] = lng[lane * 8 + e]; lb[e] = lnb[lane * 8 + e]; }
    u32x4 ru[8];
#define CONV_LOAD(it_) do { int sb_, sl_, t0_; if ((it_) < 1024) { sb_ = ((it_) >> 7) * TL; sl_ = TL; t0_ = ((it_) & 127) * 32; } else { const int j_ = (it_) - 1024; sb_ = MLAT + (j_ >> 3) * NCTX; sl_ = NCTX; t0_ = (j_ & 7) * 32; } \
        _Pragma("unroll") for (int ps_ = 0; ps_ < 8; ++ps_) { const int i_ = ps_ * 8 + (tid >> 6); const int t_ = t0_ - 15 + i_; ru[ps_] = (u32x4){0u, 0u, 0u, 0u}; \
            if (i_ < 62 && t_ >= 0 && t_ < sl_) ru[ps_] = *(const u32x4*)(QKV + (size_t)(sb_ + t_) * LDQ0 + 1536 + lane * 8); } } while (0)
    if ((int)blockIdx.x < 1088) CONV_LOAD((int)blockIdx.x);
    for (int it = blockIdx.x; it < 1088; it += gridDim.x) {
        int seq_base, t0;
        if (it < 1024) { seq_base = (it >> 7) * TL; t0 = (it & 127) * 32; } else { const int j = it - 1024; seq_base = MLAT + (j >> 3) * NCTX; t0 = (j & 7) * 32; }
#pragma unroll
        for (int ps = 0; ps < 8; ++ps) { const int i = ps * 8 + (tid >> 6); if (i < 62) *(LAS u32x4*)(glu + i * 512 + lane * 8) = ru[ps]; }
        if (it + (int)gridDim.x < 1088) CONV_LOAD(it + (int)gridDim.x);
        __syncthreads();
        for (int tg = 0; tg < 4; ++tg) {
            float v[38];
#pragma unroll
            for (int j = 0; j < 38; ++j) v[j] = bf2f(glu[(tg * 8 + j) * 512 + tid]);
#pragma unroll
            for (int t = 0; t < 8; ++t) { float a = bias;
#pragma unroll
                for (int k = 0; k < 31; ++k) a += v[t + k] * w[k];
                ybuf[(tg * 8 + t) * 512 + tid] = a; }
        }
        __syncthreads();
#pragma unroll
        for (int q = 0; q < 4; ++q) { const int t = wave * 4 + q; const LAS f32x4* yp = (const LAS f32x4*)(ybuf + t * 512 + lane * 8);
            const f32x4 a = yp[0], b = yp[1]; float f[8] = {a.x, a.y, a.z, a.w, b.x, b.y, b.z, b.w};
            float s = 0.f;
#pragma unroll
            for (int e = 0; e < 8; ++e) s += f[e];
            const float mu = wave_sum(s) * (1.f / 512.f); float s2 = 0.f;
#pragma unroll
            for (int e = 0; e < 8; ++e) { f[e] -= mu; s2 += f[e] * f[e]; }
            const float rstd = rsqrtf(wave_sum(s2) * (1.f / 512.f) + EPS);
#pragma unroll
            for (int e = 0; e < 8; ++e) f[e] = silu_f(f[e] * rstd * lg[e] + lb[e]);
            *(u32x4*)(ATT + (size_t)(seq_base + t0 + t) * D + 512 + lane * 8) = pack8f(f); }
    }
    __syncthreads();
}

constexpr int AVS = 144;
template <int NQR>
__device__ __forceinline__ void attn_wave(const bf16* QKV, int tq0, int h, int krlo, int nkr, int tkloc0, int tkctx0, const LAS float* rpbh, int rbase, int qc0, int kc0, bf16* ATT, LAS char* vl, int lane, const LAS float* gqk) {
    const int fr = lane & 15, g = lane >> 4, q4 = (lane & 15) >> 2, p4 = lane & 3;
    bf16x8 qf[NQR][2]; f32x4 oacc[NQR][4]; float lrun[NQR]; int r0q[NQR];
    const float sref = __builtin_bit_cast(float, __builtin_amdgcn_readfirstlane(__builtin_bit_cast(int, gqk[64])));
#pragma unroll
    for (int qr = 0; qr < NQR; ++qr) {
        const bf16* qp = QKV + (size_t)(tq0 + 64 * qr + fr) * LDQ0 + h * 64 + 8 * g;
        { float a8[8], b8[8]; unpack8(*(const u32x4*)qp, a8); unpack8(*(const u32x4*)(qp + 32), b8); float ss = 0.f;
#pragma unroll
          for (int e = 0; e < 8; ++e) ss += a8[e] * a8[e] + b8[e] * b8[e];
          ss += __shfl_xor(ss, 16); ss += __shfl_xor(ss, 32); const float rq = rsqrtf(ss * (1.f / 64.f) + EPS);
#pragma unroll
          for (int e = 0; e < 8; ++e) { a8[e] *= rq * gqk[8 * g + e]; b8[e] *= rq * gqk[32 + 8 * g + e]; }
          qf[qr][0] = __builtin_bit_cast(bf16x8, pack8f(a8)); qf[qr][1] = __builtin_bit_cast(bf16x8, pack8f(b8)); }
#pragma unroll
        for (int c = 0; c < 4; ++c) oacc[qr][c] = (f32x4){0.f, 0.f, 0.f, 0.f};
        lrun[qr] = 0.f; r0q[qr] = min(max(rbase + qr - 4, 0), 56);
    }
    const int ns = nkr + 8;
    const int qcol = qc0 + fr; const int lo = min(max(qcol - 8, 0), 48);
    bf16x8 kf[4]; u32x4 vv[4];
    {
        const int tk0 = nkr > 0 ? tkloc0 : tkctx0;
        const bf16* kp = QKV + (size_t)(tk0 + fr) * LDQ0 + 512 + h * 64 + 8 * g;
        kf[0] = *(const bf16x8*)kp; kf[1] = *(const bf16x8*)(kp + 32); kf[2] = *(const bf16x8*)(kp + 16 * LDQ0); kf[3] = *(const bf16x8*)(kp + 16 * LDQ0 + 32);
#pragma unroll
        for (int i = 0; i < 4; ++i) { const int c = lane + 64 * i; vv[i] = *(const u32x4*)(QKV + (size_t)(tk0 + (c >> 3)) * LDQ0 + 1024 + h * 64 + (c & 7) * 8); }
    }
    for (int s = 0; s < ns; ++s) {
        bf16x8 kn[4]; u32x4 vn[4];
        if (s + 1 < ns) {
            const int tk0 = (s + 1) < nkr ? tkloc0 + (s + 1) * 64 : tkctx0 + (s + 1 - nkr) * 32;
            const bf16* kp = QKV + (size_t)(tk0 + fr) * LDQ0 + 512 + h * 64 + 8 * g;
            kn[0] = *(const bf16x8*)kp; kn[1] = *(const bf16x8*)(kp + 32); kn[2] = *(const bf16x8*)(kp + 16 * LDQ0); kn[3] = *(const bf16x8*)(kp + 16 * LDQ0 + 32);
#pragma unroll
            for (int i = 0; i < 4; ++i) { const int c = lane + 64 * i; vn[i] = *(const u32x4*)(QKV + (size_t)(tk0 + (c >> 3)) * LDQ0 + 1024 + h * 64 + (c & 7) * 8); }
        } else {
#pragma unroll
            for (int i = 0; i < 4; ++i) { kn[i] = kf[i]; vn[i] = vv[i]; }
        }
#pragma unroll
        for (int i = 0; i < 4; ++i) { const int c = lane + 64 * i; *(LAS u32x4*)(vl + (c >> 3) * AVS + (c & 7) * 16) = vv[i]; }
        asm volatile("s_waitcnt lgkmcnt(0)" ::: "memory");
        bf16x8 vfr[4];
#pragma unroll
        for (int c = 0; c < 4; ++c) vfr[c] = cat44(trread(vl + (4 * g + q4) * AVS + (16 * c + 4 * p4) * 2), trread(vl + (16 + 4 * g + q4) * AVS + (16 * c + 4 * p4) * 2));
        asm volatile("s_waitcnt lgkmcnt(0)" ::: "memory");
        const bool local = s < nkr; const int kr = krlo + s;
#pragma unroll
        for (int jb = 0; jb < 2; ++jb) { float a8[8], b8[8]; unpack8(__builtin_bit_cast(u32x4, kf[2 * jb]), a8); unpack8(__builtin_bit_cast(u32x4, kf[2 * jb + 1]), b8); float ss = 0.f;
#pragma unroll
            for (int e = 0; e < 8; ++e) ss += a8[e] * a8[e] + b8[e] * b8[e];
            ss += __shfl_xor(ss, 16); ss += __shfl_xor(ss, 32); const float rk = rsqrtf(ss * (1.f / 64.f) + EPS);
#pragma unroll
            for (int e = 0; e < 8; ++e) { a8[e] *= rk; b8[e] *= rk; }
            kf[2 * jb] = __builtin_bit_cast(bf16x8, pack8f(a8)); kf[2 * jb + 1] = __builtin_bit_cast(bf16x8, pack8f(b8)); }
#pragma unroll
        for (int qr = 0; qr < NQR; ++qr) {
            if (!local || (kr >= r0q[qr] && kr < r0q[qr] + 8)) {
                f32x4 st[2];
#pragma unroll
                for (int jb = 0; jb < 2; ++jb) { st[jb] = MFMA16(kf[2 * jb], qf[qr][0], ((f32x4){0.f, 0.f, 0.f, 0.f})); st[jb] = MFMA16(kf[2 * jb + 1], qf[qr][1], st[jb]); }
                float ps = 0.f; float pv[8];
                if (local) {
                    const LAS float* rrow = rpbh + (kr - (rbase + qr) + 7) * 31;
#pragma unroll
                    for (int jb = 0; jb < 2; ++jb)
#pragma unroll
                        for (int e = 0; e < 4; ++e) { const int kcol = kc0 + 16 * jb + 4 * g + e; const bool valid = (kcol >= lo) && (kcol < lo + 16);
                            const int rel = min(max(kcol - qcol + 15, 0), 30); const float bv = valid ? rrow[rel] : -1e30f;
                            const float pe = __builtin_amdgcn_exp2f(st[jb][e] + bv); pv[jb * 4 + e] = pe; ps += pe; }
                } else {
#pragma unroll
                    for (int jb = 0; jb < 2; ++jb)
#pragma unroll
                        for (int e = 0; e < 4; ++e) { const float pe = __builtin_amdgcn_exp2f(st[jb][e] - sref); pv[jb * 4 + e] = pe; ps += pe; }
                }
                lrun[qr] += ps;
                const bf16x8 pf = __builtin_bit_cast(bf16x8, pack8f(pv));
#pragma unroll
                for (int c = 0; c < 4; ++c) oacc[qr][c] = MFMA16(vfr[c], pf, oacc[qr][c]);
            }
        }
#pragma unroll
        for (int i = 0; i < 4; ++i) { kf[i] = kn[i]; vv[i] = vn[i]; }
    }
#pragma unroll
    for (int qr = 0; qr < NQR; ++qr) {
        float lt = lrun[qr]; lt += __shfl_xor(lt, 16); lt += __shfl_xor(lt, 32);
        const float inv = 1.0f / lt;
        bf16* op = ATT + (size_t)(tq0 + 64 * qr + fr) * D + h * 64 + 4 * g;
#pragma unroll
        for (int c = 0; c < 4; ++c) { u32x2 w; w.x = pk2(oacc[qr][c][0] * inv, oacc[qr][c][1] * inv); w.y = pk2(oacc[qr][c][2] * inv, oacc[qr][c][3] * inv); *(u32x2*)(op + 16 * c) = w; }
    }
}

__device__ __forceinline__ void phase_attn(const bf16* QKV, const float* rpb, const float* qg, const float* kg, bf16* ATT, LAS unsigned char* lds, int lane, int wave) {
    const int gw = blockIdx.x * NWAVES + wave, NGW = gridDim.x * NWAVES;
    LAS char* vl = (LAS char*)lds + wave * 4608;
    LAS float* rpbl = (LAS float*)(lds + 40960);
    LAS float* gqk = (LAS float*)(lds + 57344);
    if (threadIdx.x < 64) { const float gv = qg[threadIdx.x] * kg[threadIdx.x] * (0.125f * 1.44269504f); gqk[threadIdx.x] = gv;
        const float bnd = 64.0f * wave_max(fabsf(gv)); if (threadIdx.x == 0) gqk[64] = bnd; }
    __syncthreads();
    { const float bnd = gqk[64]; for (int i = threadIdx.x; i < 8 * 15 * 31; i += NTHR) rpbl[i] = rpb[i] * 1.44269504f - bnd; }
    __syncthreads();
    for (int item = gw; item < 4096; item += NGW) {
        const int cgp = item & 3, h = (item >> 2) & 7, rg = (item >> 5) & 15, b = item >> 9;
        const int rbase = 4 * rg; const int krlo = min(max(rbase - 4, 0), 56); const int krhi = min(max(rbase + 3 - 4, 0), 56) + 8;
        const int kc0 = cgp == 0 ? 0 : (cgp == 1 ? 8 : (cgp == 2 ? 24 : 32));
        attn_wave<4>(QKV, b * TL + rbase * 64 + 16 * cgp, h, krlo, krhi - krlo, b * TL + krlo * 64 + kc0, MLAT + b * NCTX, rpbl + h * 15 * 31, rbase, 16 * cgp, kc0, ATT, vl, lane, gqk);
    }
    for (int item = (gw + NGW / 2) % NGW; item < 1024; item += NGW) {
        const int qg = item & 15, h = (item >> 4) & 7, b = item >> 7;
        attn_wave<1>(QKV, MLAT + b * NCTX + 16 * qg, h, 0, 0, 0, MLAT + b * NCTX, rpbl, 0, 0, 0, ATT, vl, lane, gqk);
    }
}

__device__ __forceinline__ void phase_mlprep(const bf16* __restrict__ QKVO, const float* __restrict__ cw, const float* __restrict__ cb, bf16* __restrict__ QKP, bf16* __restrict__ CTXQK, int lane, int wave) {
    const int gw = blockIdx.x * NWAVES + wave, NGW = gridDim.x * NWAVES;
    for (int half = 0; half < 2; ++half) {
        const int cbase = half * 512 + lane * 8;
        float w[5][8], bias[8];
#pragma unroll
        for (int k = 0; k < 5; ++k)
#pragma unroll
            for (int e = 0; e < 8; ++e) w[k][e] = cw[k * 1024 + cbase + e];
#pragma unroll
        for (int e = 0; e < 8; ++e) bias[e] = cb[cbase + e];
        float inv[8];
#pragma unroll
        for (int e = 0; e < 8; ++e) inv[e] = exp2f(-(float)((lane & 1) * 8 + e) * (13.287712379549449f / 16.f));
        const int mrows = half == 0 ? MLAT : MT;
#pragma unroll 2
        for (int row = gw; row < mrows; row += NGW) {
            int t, len; if (row < MLAT) { t = row & (TL - 1); len = TL; } else { t = (row - MLAT) & (NCTX - 1); len = NCTX; }
            float a[8];
#pragma unroll
            for (int e = 0; e < 8; ++e) a[e] = bias[e];
#pragma unroll
            for (int k = 0; k < 5; ++k) { const int tt = t + k - 2;
                if (tt >= 0 && tt < len) { float f[8]; unpack8(*(const u32x4*)(QKVO + (size_t)(row + k - 2) * LDQ1 + cbase), f);
#pragma unroll
                    for (int e = 0; e < 8; ++e) a[e] += f[e] * w[k][e]; } }
            const float qs = half == 0 ? 0.125f : 1.0f;
#pragma unroll
            for (int e = 0; e < 8; ++e) a[e] = silu_f(a[e]) * qs;
            if (row < MLAT) {
                const float pos = (float)((lane & 4) ? (t & 63) : (t >> 6));
#pragma unroll
                for (int e = 0; e < 8; ++e) { const float ang = pos * inv[e]; const float cs = __cosf(ang), sn = __sinf(ang); const float other = __shfl_xor(a[e], 2);
                    a[e] = (lane & 2) ? (other * sn + a[e] * cs) : (a[e] * cs - other * sn); }
                *(u32x4*)(QKP + (size_t)row * D + cbase) = pack8f(a);
            } else {
                *(u32x4*)(CTXQK + (size_t)(row - MLAT) * D + cbase) = pack8f(a);
            }
        }
    }
}

constexpr int SKS = 144;
__device__ __forceinline__ void phase_mlscan(const bf16* QKVO, const bf16* QKP, const bf16* CTXQK, const float* GATES, bf16* SPREV, float* NPREV, float* MPREV, LAS unsigned char* lds, int tid, int lane, int wave) {
    LAS char* tb = (LAS char*)lds;
    LAS float* lnb = (LAS float*)(lds + 73728);
    LAS float* weT = (LAS float*)(lds + 77824);
    LAS float* totT = (LAS float*)(lds + 95232);
    LAS float* mlocT = totT + 64;
    LAS float* mbefT = totT + 128;
    LAS float* mnewT = totT + 192;
    LAS float* decT = totT + 256;
    const int g = lane >> 4, fr = lane & 15, q4 = (lane & 15) >> 2, p4 = lane & 3;
    const int dvb = wave >> 1, dkb0 = 2 * (wave & 1);
    for (int item = blockIdx.x; item < 256; item += gridDim.x) {
        const int vh = item & 1, dir = (item >> 1) & 1, h = (item >> 2) & 7, b = item >> 5;
#define SCAN_ROW0(st) ((st) < 2 ? MLAT + b * NCTX + (dir ? 1 - (st) : (st)) * 128 : b * TL + (dir ? 31 - ((st) - 2) : (st) - 2) * 128)
#pragma unroll 1
        for (int st = wave; st < 34; st += 8) {
            const int r0 = SCAN_ROW0(st);
            const float* gp = GATES + (size_t)(r0 + 2 * lane) * 32 + dir * 8 + h;
            const float ig0 = gp[0], ig1 = gp[32], lf0 = gp[16], lf1 = gp[48];
            float ps = lf0 + lf1;
#pragma unroll
            for (int o = 1; o < 64; o <<= 1) { const float t = __shfl_up(ps, o); if (lane >= o) ps += t; }
            const float total = __shfl(ps, 63); const float cum1 = ps, cum0 = ps - lf1;
            float we0, we1;
            if (dir == 0) { we0 = total - cum0 + ig0; we1 = total - cum1 + ig1; } else { we0 = (cum0 - lf0) + ig0; we1 = (cum1 - lf1) + ig1; }
            const float mloc = wave_max(fmaxf(we0, we1));
            weT[st * 128 + 2 * lane] = we0; weT[st * 128 + 2 * lane + 1] = we1;
            if (lane == 0) { totT[st] = total; mlocT[st] = mloc; }
        }
        __syncthreads();
        if (wave == 0) {
            float m = 0.f;
#pragma unroll 1
            for (int st = 0; st < 34; ++st) { const float total = totT[st], mloc = mlocT[st]; const float mnew = fmaxf(total + m, mloc); const float dec = __expf(total + m - mnew);
                if (lane == 0) { mbefT[st] = m; mnewT[st] = mnew; decT[st] = dec; } m = mnew; }
        }
        __syncthreads();
        u32x4 nk[2], nv[2];
#define SCAN_LOAD(st) do { const bool ic_ = (st) < 2; const int r0_ = SCAN_ROW0(st); \
            _Pragma("unroll") for (int i_ = 0; i_ < 2; ++i_) { const int id_ = tid + 512 * i_; const int l_ = id_ >> 3, c_ = id_ & 7; \
                const bf16* kp_ = ic_ ? CTXQK + (size_t)(r0_ - MLAT + l_) * D + 512 + h * 64 + c_ * 8 : QKP + (size_t)(r0_ + l_) * D + 512 + h * 64 + c_ * 8; \
                nk[i_] = *(const u32x4*)kp_; nv[i_] = *(const u32x4*)(QKVO + (size_t)(r0_ + l_) * LDQ1 + 1024 + h * 128 + vh * 64 + c_ * 8); } } while (0)
#define SCAN_STAGE(st) do { LAS char* lk_ = tb + ((st) & 1) * 36864; LAS char* lv_ = lk_ + 18432; const float mn_ = mnewT[st]; \
            _Pragma("unroll") for (int i_ = 0; i_ < 2; ++i_) { const int id_ = tid + 512 * i_; const int l_ = id_ >> 3, c_ = id_ & 7; \
                float f_[8]; unpack8(nk[i_], f_); const float wl_ = __expf(weT[(st) * 128 + l_] - mn_); \
                _Pragma("unroll") for (int e_ = 0; e_ < 8; ++e_) f_[e_] *= wl_; \
                *(LAS u32x4*)(lk_ + l_ * SKS + c_ * 16) = pack8f(f_); *(LAS u32x4*)(lv_ + l_ * SKS + c_ * 16) = nv[i_]; } } while (0)
        SCAN_LOAD(0); SCAN_STAGE(0); SCAN_LOAD(1);
        __syncthreads();
        f32x4 acc[2]; acc[0] = (f32x4){0.f, 0.f, 0.f, 0.f}; acc[1] = acc[0];
        float nst = 0.f;
#pragma unroll 1
        for (int step = 0; step < 34; ++step) {
            if (step >= 2) {
                const int cc = dir ? 31 - (step - 2) : step - 2;
                const size_t idx = (size_t)((b * 8 + h) * 2 + dir) * 32 + cc;
#pragma unroll
                for (int t = 0; t < 2; ++t) { u32x2 w; w.x = pk2(acc[t][0], acc[t][1]); w.y = pk2(acc[t][2], acc[t][3]);
                    *(u32x2*)(SPREV + (idx * 64 + 16 * (dkb0 + t) + fr) * 128 + vh * 64 + 16 * dvb + 4 * g) = w; }
                if (vh == 0 && tid < 64) NPREV[idx * 64 + tid] = nst;
                if (vh == 0 && tid == 0) MPREV[idx] = mbefT[step];
            }
            if (step + 1 < 34) { SCAN_STAGE(step + 1); if (step + 2 < 34) SCAN_LOAD(step + 2); }
            const LAS char* lk = tb + (step & 1) * 36864; const LAS char* lv = lk + 18432;
            const float decay = decT[step];
            acc[0] = acc[0] * decay; acc[1] = acc[1] * decay;
#pragma unroll
            for (int s4 = 0; s4 < 4; ++s4) {
                const int rb = (32 * s4 + 8 * g + q4) * SKS;
                const bf16x8 af = cat44(trread(lv + rb + (16 * dvb + 4 * p4) * 2), trread(lv + rb + 4 * SKS + (16 * dvb + 4 * p4) * 2));
#pragma unroll
                for (int t = 0; t < 2; ++t) { const bf16x8 bfr = cat44(trread(lk + rb + (16 * (dkb0 + t) + 4 * p4) * 2), trread(lk + rb + 4 * SKS + (16 * (dkb0 + t) + 4 * p4) * 2));
                    acc[t] = MFMA16(af, bfr, acc[t]); }
            }
            { const int dk = tid & 63, part = tid >> 6; float s = 0.f;
#pragma unroll
              for (int l = 0; l < 16; ++l) s += bf2f(*(const LAS unsigned short*)(lk + (part * 16 + l) * SKS + dk * 2));
              lnb[(step & 1) * 512 + part * 64 + dk] = s; }
            __syncthreads();
            if (tid < 64) { float s = 0.f;
#pragma unroll
                for (int pt = 0; pt < 8; ++pt) s += lnb[(step & 1) * 512 + pt * 64 + tid];
                nst = decay * nst + s; }
        }
        __syncthreads();
#undef SCAN_ROW0
#undef SCAN_LOAD
#undef SCAN_STAGE
    }
}

constexpr int OVS = 272;
__device__ __forceinline__ void phase_mlout(const bf16* QKVO, const bf16* QKP, const float* GATES, const bf16* SPREV, const float* NPREV, const float* MPREV, const float* normg, bf16* HN,
                                            LAS unsigned char* lds, int tid, int lane, int wave) {
    LAS char* lk = (LAS char*)lds; LAS char* lv = (LAS char*)lds + 18432; LAS char* ls = (LAS char*)lds + 53248;
    LAS float* arr = (LAS float*)(lds + 88064);
    const int g = lane >> 4, fr = lane & 15, q4 = (lane & 15) >> 2, p4 = lane & 3;
    u32x4 pvv[4], pss[4]; float pg0 = 0.f, pg1 = 0.f, pl0 = 0.f, pl1 = 0.f, pmp = 0.f, pnp = 0.f; bf16x8 pq[2];
#define MLOUT_LOAD(it_) do { const int c_ = (it_) & 31, h_ = ((it_) >> 5) & 7, b_ = (it_) >> 8; const int r0_ = b_ * TL + c_ * 128; \
        _Pragma("unroll") for (int i_ = 0; i_ < 4; ++i_) { const int id_ = tid + 512 * i_; pvv[i_] = *(const u32x4*)(QKVO + (size_t)(r0_ + (id_ >> 4)) * LDQ1 + 1024 + h_ * 128 + (id_ & 15) * 8); } \
        _Pragma("unroll") for (int i_ = 0; i_ < 4; ++i_) { const int id_ = tid + 512 * i_; const int dr_ = id_ >> 10, rem_ = id_ & 1023; \
            const size_t ix_ = (size_t)((b_ * 8 + h_) * 2 + dr_) * 32 + c_; pss[i_] = *(const u32x4*)(SPREV + (ix_ * 64 + (rem_ >> 4)) * 128 + (rem_ & 15) * 8); } \
        { const int tq_ = r0_ + 16 * wave + fr; const bf16* qp_ = QKP + (size_t)tq_ * D + h_ * 64 + 8 * g; pq[0] = *(const bf16x8*)qp_; pq[1] = *(const bf16x8*)(qp_ + 32); } \
        if (wave < 2) { const size_t ix_ = (size_t)((b_ * 8 + h_) * 2 + wave) * 32 + c_; const float* gp_ = GATES + (size_t)(r0_ + 2 * lane) * 32 + wave * 8 + h_; \
            pg0 = gp_[0]; pg1 = gp_[32]; pl0 = gp_[16]; pl1 = gp_[48]; pmp = MPREV[ix_]; pnp = NPREV[ix_ * 64 + lane]; } } while (0)
    if ((int)blockIdx.x < 2048) MLOUT_LOAD((int)blockIdx.x);
    for (int item = blockIdx.x; item < 2048; item += gridDim.x) {
        const int c = item & 31, h = (item >> 5) & 7, b = item >> 8;
        const int row0 = b * TL + c * 128;
#pragma unroll
        for (int i = 0; i < 2; ++i) { const int id = tid + 512 * i; const int l = id >> 3, c16 = id & 7; *(LAS u32x4*)(lk + l * SKS + c16 * 16) = *(const u32x4*)(QKP + (size_t)(row0 + l) * D + 512 + h * 64 + c16 * 8); }
#pragma unroll
        for (int i = 0; i < 4; ++i) { const int id = tid + 512 * i; const int l = id >> 4, c16 = id & 15; *(LAS u32x4*)(lv + l * OVS + c16 * 16) = pvv[i]; }
#pragma unroll
        for (int i = 0; i < 4; ++i) { const int id = tid + 512 * i; const int dr = id >> 10, rem = id & 1023; const int l = rem >> 4, c16 = rem & 15; *(LAS u32x4*)(ls + dr * 17408 + l * OVS + c16 * 16) = pss[i]; }
        const float cg0 = pg0, cg1 = pg1, cl0 = pl0, cl1 = pl1, cmp_ = pmp, cnp = pnp; bf16x8 qf[2]; qf[0] = pq[0]; qf[1] = pq[1];
        if (item + (int)gridDim.x < 2048) MLOUT_LOAD(item + (int)gridDim.x);
        if (wave < 2) {
            const int dr = wave; const size_t idx = (size_t)((b * 8 + h) * 2 + dr) * 32 + c;
            const float ig0 = cg0, ig1 = cg1, lf0 = cl0, lf1 = cl1;
            float ps = lf0 + lf1;
#pragma unroll
            for (int o = 1; o < 64; o <<= 1) { const float t = __shfl_up(ps, o); if (lane >= o) ps += t; }
            const float total = __shfl(ps, 63);
            float cum0, cum1;
            if (dr == 0) { cum1 = ps; cum0 = ps - lf1; } else { cum0 = total - (ps - lf1 - lf0); cum1 = total - (ps - lf1); }
            const float a0 = ig0 - cum0, a1 = ig1 - cum1;
            float am0, am1;
            if (dr == 0) { float pm = fmaxf(a0, a1);
#pragma unroll
                for (int o = 1; o < 64; o <<= 1) { const float t = __shfl_up(pm, o); if (lane >= o) pm = fmaxf(pm, t); }
                float prev = __shfl_up(pm, 1); if (lane == 0) prev = -1e30f; am0 = fmaxf(prev, a0); am1 = pm;
            } else { float pm = fmaxf(a0, a1);
#pragma unroll
                for (int o = 1; o < 64; o <<= 1) { const float t = __shfl_down(pm, o); if (lane + o < 64) pm = fmaxf(pm, t); }
                float nxt = __shfl_down(pm, 1); if (lane == 63) nxt = -1e30f; am0 = pm; am1 = fmaxf(nxt, a1);
            }
            const float mp = cmp_;
            const float mx0 = fmaxf(mp, am0), mx1 = fmaxf(mp, am1);
            LAS float* ar = arr + dr * 576;
            ar[2 * lane] = a0; ar[2 * lane + 1] = a1;
            ar[128 + 2 * lane] = -mx0; ar[128 + 2 * lane + 1] = -mx1;
            ar[256 + 2 * lane] = __expf(mp - mx0); ar[256 + 2 * lane + 1] = __expf(mp - mx1);
            ar[384 + 2 * lane] = __expf(-(cum0 + mx0)); ar[384 + 2 * lane + 1] = __expf(-(cum1 + mx1));
            ar[512 + lane] = cnp;
        }
        __syncthreads();
        const int tq = row0 + 16 * wave + fr; const int iq = 16 * wave + fr;
        u32x2 cow[8];
#pragma unroll
        for (int d = 0; d < 8; ++d) cow[d] = *(const u32x2*)(QKVO + (size_t)tq * LDQ1 + 2048 + h * 128 + 16 * d + 4 * g);
        float qv[16];
        { float t8[8]; unpack8(__builtin_bit_cast(u32x4, qf[0]), t8);
#pragma unroll
          for (int e = 0; e < 8; ++e) qv[e] = t8[e];
          unpack8(__builtin_bit_cast(u32x4, qf[1]), t8);
#pragma unroll
          for (int e = 0; e < 8; ++e) qv[8 + e] = t8[e]; }
        f32x4 hsum[8];
#pragma unroll
        for (int d = 0; d < 8; ++d) hsum[d] = (f32x4){0.f, 0.f, 0.f, 0.f};
#pragma unroll
        for (int dr = 0; dr < 2; ++dr) {
            const LAS float* ar = arr + dr * 576;
            const float bmq = ar[128 + iq], inter = ar[256 + iq], emq = ar[384 + iq];
            float qn = 0.f;
#pragma unroll
            for (int e = 0; e < 8; ++e) { qn += qv[e] * ar[512 + 8 * g + e]; qn += qv[8 + e] * ar[512 + 32 + 8 * g + e]; }
            qn += __shfl_xor(qn, 16); qn += __shfl_xor(qn, 32);
            bf16x8 qs[2];
            { float t8[8];
#pragma unroll
              for (int e = 0; e < 8; ++e) t8[e] = qv[e] * inter;
              qs[0] = __builtin_bit_cast(bf16x8, pack8f(t8));
#pragma unroll
              for (int e = 0; e < 8; ++e) t8[e] = qv[8 + e] * inter;
              qs[1] = __builtin_bit_cast(bf16x8, pack8f(t8)); }
            f32x4 acc[8];
            const LAS char* lsd = ls + dr * 17408;
#pragma unroll
            for (int d = 0; d < 8; ++d) { acc[d] = (f32x4){0.f, 0.f, 0.f, 0.f};
#pragma unroll
                for (int ks = 0; ks < 2; ++ks) { const int rb = (32 * ks + 8 * g + q4) * OVS + (16 * d + 4 * p4) * 2;
                    acc[d] = MFMA16(cat44(trread(lsd + rb), trread(lsd + rb + 4 * OVS)), qs[ks], acc[d]); } }
            float psum = 0.f;
            const int jlo = dr == 0 ? 0 : (wave >> 1), jhi = dr == 0 ? (wave >> 1) : 3;
            for (int jp = jlo; jp <= jhi; ++jp) {
                float pv[8];
#pragma unroll
                for (int jj = 0; jj < 2; ++jj) { const int jb = 2 * jp + jj;
                    const LAS char* kp = lk + (16 * jb + fr) * SKS + 8 * g * 2;
                    f32x4 st = MFMA16(*(const LAS bf16x8*)kp, qf[0], ((f32x4){0.f, 0.f, 0.f, 0.f})); st = MFMA16(*(const LAS bf16x8*)(kp + 64), qf[1], st);
                    const f32x4 av = *(const LAS f32x4*)(ar + 16 * jb + 4 * g);
#pragma unroll
                    for (int e = 0; e < 4; ++e) { const int j = 16 * jb + 4 * g + e; const bool valid = dr == 0 ? (j <= iq) : (j >= iq);
                        const float wgt = valid ? __expf(bmq + av[e]) : 0.f; const float pe = wgt * st[e]; pv[jj * 4 + e] = pe; psum += pe; } }
                const bf16x8 pf = __builtin_bit_cast(bf16x8, pack8f(pv));
#pragma unroll
                for (int d = 0; d < 8; ++d) { const int rb0 = (32 * jp + 4 * g + q4) * OVS + (16 * d + 4 * p4) * 2;
                    acc[d] = MFMA16(cat44(trread(lv + rb0), trread(lv + rb0 + 16 * OVS)), pf, acc[d]); }
            }
            psum += __shfl_xor(psum, 16); psum += __shfl_xor(psum, 32);
            const float den = inter * qn + psum;
            const float hs = 1.0f / fmaxf(fabsf(den), emq);
#pragma unroll
            for (int d = 0; d < 8; ++d) hsum[d] = hsum[d] + acc[d] * hs;
        }
        float ss = 0.f;
#pragma unroll
        for (int d = 0; d < 8; ++d) ss += (hsum[d][0] * hsum[d][0] + hsum[d][1] * hsum[d][1]) + (hsum[d][2] * hsum[d][2] + hsum[d][3] * hsum[d][3]);
        ss += __shfl_xor(ss, 16); ss += __shfl_xor(ss, 32);
        const float rstd = rsqrtf(ss * (1.f / 128.f) + EPS);
#pragma unroll
        for (int d = 0; d < 8; ++d) { const int col = h * 128 + 16 * d + 4 * g;
            const f32x4 ng = *(const f32x4*)(normg + col); const u32x2 ow = cow[d];
            const float o0 = bflo(ow.x), o1 = bfhi(ow.x), o2 = bflo(ow.y), o3 = bfhi(ow.y);
            u32x2 w; w.x = pk2(hsum[d][0] * rstd * ng[0] * fast_sig(o0), hsum[d][1] * rstd * ng[1] * fast_sig(o1));
            w.y = pk2(hsum[d][2] * rstd * ng[2] * fast_sig(o2), hsum[d][3] * rstd * ng[3] * fast_sig(o3));
            *(u32x2*)(HN + (size_t)tq * D + col) = w; }
        __syncthreads();
    }
}

#define XB_TMO      128
#define XB_XCNT(j)  (256  + 64 * (j))
#define XB_XSUB(j)  (1280 + 64 * (j))
#define XB_XGEN(j)  (2304 + 64 * (j))
#define XB_TOP      3328
#define XB_TOPGEN   3392
#define XCD_BAR_WORDS 3456
#define XB_SPIN_CAP (1u << 18)

__device__ __forceinline__ unsigned xb_ld(unsigned* p)              { return __hip_atomic_load(p, __ATOMIC_RELAXED, __HIP_MEMORY_SCOPE_AGENT); }
__device__ __forceinline__ unsigned xb_add(unsigned* p, unsigned v) { return __hip_atomic_fetch_add(p, v, __ATOMIC_RELAXED, __HIP_MEMORY_SCOPE_AGENT); }
__device__ __forceinline__ unsigned xb_xcc_id() { return (unsigned)__builtin_amdgcn_s_getreg((3 << 11) | 20) & 0xFu; }
#define XB_SPIN(cond, bar) do { unsigned _sp = 0; while (cond) { __builtin_amdgcn_s_sleep(1); \
    if ((++_sp & 255u) == 0u) { if (xb_ld(&(bar)[XB_TMO])) break; if (_sp > XB_SPIN_CAP) { atomicAdd(&(bar)[XB_TMO], 1u); break; } } } } while (0)

struct XcdBarrier {
    unsigned* bar; unsigned x;
    volatile LAS unsigned* st;
};

__device__ __forceinline__ XcdBarrier xcd_barrier_post(unsigned* bar, volatile LAS unsigned* st) {
    XcdBarrier b; b.bar = bar; b.x = xb_xcc_id(); b.st = st;
    if (threadIdx.x == 0) (void)xb_add(&bar[XB_XCNT(b.x)], 1u);
    return b;
}
__device__ __forceinline__ void xcd_barrier_complete(unsigned* bar, unsigned x, unsigned& nloc, unsigned& nx) {
    const unsigned G = gridDim.x * gridDim.y * gridDim.z;
    unsigned sum, cnt, mine, sp = 0u;
    for (;;) {
        sum = 0u; cnt = 0u; mine = 0u;
#pragma unroll
        for (unsigned j = 0; j < 16; ++j) { const unsigned c = xb_ld(&bar[XB_XCNT(j)]); sum += c; cnt += (c > 0u) ? 1u : 0u; mine = (j == x) ? c : mine; }
        if (sum == G) break;
        __builtin_amdgcn_s_sleep(1);
        if ((++sp & 255u) == 0u) { if (xb_ld(&bar[XB_TMO])) break; if (sp > XB_SPIN_CAP) { atomicAdd(&bar[XB_TMO], 1u); break; } }
    }
    nloc = mine > 0u ? mine : 1u; nx = cnt > 0u ? cnt : 1u;
}

__device__ __forceinline__ void xcd_barrier(const XcdBarrier& b) {
    asm volatile("s_waitcnt vmcnt(0)" ::: "memory");
    __syncthreads();
    if (threadIdx.x == 0) {
        unsigned* bar = b.bar;
        __builtin_amdgcn_s_waitcnt(0);
        unsigned nloc = b.st[0], nx = b.st[1];
        if (nloc == 0u) { xcd_barrier_complete(bar, b.x, nloc, nx); b.st[0] = nloc; b.st[1] = nx; }
        const unsigned old = xb_add(&bar[XB_XSUB(b.x)], 1u);
        const unsigned gen = old / nloc;
        if (old + 1u == (gen + 1u) * nloc) {
            __builtin_amdgcn_fence(__ATOMIC_RELEASE, "agent");
            asm volatile("s_waitcnt vmcnt(0)" ::: "memory");
            const unsigned og = xb_add(&bar[XB_TOP], 1u);
            const unsigned tg = og / nx;
            if (og + 1u == (tg + 1u) * nx) xb_add(&bar[XB_TOPGEN], 1u);
            else XB_SPIN(xb_ld(&bar[XB_TOPGEN]) == tg, bar);
            __builtin_amdgcn_fence(__ATOMIC_ACQUIRE, "agent");
            xb_add(&bar[XB_XGEN(b.x)], 1u);
            asm volatile("s_waitcnt vmcnt(0)" ::: "memory");
        } else {
            XB_SPIN(xb_ld(&bar[XB_XGEN(b.x)]) == gen, bar);
            __builtin_amdgcn_fence(__ATOMIC_ACQUIRE, "agent");
            asm volatile("s_waitcnt vmcnt(0)" ::: "memory");
        }
    }
    __syncthreads();
}

__global__ void __launch_bounds__(NTHR) fwd_megakernel(Params p) {
    extern __shared__ __attribute__((aligned(16))) unsigned char lds_raw[];
    LAS unsigned char* lds = (LAS unsigned char*)lds_raw;
    cg::grid_group grid = cg::this_grid();
    const int tid = threadIdx.x, lane = tid & 63, wave = __builtin_amdgcn_readfirstlane(tid >> 6);
    unsigned char* ws = p.ws;
    float* mod = (float*)(ws + WS_MOD);
    bf16* BUFA = (bf16*)(ws + WS_BUFA); bf16* XSA = (bf16*)(ws + WS_XS); bf16* XSB = (bf16*)(ws + WS_XS + 68 * MiB);     bf16* QKV = (bf16*)(ws + WS_QKV);
    float* GATES = (float*)(ws + WS_GATES); bf16* CTXQK = (bf16*)(ws + WS_CTXQK); float* NPREV = (float*)(ws + WS_NPREV); float* MPREV = (float*)(ws + WS_MPREV);
    bf16* QKP = (bf16*)p.out;
    bf16* SPREV = (bf16*)((unsigned char*)p.out + 64 * MiB);
    const float* x_in = p.in[0]; const float* ctx_in = p.in[2] - (size_t)MLAT * D;
    const int lo = p.ph_lo, hi = p.ph_hi;
    if (tid < 4) ((LAS unsigned*)(lds + LDS_XB_OFF))[tid] = 0u;
    __syncthreads();
    const XcdBarrier xbar = xcd_barrier_post((unsigned*)(ws + WS_BAR), (volatile LAS unsigned*)(lds + LDS_XB_OFF));
    const int G = gridDim.x, bx = blockIdx.x;
#define RUN(k) (lo <= (k) && (k) < hi)
#define NREP(k) ((((REPMASK) >> (k)) & 1) ? 2 : 1)
#define SIDE(units) const int ex_ = (units) % G; const bool idle_ = ex_ == 0 || bx >= ex_; const int rank_ = ex_ == 0 ? bx : bx - ex_, nblk_ = ex_ == 0 ? G : G - ex_;
#define SYNC(k) do { if (RUN(k) && (k) + 1 < hi) { if (hi > 1000) grid.sync(); else xcd_barrier(xbar); } } while (0)

    if (RUN(0)) for (int rp = 0; rp < NREP(0); ++rp) phase_prologue(p, lds, tid, lane, wave);
    SYNC(0);
    float* RSS = (float*)(ws + WS_RSS); const float* SHW = (const float*)(ws + WS_SHW); const float* GM = (const float*)(ws + WS_GM); const float* GMI = GM + 3 * 9216;
    bf16* AOUT = (bf16*)p.out;
    if (RUN(1)) { phase_aux(p, lds, tid, lane, wave); phase_norm(x_in, ctx_in, p.in[6], mod, 0, 1024, MT, BUFA, lane, wave); }
    SYNC(1);
    if (RUN(2)) { pg8::Gemm g{BUFA, (const bf16*)(ws + WS_W_ABIN), MT, NAB, D}; pg8::StaticOrder S; S.init(MT, NAB, G, bx); pg8::EpiStoreGLU E{QKV, LDQ0};
        pg8::gemm_phase<pg8::EpiStoreGLU, pg8::StaticOrder, true, true>(lds, g, S, E);
        SIDE((MT / 256) * (NAB / 256)); if (idle_) side_weights(p, 0, rank_, nblk_, lds, tid, lane, wave); }
    SYNC(2);
    if (RUN(4)) { shw_compute(p, 0, bx, G, lds, tid, lane, wave);
        for (int rp = 0; rp < NREP(20); ++rp) phase_conv(QKV, p.in[15], p.in[16], p.in[17], p.in[18], BUFA, lds, tid, lane, wave);
        for (int rp = 0; rp < NREP(4); ++rp) phase_attn(QKV, p.in[14], p.in[12], p.in[13], BUFA, lds, lane, wave); }
    SYNC(4);
    if (RUN(5)) { pg8::Gemm g{BUFA, (const bf16*)(ws + WS_W_ABOUT), MT, D, D}; pg8::StaticOrder S; S.init(MT, D, G, bx); pg8::EpiResid2<false> E{x_in, ctx_in, nullptr, mod + 2048, GM, AOUT, RSS};
        pg8::gemm_phase<pg8::EpiResid2<false>, pg8::StaticOrder, true, true>(lds, g, S, E);
        SIDE((MT / 256) * (D / 256)); if (idle_) { side_weights(p, 1, rank_, nblk_, lds, tid, lane, wave); side_weights(p, 2, rank_, nblk_, lds, tid, lane, wave); } }
    SYNC(5);
    if (RUN(7)) { pg8::Gemm g{AOUT, (const bf16*)(ws + WS_W_GU0), MT, 2 * DFF, D}; pg8::StaticOrder S; S.init(MT, 2 * DFF, G, bx); pg8::EpiSwiGLU2 E{QKV, DFF, RSS, SHW, 2 * DFF};
        pg8::gemm_phase<pg8::EpiSwiGLU2, pg8::StaticOrder, true, true>(lds, g, S, E);
        SIDE((MT / 256) * (2 * DFF / 256)); if (idle_) shw_compute(p, 1, rank_, nblk_, lds, tid, lane, wave); }
    SYNC(7);
    const float* mod1 = mod + 9 * 6144;
    if (G == 256) {
        if (RUN(8)) { pg8::Gemm g{QKV, (const bf16*)(ws + WS_W_DN0), MT, D, DFF}; pg8::StaticOrder S; S.init(MLAT, D, G, bx); pg8::EpiResid2<true> E{AOUT, AOUT, GMI, mod + 5120, GM + 9216, XSB, RSS + MT};
            pg8::gemm_phase<pg8::EpiResid2<true>, pg8::StaticOrder, true, true>(lds, g, S, E); }
        SYNC(8);
        if (RUN(9)) {
            if (bx < 32) { pg8::Gemm g{QKV, (const bf16*)(ws + WS_W_DN0), MT, D, DFF}; pg8::OneUnit S{128 + (bx >> 2), bx & 3, 1}; pg8::EpiResid2<true> E{AOUT, AOUT, GMI, mod + 5120, GM + 9216, XSB, RSS + MT};
                pg8::gemm_phase<pg8::EpiResid2<true>, pg8::OneUnit, true, true>(lds, g, S, E); }
            else { pg8::Gemm g{XSB, (const bf16*)(ws + WS_W_MLIN), MT, NMLP, D}; pg8::XcdPanels S{(bx - 32) & 7, (bx - 32) >> 3, 28, 8, 8, 0, 0, NMLP / 256};
                pg8::EpiMlIn2 E{QKV, GATES, p.in[23], RSS + MT, SHW + 9 * 5632};
                pg8::gemm_phase<pg8::EpiMlIn2, pg8::XcdPanels, true, true>(lds, g, S, E); }
        }
        SYNC(9);
        if (RUN(10)) { pg8::Gemm g{XSB, (const bf16*)(ws + WS_W_MLIN), MT, NMLP, D}; pg8::XcdPanels S{bx & 7, bx >> 3, 32, 9, 8, 64, 128, NMLP / 256};
            pg8::EpiMlIn2 E{QKV, GATES, p.in[23], RSS + MT, SHW + 9 * 5632};
            pg8::gemm_phase<pg8::EpiMlIn2, pg8::XcdPanels, true, true>(lds, g, S, E); }
        SYNC(10);
    } else {
    if (RUN(8)) { pg8::Gemm g{QKV, (const bf16*)(ws + WS_W_DN0), MT, D, DFF}; pg8::StaticOrder S; S.init(MT, D, G, bx); pg8::EpiResid2<true> E{AOUT, AOUT, GMI, mod + 5120, GM + 9216, XSB, RSS + MT};
        pg8::gemm_phase<pg8::EpiResid2<true>, pg8::StaticOrder, true, true>(lds, g, S, E); }
    SYNC(8);
    if (RUN(10)) { pg8::Gemm g{XSB, (const bf16*)(ws + WS_W_MLIN), MT, NMLP, D}; pg8::StaticOrder S; S.init(MT, NMLP, G, bx); pg8::EpiMlIn2 E{QKV, GATES, p.in[23], RSS + MT, SHW + 9 * 5632};
        pg8::gemm_phase<pg8::EpiMlIn2, pg8::StaticOrder, true, true>(lds, g, S, E); }
    SYNC(10);
    }
    if (RUN(11)) shw_compute(p, 2, bx, G, lds, tid, lane, wave);
    if (RUN(11)) for (int rp = 0; rp < NREP(11); ++rp) phase_mlprep(QKV, p.in[21], p.in[22], QKP, CTXQK, lane, wave);
    SYNC(11);
    if (RUN(12)) for (int rp = 0; rp < NREP(12); ++rp) phase_mlscan(QKV, QKP, CTXQK, GATES, SPREV, NPREV, MPREV, lds, tid, lane, wave);
    SYNC(12);
    if (RUN(13)) for (int rp = 0; rp < NREP(13); ++rp) phase_mlout(QKV, QKP, GATES, SPREV, NPREV, MPREV, p.in[24], BUFA, lds, tid, lane, wave);
    SYNC(13);
    if (RUN(14)) { pg8::Gemm g{BUFA, (const bf16*)(ws + WS_W_MLOUT), MLAT, D, D}; pg8::StaticOrder S; S.init(MLAT, D, G, bx); pg8::EpiResid2<true> E{XSB, XSB, GMI + 9216, mod1 + 2048, GM + 2 * 9216, XSA, RSS + 2 * MT};
        pg8::gemm_phase<pg8::EpiResid2<true>, pg8::StaticOrder, true, true>(lds, g, S, E); }
    SYNC(14);
    if (RUN(16)) { pg8::Gemm g{XSA, (const bf16*)(ws + WS_W_GU1), MLAT, 2 * DFF, D}; pg8::StaticOrder S; S.init(MLAT, 2 * DFF, G, bx); pg8::EpiSwiGLU2 E{QKV, DFF, RSS + 2 * MT, SHW + 9 * 5632 + 9 * 3328, 2 * DFF};
        pg8::gemm_phase<pg8::EpiSwiGLU2, pg8::StaticOrder, true, true>(lds, g, S, E); }
    SYNC(16);
    if (RUN(17)) { pg8::Gemm g{QKV, (const bf16*)(ws + WS_W_DN1), MLAT, D, DFF}; pg8::StaticOrder S; S.init(MLAT, D, G, bx); pg8::EpiResid E{XSA, XSA, GMI + 2 * 9216, p.out, mod1 + 5120};
        pg8::gemm_phase<pg8::EpiResid, pg8::StaticOrder, true, true>(lds, g, S, E); }
#undef RUN
#undef SYNC
}

extern "C" void kernel_launch(void* const* d_in, const int* in_sizes, int n_in, void* d_out, int out_size, void* d_ws, size_t ws_size, hipStream_t stream) {
    static int grid = 0;
    if (grid == 0) {
        if (n_in != 26 || out_size != MLAT * D || ws_size < WS_END) { fprintf(stderr, "kernel_launch: unexpected shapes (n_in %d out %d ws %zu)\n", n_in, out_size, ws_size); grid = -1; return; }
        int dev = 0, cus = 0, per_cu = 0;
        hipGetDevice(&dev); hipDeviceGetAttribute(&cus, hipDeviceAttributeMultiprocessorCount, dev);
        hipFuncSetAttribute((const void*)fwd_megakernel, hipFuncAttributeMaxDynamicSharedMemorySize, LDS_BYTES);
        hipOccupancyMaxActiveBlocksPerMultiprocessor(&per_cu, (const void*)fwd_megakernel, NTHR, LDS_BYTES);
        if (per_cu < 1) { fprintf(stderr, "kernel_launch: occupancy query says %d blocks per CU\n", per_cu); per_cu = 1; }
        (void)hipGetLastError();
        grid = cus * per_cu;
    }
    if (grid < 0) return;
    if (hipMemsetAsync((char*)d_ws + WS_BAR, 0, WS_BAR_BYTES, stream) != hipSuccess) { fprintf(stderr, "kernel_launch: memset of barrier words failed\n"); return; }
    Params p{};
    for (int i = 0; i < 26; ++i) p.in[i] = (const float*)d_in[i];
    p.out = (float*)d_out; p.ws = (unsigned char*)d_ws; p.ph_lo = 0; p.ph_hi = 18; p.rep = REPMASK;
    void* args[] = {&p};
    hipError_t e = hipLaunchCooperativeKernel((const void*)fwd_megakernel, dim3(grid), dim3(NTHR), args, LDS_BYTES, stream);
    if (e != hipSuccess) fprintf(stderr, "cooperative launch failed: %s (grid %d)\n", hipGetErrorString(e), grid);
}
```

```cpp
#include <hip/hip_runtime.h>
#include <hip/hip_cooperative_groups.h>
#include <cstdio>
#include <cstdint>
namespace cg = cooperative_groups;
#ifndef REPMASK
#define REPMASK 0
#endif

namespace pg8 {
#define PG8_LAS __attribute__((address_space(3)))
typedef unsigned short bf16_t;
typedef short bf16x8 __attribute__((ext_vector_type(8)));
typedef float f32x4 __attribute__((ext_vector_type(4)));
typedef unsigned u32x4 __attribute__((ext_vector_type(4)));
typedef unsigned u32x2 __attribute__((ext_vector_type(2)));
constexpr int BM = 256, BK = 64, HALF = 128, HTB = HALF * BK * 2  , STAGE_BYTES = 8 * HTB, NXCD = 8, WGM = 4;

__host__ __device__ __forceinline__ int lds_byte(int r, int c) { const int st = (r >> 4) * 2 + (c >> 5), rr = r & 15, cc = c & 31, ob = rr * 64 + cc * 2; return st * 1024 + (ob ^ (((ob >> 9) & 1) << 5)); }
__host__ __device__ __forceinline__ void stage_rc(int b, int& R, int& C) { const int st = b / 1024, sb = b % 1024, swz = sb ^ (((sb >> 9) & 1) << 5); R = (st >> 1) * 16 + swz / 64; C = (st & 1) * 32 + (swz % 64) / 2; }
__host__ __device__ __forceinline__ int perm32(int rho) { const int n = rho >> 4, i = rho & 15; return 8 * (i >> 2) + 4 * n + (i & 3); }

struct Unit { int pm, pn; };
struct Gemm { const bf16_t* A; const bf16_t* Bt; int M, N, K; };

struct StaticOrder {
    int nM, nN, nwg, G, c;
    __host__ __device__ void init(int M, int N, int G_, int c_) { nM = M / BM; nN = N / BM; nwg = nM * nN; G = G_; c = c_; }
    __host__ __device__ bool next(int i, Unit& u) const {
        const long L = (long)i * G + c; if (L >= nwg) return false;
        int wgid = (int)L; { const int q = nwg / NXCD, r = nwg % NXCD, xcd = wgid % NXCD, off = wgid / NXCD; wgid = (xcd < r ? xcd * (q + 1) : r * (q + 1) + (xcd - r) * q) + off; }
        const int nig = WGM * nN, gid = wgid / nig, fm = gid * WGM, gsz = (nM - fm) < WGM ? (nM - fm) : WGM;
        u.pm = fm + ((wgid % nig) % gsz); u.pn = (wgid % nig) / gsz; return true;
    }
    __device__ __forceinline__ void a_ready(const Unit&) const {}
    __device__ __forceinline__ void done(const Unit&) const {}
};


struct OneUnit { int pm, pn, valid;
    __device__ __forceinline__ bool next(int i, Unit& u) const { if (i != 0 || !valid) return false; u.pm = pm; u.pn = pn; return true; }
    __device__ __forceinline__ void a_ready(const Unit&) const {}
    __device__ __forceinline__ void done(const Unit&) const {} };
struct XcdPanels { int x, j, nb, P, PL, pm0, pmx, nN;
    __device__ __forceinline__ bool next(int i, Unit& u) const {
        const int t = i * nb + j; if (j < 0 || t >= P * nN) return false;
        int grp = t / (2 * nN), r = t - grp * 2 * nN; const int gsz = (P - 2 * grp) >= 2 ? 2 : 1;
        const int idx = 2 * grp + (gsz == 2 ? (r & 1) : 0); u.pn = gsz == 2 ? (r >> 1) : r;
        u.pm = idx < PL ? pm0 + x * PL + idx : pmx + x; return true; }
    __device__ __forceinline__ void a_ready(const Unit&) const {}
    __device__ __forceinline__ void done(const Unit&) const {} };

__device__ __forceinline__ unsigned cvt_pk_bf16(float lo, float hi) { unsigned r; asm volatile("v_cvt_pk_bf16_f32 %0, %1, %2" : "=v"(r) : "v"(lo), "v"(hi)); return r; }
__device__ __forceinline__ u32x4 pack8(const f32x4 v0, const f32x4 v1) { u32x4 w; w.x = cvt_pk_bf16(v0[0], v0[1]); w.y = cvt_pk_bf16(v0[2], v0[3]); w.z = cvt_pk_bf16(v1[0], v1[1]); w.w = cvt_pk_bf16(v1[2], v1[3]); return w; }
__device__ __forceinline__ float fast_sigmoid(float x) { return __builtin_amdgcn_rcpf(1.0f + __expf(-x)); }

struct EpiStore {
    static constexpr bool PERM = true, AFTER_DRAIN = false;
    bf16_t* O; int ldc;
    __device__ __forceinline__ void operator()(const f32x4 (&acc)[2][2][4][2], const Unit& u, int wr, int wc, int fr, int fq) const {
        const int row0 = u.pm * BM + wr * 64 + fr, col0 = u.pn * BM + wc * 32 + 8 * fq;
#pragma unroll
        for (int ai = 0; ai < 2; ++ai)
#pragma unroll
            for (int m = 0; m < 4; ++m) { bf16_t* rowp = O + (size_t)(row0 + ai * HALF + m * 16) * ldc + col0;
#pragma unroll
                for (int bj = 0; bj < 2; ++bj) *(u32x4*)(rowp + bj * HALF) = pack8(acc[ai][bj][m][0], acc[ai][bj][m][1]); }
    }
};
struct EpiStoreGLU {
    static constexpr bool PERM = true, AFTER_DRAIN = false;
    bf16_t* O; int ldc;
    __device__ __forceinline__ void operator()(const f32x4 (&acc)[2][2][4][2], const Unit& u, int wr, int wc, int fr, int fq) const {
        const int row0 = u.pm * BM + wr * 64 + fr;
        if (u.pn < 6) {
            const int col0 = u.pn * BM + wc * 32 + 8 * fq;
#pragma unroll
            for (int ai = 0; ai < 2; ++ai)
#pragma unroll
                for (int m = 0; m < 4; ++m) { bf16_t* rowp = O + (size_t)(row0 + ai * HALF + m * 16) * ldc + col0;
#pragma unroll
                    for (int bj = 0; bj < 2; ++bj) *(u32x4*)(rowp + bj * HALF) = pack8(acc[ai][bj][m][0], acc[ai][bj][m][1]); }
        } else {
            const int col0 = 1536 + (u.pn - 6) * HALF + wc * 32 + 8 * fq;
#pragma unroll
            for (int ai = 0; ai < 2; ++ai)
#pragma unroll
                for (int m = 0; m < 4; ++m) { f32x4 o[2];
#pragma unroll
                    for (int n = 0; n < 2; ++n)
#pragma unroll
                        for (int e = 0; e < 4; ++e) o[n][e] = acc[ai][0][m][n][e] * fast_sigmoid(acc[ai][1][m][n][e]);
                    *(u32x4*)(O + (size_t)(row0 + ai * HALF + m * 16) * ldc + col0) = pack8(o[0], o[1]); }
        }
    }
};
struct EpiResid {
    static constexpr bool PERM = true, AFTER_DRAIN = false;
    const bf16_t* res_lat; const bf16_t* res_ctx; const float* rgm; float* out; const float* gate;
    __device__ __forceinline__ void operator()(const f32x4 (&acc)[2][2][4][2], const Unit& u, int wr, int wc, int fr, int fq) const {
        const int base = u.pm * BM; const int bb = base < 32768 ? (base >> 12) : 8; const bf16_t* res = base < 32768 ? res_lat : res_ctx;
        const int row0 = base + wr * 64 + fr, col0 = u.pn * BM + wc * 32 + 8 * fq;
        f32x4 gv[2][2], rgv[2][2];
#pragma unroll
        for (int bj = 0; bj < 2; ++bj)
#pragma unroll
            for (int n = 0; n < 2; ++n) { gv[bj][n] = *(const f32x4*)(gate + (size_t)bb * 6144 + col0 + bj * HALF + 4 * n); rgv[bj][n] = *(const f32x4*)(rgm + (size_t)bb * 1024 + col0 + bj * HALF + 4 * n); }
#pragma unroll
        for (int ai = 0; ai < 2; ++ai)
#pragma unroll
            for (int m = 0; m < 4; ++m) { const size_t ro = (size_t)(row0 + ai * HALF + m * 16) * 1024 + col0;
#pragma unroll
                for (int bj = 0; bj < 2; ++bj)
#pragma unroll
                    for (int n = 0; n < 2; ++n) { const size_t ix = ro + bj * HALF + 4 * n; const u32x2 rw = *(const u32x2*)(res + ix);
                        const f32x4 r = {__builtin_bit_cast(float, rw.x << 16), __builtin_bit_cast(float, rw.x & 0xffff0000u), __builtin_bit_cast(float, rw.y << 16), __builtin_bit_cast(float, rw.y & 0xffff0000u)};
                        *(f32x4*)(out + ix) = r * rgv[bj][n] + gv[bj][n] * acc[ai][bj][m][n]; } }
    }
};
struct EpiSwiGLU {
    static constexpr bool PERM = true, AFTER_DRAIN = false;
    bf16_t* O; int ldc;
    __device__ __forceinline__ void operator()(const f32x4 (&acc)[2][2][4][2], const Unit& u, int wr, int wc, int fr, int fq) const {
        const int row0 = u.pm * BM + wr * 64 + fr, col0 = u.pn * HALF + wc * 32 + 8 * fq;
#pragma unroll
        for (int ai = 0; ai < 2; ++ai)
#pragma unroll
            for (int m = 0; m < 4; ++m) {
                f32x4 o[2];
#pragma unroll
                for (int n = 0; n < 2; ++n)
#pragma unroll
                    for (int e = 0; e < 4; ++e) { const float g = acc[ai][0][m][n][e], up = acc[ai][1][m][n][e]; o[n][e] = g * fast_sigmoid(g) * up; }
                *(u32x4*)(O + (size_t)(row0 + ai * HALF + m * 16) * ldc + col0) = pack8(o[0], o[1]);
            }
    }
};
struct EpiMlIn {
    static constexpr bool PERM = true, AFTER_DRAIN = false;
    bf16_t* O; float* gates; const float* gate_b;
    __device__ __forceinline__ void operator()(const f32x4 (&acc)[2][2][4][2], const Unit& u, int wr, int wc, int fr, int fq) const {
        const int row0 = u.pm * BM + wr * 64 + fr;
        if (u.pn < 12) {
            const int col0 = u.pn * BM + wc * 32 + 8 * fq;
#pragma unroll
            for (int ai = 0; ai < 2; ++ai)
#pragma unroll
                for (int m = 0; m < 4; ++m) { bf16_t* rowp = O + (size_t)(row0 + ai * HALF + m * 16) * 3072 + col0;
#pragma unroll
                    for (int bj = 0; bj < 2; ++bj) *(u32x4*)(rowp + bj * HALF) = pack8(acc[ai][bj][m][0], acc[ai][bj][m][1]); }
        } else if (wc == 0) {
            const int col0 = 8 * fq;
#pragma unroll
            for (int ai = 0; ai < 2; ++ai)
#pragma unroll
                for (int m = 0; m < 4; ++m)
#pragma unroll
                    for (int n = 0; n < 2; ++n) { f32x4 v = acc[ai][0][m][n] + *(const f32x4*)(gate_b + col0 + 4 * n);
                        if (col0 >= 16) {
#pragma unroll
                            for (int e = 0; e < 4; ++e) { const float x = v[e]; v[e] = fminf(x, 0.f) - log1pf(__expf(-fabsf(x))); } }
                        *(f32x4*)(gates + (size_t)(row0 + ai * HALF + m * 16) * 32 + col0 + 4 * n) = v; }
        }
    }
};


template <bool RES_SCALED> struct EpiResid2 {
    static constexpr bool PERM = true, AFTER_DRAIN = false;
    const void* res_lat; const void* res_ctx; const float* rgm; const float* gate; const float* gm; bf16_t* A2; float* rss;
    __device__ __forceinline__ void operator()(const f32x4 (&acc)[2][2][4][2], const Unit& u, int wr, int wc, int fr, int fq) const {
        const int base = u.pm * BM; const int bb = base < 32768 ? (base >> 12) : 8; const void* res = base < 32768 ? res_lat : res_ctx;
        const int row0 = base + wr * 64 + fr, col0 = u.pn * BM + wc * 32 + 8 * fq;
        f32x4 gv[2][2], gmv[2][2], rgv[2][2];
#pragma unroll
        for (int bj = 0; bj < 2; ++bj)
#pragma unroll
            for (int n = 0; n < 2; ++n) { gv[bj][n] = *(const f32x4*)(gate + (size_t)bb * 6144 + col0 + bj * HALF + 4 * n); gmv[bj][n] = *(const f32x4*)(gm + (size_t)bb * 1024 + col0 + bj * HALF + 4 * n);
                if constexpr (RES_SCALED) rgv[bj][n] = *(const f32x4*)(rgm + (size_t)bb * 1024 + col0 + bj * HALF + 4 * n); else rgv[bj][n] = (f32x4){1.f, 1.f, 1.f, 1.f}; }
#pragma unroll
        for (int ai = 0; ai < 2; ++ai)
#pragma unroll
            for (int m = 0; m < 4; ++m) { const int row = row0 + ai * HALF + m * 16; const size_t ro = (size_t)row * 1024 + col0; float ss = 0.f;
#pragma unroll
                for (int bj = 0; bj < 2; ++bj) { f32x4 r[2];
                    if constexpr (RES_SCALED) { const u32x4 rw = *(const u32x4*)((const bf16_t*)res + ro + bj * HALF);
                        r[0] = (f32x4){__builtin_bit_cast(float, rw.x << 16), __builtin_bit_cast(float, rw.x & 0xffff0000u), __builtin_bit_cast(float, rw.y << 16), __builtin_bit_cast(float, rw.y & 0xffff0000u)} * rgv[bj][0];
                        r[1] = (f32x4){__builtin_bit_cast(float, rw.z << 16), __builtin_bit_cast(float, rw.z & 0xffff0000u), __builtin_bit_cast(float, rw.w << 16), __builtin_bit_cast(float, rw.w & 0xffff0000u)} * rgv[bj][1]; }
                    else { r[0] = *(const f32x4*)((const float*)res + ro + bj * HALF); r[1] = *(const f32x4*)((const float*)res + ro + bj * HALF + 4); }
                    f32x4 o[2];
#pragma unroll
                    for (int n = 0; n < 2; ++n) { o[n] = r[n] + gv[bj][n] * acc[ai][bj][m][n]; ss += (o[n][0] * o[n][0] + o[n][1] * o[n][1]) + (o[n][2] * o[n][2] + o[n][3] * o[n][3]); }
                    *(u32x4*)(A2 + ro + bj * HALF) = pack8(o[0] * gmv[bj][0], o[1] * gmv[bj][1]); }
                ss += __shfl_xor(ss, 16); ss += __shfl_xor(ss, 32);
                if (fq == 0) (void)__hip_atomic_fetch_add(rss + row, ss, __ATOMIC_RELAXED, __HIP_MEMORY_SCOPE_AGENT); }
    }
};
struct EpiSwiGLU2 {
    static constexpr bool PERM = true, AFTER_DRAIN = false;
    bf16_t* O; int ldc; const float* rss; const float* shw; int ldn;
    __device__ __forceinline__ void operator()(const f32x4 (&acc)[2][2][4][2], const Unit& u, int wr, int wc, int fr, int fq) const {
        const int base = u.pm * BM; const int bb = base < 32768 ? (base >> 12) : 8;
        const int row0 = base + wr * 64 + fr, col0 = u.pn * HALF + wc * 32 + 8 * fq, bcol0 = u.pn * BM + wc * 32 + 8 * fq;
        f32x4 sg[2], su[2];
#pragma unroll
        for (int n = 0; n < 2; ++n) { sg[n] = *(const f32x4*)(shw + (size_t)bb * ldn + bcol0 + 4 * n); su[n] = *(const f32x4*)(shw + (size_t)bb * ldn + bcol0 + HALF + 4 * n); }
#pragma unroll
        for (int ai = 0; ai < 2; ++ai)
#pragma unroll
            for (int m = 0; m < 4; ++m) { const int row = row0 + ai * HALF + m * 16; const float rstd = rsqrtf(rss[row] * (1.f / 1024.f) + 1e-6f);
                f32x4 o[2];
#pragma unroll
                for (int n = 0; n < 2; ++n)
#pragma unroll
                    for (int e = 0; e < 4; ++e) { const float g = acc[ai][0][m][n][e] * rstd + sg[n][e], up = acc[ai][1][m][n][e] * rstd + su[n][e]; o[n][e] = g * fast_sigmoid(g) * up; }
                *(u32x4*)(O + (size_t)row * ldc + col0) = pack8(o[0], o[1]);
            }
    }
};
struct EpiMlIn2 {
    static constexpr bool PERM = true, AFTER_DRAIN = false;
    bf16_t* O; float* gates; const float* gate_b; const float* rss; const float* shw;
    __device__ __forceinline__ void operator()(const f32x4 (&acc)[2][2][4][2], const Unit& u, int wr, int wc, int fr, int fq) const {
        const int base = u.pm * BM; const int bb = base < 32768 ? (base >> 12) : 8;
        const int row0 = base + wr * 64 + fr;
        if (u.pn < 12) {
            const int col0 = u.pn * BM + wc * 32 + 8 * fq;
            f32x4 sv[2][2];
#pragma unroll
            for (int bj = 0; bj < 2; ++bj)
#pragma unroll
                for (int n = 0; n < 2; ++n) sv[bj][n] = *(const f32x4*)(shw + (size_t)bb * 3328 + col0 + bj * HALF + 4 * n);
#pragma unroll
            for (int ai = 0; ai < 2; ++ai)
#pragma unroll
                for (int m = 0; m < 4; ++m) { const int row = row0 + ai * HALF + m * 16; const float rstd = rsqrtf(rss[row] * (1.f / 1024.f) + 1e-6f); bf16_t* rowp = O + (size_t)row * 3072 + col0;
#pragma unroll
                    for (int bj = 0; bj < 2; ++bj) *(u32x4*)(rowp + bj * HALF) = pack8(acc[ai][bj][m][0] * rstd + sv[bj][0], acc[ai][bj][m][1] * rstd + sv[bj][1]); }
        } else if (wc == 0) {
            const int col0 = 8 * fq;
#pragma unroll
            for (int ai = 0; ai < 2; ++ai)
#pragma unroll
                for (int m = 0; m < 4; ++m) { const int row = row0 + ai * HALF + m * 16; const float rstd = rsqrtf(rss[row] * (1.f / 1024.f) + 1e-6f);
#pragma unroll
                    for (int n = 0; n < 2; ++n) { f32x4 v = acc[ai][0][m][n] * rstd + *(const f32x4*)(shw + (size_t)bb * 3328 + 3072 + col0 + 4 * n) + *(const f32x4*)(gate_b + col0 + 4 * n);
                        if (col0 >= 16) {
#pragma unroll
                            for (int e = 0; e < 4; ++e) { const float x = v[e]; v[e] = fminf(x, 0.f) - log1pf(__expf(-fabsf(x))); } }
                        *(f32x4*)(gates + (size_t)row * 32 + col0 + 4 * n) = v; } }
        }
    }
};

template <class Epi, class Sched, bool ALIGN_EPI = false, bool SP2 = false>
__device__ __forceinline__ void gemm_phase(PG8_LAS unsigned char* lds, const Gemm g, const Sched& S, const Epi& E) {
    const int tid = threadIdx.x, wid = __builtin_amdgcn_readfirstlane(tid >> 6), lane = tid & 63, wr = wid >> 2, wc = wid & 3, fr = lane & 15, fq = lane >> 4;
    const int K = g.K, nt = K / BK;
    unsigned voffA[2], voffB[2];
#pragma unroll
    for (int i = 0; i < 2; ++i) { int R, C; stage_rc(tid * 16 + i * 8192, R, C); const int Rb = Epi::PERM ? ((R & ~31) + perm32(R & 31)) : R;
        voffA[i] = (unsigned)(R * K + C) * 2u; voffB[i] = (unsigned)(Rb * K + C) * 2u; }
    const size_t kstep = (size_t)(BK * 2);
    const size_t hstep = (size_t)HALF * K * 2;
    const size_t tstep = 2 * hstep;
    const unsigned ldsw = (unsigned)wid * 1024u;
    const int aoff = lds_byte(wr * 64 + fr, fq * 8), boff = lds_byte(wc * 32 + fr, fq * 8);
#define PG8_SA(b, h) (((b) * 2 + (h)) * HTB)
#define PG8_SB(b, h) ((4 + (b) * 2 + (h)) * HTB)
#define PG8_STAGE(bufoff, gbase, voff) do { _Pragma("unroll") for (int _i = 0; _i < 2; ++_i) \
        __builtin_amdgcn_global_load_lds((const unsigned*)((const char*)(gbase) + (voff)[_i]), (PG8_LAS unsigned*)(lds + (bufoff) + ldsw + _i * 8192), 16, 0, 0); } while (0)
#define PG8_LDA(dst, b, h) do { _Pragma("unroll") for (int m = 0; m < 4; ++m) _Pragma("unroll") for (int k = 0; k < 2; ++k) dst[m][k] = *(const PG8_LAS bf16x8*)(lds + PG8_SA(b, h) + aoff + m * 2048 + k * 1024); } while (0)
#define PG8_LDB(dst, b, h) do { _Pragma("unroll") for (int n = 0; n < 2; ++n) _Pragma("unroll") for (int k = 0; k < 2; ++k) dst[n][k] = *(const PG8_LAS bf16x8*)(lds + PG8_SB(b, h) + boff + n * 2048 + k * 1024); } while (0)
#define PG8_MMA(ai, bj, At, Bt) do { __builtin_amdgcn_s_setprio(1); _Pragma("unroll") for (int m = 0; m < 4; ++m) _Pragma("unroll") for (int n = 0; n < 2; ++n) _Pragma("unroll") for (int k = 0; k < 2; ++k) \
        acc[ai][bj][m][n] = __builtin_amdgcn_mfma_f32_16x16x32_bf16(Bt[n][k], At[m][k], acc[ai][bj][m][n], 0, 0, 0); __builtin_amdgcn_s_setprio(0); } while (0)
#define PG8_WAIT_V(n) asm volatile("s_waitcnt vmcnt(" #n ")" ::: "memory")
#define PG8_WAIT_L(n) asm volatile("s_waitcnt lgkmcnt(" #n ")" ::: "memory")
#define PG8_BAR __builtin_amdgcn_s_barrier()
#define PG8_SCHED __builtin_amdgcn_sched_barrier(0)
    Unit cur, nxt; int ui = 0;
    if (!S.next(0, cur)) return;
    f32x4 acc[2][2][4][2];
#pragma unroll
    for (int a = 0; a < 2; ++a)
#pragma unroll
        for (int b = 0; b < 2; ++b)
#pragma unroll
            for (int m = 0; m < 4; ++m)
#pragma unroll
                for (int n = 0; n < 2; ++n) acc[a][b][m][n] = (f32x4){0.f, 0.f, 0.f, 0.f};
    bf16x8 At[4][2], B0[2][2], B1[2][2];
    const char* cA = (const char*)g.A + (size_t)cur.pm * tstep; const char* cB = (const char*)g.Bt + (size_t)cur.pn * tstep;
    S.a_ready(cur);
    if constexpr (SP2) {
        PG8_STAGE(PG8_SB(0, 0), cB, voffB); PG8_STAGE(PG8_SB(0, 1), cB + hstep, voffB); PG8_STAGE(PG8_SA(0, 0), cA, voffA); PG8_STAGE(PG8_SA(0, 1), cA + hstep, voffA);
        if (wr == 1) PG8_BAR;
        PG8_WAIT_V(2); PG8_BAR;
        PG8_STAGE(PG8_SB(1, 0), cB + kstep, voffB); PG8_STAGE(PG8_SA(1, 0), cA + kstep, voffA); PG8_STAGE(PG8_SB(1, 1), cB + hstep + kstep, voffB);
        PG8_WAIT_V(6); PG8_BAR;
    } else {
        PG8_STAGE(PG8_SB(0, 0), cB, voffB); PG8_STAGE(PG8_SA(0, 0), cA, voffA); PG8_STAGE(PG8_SB(0, 1), cB + hstep, voffB); PG8_STAGE(PG8_SA(0, 1), cA + hstep, voffA);
        if (wr == 1) PG8_BAR;
        PG8_WAIT_V(4); PG8_BAR;
        PG8_STAGE(PG8_SB(1, 0), cB + kstep, voffB); PG8_STAGE(PG8_SA(1, 0), cA + kstep, voffA); PG8_STAGE(PG8_SB(1, 1), cB + hstep + kstep, voffB);
        PG8_WAIT_V(6); PG8_BAR;
    }
    for (;;) {
        const bool has_next = S.next(ui + 1, nxt);
        const char* nA = has_next ? (const char*)g.A + (size_t)nxt.pm * tstep : cA; const char* nB = has_next ? (const char*)g.Bt + (size_t)nxt.pn * tstep : cB;
        for (int t = 0; t < nt; t += 2) {
            const bool last = (t == nt - 2);
            const char* a1 = cA + (size_t)(t + 1) * kstep;
            const char* a2 = last ? nA : cA + (size_t)(t + 2) * kstep; const char* b2 = last ? nB : cB + (size_t)(t + 2) * kstep;
            const char* a3 = a2 + kstep; const char* b3 = b2 + kstep;
            if (last && has_next) S.a_ready(nxt);
            if constexpr (SP2) {
            PG8_LDB(B0, 0, 0); PG8_LDB(B1, 0, 1); PG8_SCHED; PG8_LDA(At, 0, 0); PG8_STAGE(PG8_SA(1, 1), a1 + hstep, voffA);
            PG8_WAIT_V(8); PG8_WAIT_L(0); PG8_BAR; PG8_MMA(0, 0, At, B0); PG8_MMA(0, 1, At, B1); PG8_BAR; PG8_SCHED;
            PG8_LDA(At, 0, 1); PG8_STAGE(PG8_SB(0, 0), b2, voffB); PG8_STAGE(PG8_SB(0, 1), b2 + hstep, voffB); PG8_STAGE(PG8_SA(0, 0), a2, voffA);
            PG8_WAIT_V(8); PG8_WAIT_L(0); PG8_BAR; PG8_MMA(1, 0, At, B0); PG8_MMA(1, 1, At, B1); PG8_BAR; PG8_SCHED;
            PG8_LDB(B0, 1, 0); PG8_LDB(B1, 1, 1); PG8_SCHED; PG8_LDA(At, 1, 0); PG8_STAGE(PG8_SA(0, 1), a2 + hstep, voffA);
            PG8_WAIT_V(8); PG8_WAIT_L(0); PG8_BAR; PG8_MMA(0, 0, At, B0); PG8_MMA(0, 1, At, B1); PG8_BAR; PG8_SCHED;
            PG8_LDA(At, 1, 1); PG8_STAGE(PG8_SB(1, 0), b3, voffB); PG8_STAGE(PG8_SB(1, 1), b3 + hstep, voffB); PG8_STAGE(PG8_SA(1, 0), a3, voffA);
            PG8_WAIT_V(8); PG8_WAIT_L(0); PG8_BAR; PG8_MMA(1, 0, At, B0); PG8_MMA(1, 1, At, B1); PG8_BAR; PG8_SCHED;
            } else {
            PG8_LDB(B0, 0, 0); PG8_SCHED; PG8_LDA(At, 0, 0); PG8_STAGE(PG8_SA(1, 1), a1 + hstep, voffA);
            PG8_WAIT_L(8); PG8_BAR; PG8_WAIT_L(0); PG8_MMA(0, 0, At, B0); PG8_BAR; PG8_SCHED;
            PG8_LDB(B1, 0, 1); PG8_STAGE(PG8_SB(0, 0), b2, voffB);
            PG8_BAR; PG8_WAIT_L(0); PG8_MMA(0, 1, At, B1); PG8_BAR;
            PG8_LDA(At, 0, 1); PG8_STAGE(PG8_SA(0, 0), a2, voffA);
            PG8_BAR; PG8_WAIT_L(0); PG8_MMA(1, 0, At, B0); PG8_BAR; PG8_SCHED;
            PG8_STAGE(PG8_SB(0, 1), b2 + hstep, voffB);
            PG8_WAIT_V(6); PG8_BAR; PG8_MMA(1, 1, At, B1); PG8_BAR;
            PG8_LDB(B0, 1, 0); PG8_SCHED; PG8_LDA(At, 1, 0); PG8_STAGE(PG8_SA(0, 1), a2 + hstep, voffA);
            PG8_WAIT_L(8); PG8_BAR; PG8_WAIT_L(0); PG8_MMA(0, 0, At, B0); PG8_BAR; PG8_SCHED;
            PG8_LDB(B1, 1, 1); PG8_STAGE(PG8_SB(1, 0), b3, voffB);
            PG8_BAR; PG8_WAIT_L(0); PG8_MMA(0, 1, At, B1); PG8_BAR;
            PG8_LDA(At, 1, 1); PG8_STAGE(PG8_SA(1, 0), a3, voffA);
            PG8_BAR; PG8_WAIT_L(0); PG8_MMA(1, 0, At, B0); PG8_BAR; PG8_SCHED;
            PG8_STAGE(PG8_SB(1, 1), b3 + hstep, voffB);
            PG8_WAIT_V(6); PG8_BAR; PG8_MMA(1, 1, At, B1); PG8_BAR;
            }
        }
        if constexpr (ALIGN_EPI) { if (wr == 0) PG8_BAR; }
        if constexpr (!Epi::AFTER_DRAIN) { E(acc, cur, wr, wc, fr, fq); S.done(cur); }
        if (!has_next) break;
#pragma unroll
        for (int a = 0; a < 2; ++a)
#pragma unroll
            for (int b = 0; b < 2; ++b)
#pragma unroll
                for (int m = 0; m < 4; ++m)
#pragma unroll
                    for (int n = 0; n < 2; ++n) acc[a][b][m][n] = (f32x4){0.f, 0.f, 0.f, 0.f};
        cur = nxt; cA = nA; cB = nB; ++ui;
        if constexpr (ALIGN_EPI) { if (wr == 1) PG8_BAR; }
    }
    PG8_WAIT_V(0);
    if constexpr (!ALIGN_EPI) { if (wr == 0) PG8_BAR; }
    PG8_BAR;
    if constexpr (Epi::AFTER_DRAIN) { E.fused(acc, cur, wr, wc, fr, fq, lds, wid, lane); S.done(cur); }
#undef PG8_SA
#undef PG8_SB
#undef PG8_STAGE
#undef PG8_LDA
#undef PG8_LDB
#undef PG8_MMA
#undef PG8_WAIT_V
#undef PG8_WAIT_L
#undef PG8_BAR
#undef PG8_SCHED
}
}

constexpr int D = 1024, NB = 8, TL = 4096, NCTX = 256, MLAT = NB * TL, MCTX = NB * NCTX, MT = MLAT + MCTX;
constexpr int DFF = 2816, NAB = 2560, NML = 3104, NMLP = 3328, LDQ0 = 2048, LDQ1 = 3072;
constexpr int NTHR = 512, NWAVES = 8;
constexpr float EPS = 1e-6f;
constexpr size_t MiB = 1u << 20;
constexpr size_t WS_MOD = 0;
constexpr size_t WS_W_ABIN = 1 * MiB, WS_W_ABOUT = 6 * MiB, WS_W_GU0 = 8 * MiB, WS_W_GU1 = 19 * MiB, WS_W_DN0 = 30 * MiB, WS_W_DN1 = 36 * MiB, WS_W_MLIN = 42 * MiB, WS_W_MLOUT = 49 * MiB;
constexpr size_t WS_BUFA = 52 * MiB;
constexpr size_t WS_XS = 120 * MiB;
constexpr size_t WS_QKV = 256 * MiB;
constexpr size_t WS_GATES = 460 * MiB;
constexpr size_t WS_CTXQK = 466 * MiB;
constexpr size_t WS_NPREV = 471 * MiB;
constexpr size_t WS_MPREV = 473 * MiB;
constexpr size_t WS_RSS = 474 * MiB;
constexpr size_t WS_SHW = 475 * MiB;
constexpr size_t WS_GM = 476 * MiB;
constexpr size_t WS_END = 477 * MiB;
constexpr size_t WS_BAR = 512 * 1024;
constexpr size_t WS_BAR_BYTES = 16384;
constexpr int LDS_BYTES = 147456;
constexpr int LDS_XB_OFF = 131072 + 256;

#define LAS __attribute__((address_space(3)))
typedef unsigned short bf16;
typedef short bf16x8 __attribute__((ext_vector_type(8)));
typedef short s16x4 __attribute__((ext_vector_type(4)));
typedef float f32x4 __attribute__((ext_vector_type(4)));
typedef unsigned u32x4 __attribute__((ext_vector_type(4)));
typedef unsigned u32x2 __attribute__((ext_vector_type(2)));

__device__ __forceinline__ float bf2f(unsigned h) { return __builtin_bit_cast(float, h << 16); }
__device__ __forceinline__ float bflo(unsigned w) { return __builtin_bit_cast(float, w << 16); }
__device__ __forceinline__ float bfhi(unsigned w) { return __builtin_bit_cast(float, w & 0xffff0000u); }
__device__ __forceinline__ unsigned f2bf(float f) { unsigned u = __builtin_bit_cast(unsigned, f); return (u + 0x7fffu + ((u >> 16) & 1u)) >> 16; }
typedef float f32x2_t __attribute__((ext_vector_type(2))); typedef __bf16 bf16x2_t __attribute__((ext_vector_type(2)));
__device__ __forceinline__ unsigned pk2(float lo, float hi) { const f32x2_t v = {lo, hi}; const bf16x2_t b = __builtin_convertvector(v, bf16x2_t); return __builtin_bit_cast(unsigned, b); }
__device__ __forceinline__ float wave_sum(float v) {
#pragma unroll
    for (int o = 1; o < 64; o <<= 1) v += __shfl_xor(v, o);
    return v;
}
__device__ __forceinline__ float wave_max(float v) {
#pragma unroll
    for (int o = 1; o < 64; o <<= 1) v = fmaxf(v, __shfl_xor(v, o));
    return v;
}
__device__ __forceinline__ float fast_sig(float x) { return __builtin_amdgcn_rcpf(1.0f + __expf(-x)); }
__device__ __forceinline__ float silu_f(float x) { return x * __builtin_amdgcn_rcpf(1.0f + __expf(-x)); }
__device__ __forceinline__ void unpack8(const u32x4 w, float (&f)[8]) { f[0] = bflo(w.x); f[1] = bfhi(w.x); f[2] = bflo(w.y); f[3] = bfhi(w.y); f[4] = bflo(w.z); f[5] = bfhi(w.z); f[6] = bflo(w.w); f[7] = bfhi(w.w); }
__device__ __forceinline__ u32x4 pack8f(const float (&f)[8]) { u32x4 w; w.x = pk2(f[0], f[1]); w.y = pk2(f[2], f[3]); w.z = pk2(f[4], f[5]); w.w = pk2(f[6], f[7]); return w; }
typedef short v4i16_t __attribute__((ext_vector_type(4)));
__device__ __forceinline__ s16x4 trread(const LAS char* p) { return __builtin_bit_cast(s16x4, __builtin_amdgcn_ds_read_tr16_b64_v4i16((LAS v4i16_t*)p)); }
__device__ __forceinline__ bf16x8 cat44(const s16x4 a, const s16x4 b) { bf16x8 r; r[0] = a[0]; r[1] = a[1]; r[2] = a[2]; r[3] = a[3]; r[4] = b[0]; r[5] = b[1]; r[6] = b[2]; r[7] = b[3]; return r; }
#define MFMA16(a, b, c) __builtin_amdgcn_mfma_f32_16x16x32_bf16((a), (b), (c), 0, 0, 0)

struct Params {
    const float* in[26]; float* out; unsigned char* ws; int ph_lo, ph_hi; int rep, pad;
};
typedef const float* const __attribute__((address_space(4)))* kin_ptr_t;
__device__ __forceinline__ kin_ptr_t kin() { kin_ptr_t q = (kin_ptr_t)__builtin_amdgcn_kernarg_segment_ptr(); asm volatile("" : "+s"(q)); return q; }

__device__ __forceinline__ void transpose_matrix(const float* W, int K, int N, bf16* WT, int kind, LAS float* scr, int gw, int NGW, int lane, int& start) {
    const int nblk = N / 32, items = nblk * (K / 64);
    int first = gw - start; if (first < 0) first += NGW;
    for (int it = first; it < items; it += NGW) {
        const int kb = it / nblk, nb = it % nblk, k0 = 64 * kb, n0 = 32 * nb;
        { const int kr = lane >> 3, nc = lane & 7; f32x4 v[8];
#pragma unroll
          for (int i = 0; i < 8; ++i) v[i] = *(const f32x4*)(W + (size_t)(k0 + 8 * i + kr) * N + n0 + 4 * nc);
#pragma unroll
          for (int i = 0; i < 8; ++i) { LAS float* sp = scr + (8 * i + kr) * 33 + 4 * nc; sp[0] = v[i][0]; sp[1] = v[i][1]; sp[2] = v[i][2]; sp[3] = v[i][3]; } }
        asm volatile("s_waitcnt lgkmcnt(0)" ::: "memory");
        const int drow0 = kind == 0 ? n0 : (kind == 3 ? (n0 < 1536 ? n0 : (n0 < 2048 ? 1536 + ((n0 - 1536) >> 7) * 256 + ((n0 - 1536) & 127) : 1536 + ((n0 - 2048) >> 7) * 256 + 128 + ((n0 - 2048) & 127)))
                                                  : ((n0 >> 7) * 256 + (kind == 2 ? 128 : 0) + (n0 & 127)));
        const int c = lane & 7;
#pragma unroll
        for (int j = 0; j < 4; ++j) { const int n = (lane >> 3) + 8 * j; const LAS float* s = scr + (8 * c) * 33 + n;
            u32x4 o; o.x = pk2(s[0 * 33], s[1 * 33]); o.y = pk2(s[2 * 33], s[3 * 33]); o.z = pk2(s[4 * 33], s[5 * 33]); o.w = pk2(s[6 * 33], s[7 * 33]);
            *(u32x4*)(WT + (size_t)(drow0 + n) * K + k0 + 8 * c) = o; }
        asm volatile("s_waitcnt lgkmcnt(0)" ::: "memory");
    }
    start = (start + items) % NGW;
}

__device__ __forceinline__ void phase_prologue(const Params& p, LAS unsigned char* lds, int tid, int lane, int wave) {
    unsigned char* ws = p.ws;
    const int gw = blockIdx.x * NWAVES + wave, NGW = gridDim.x * NWAVES;
    LAS float* scr = (LAS float*)(lds + wave * 8704);
    int start = 0;
    transpose_matrix(kin()[11], D, NAB, (bf16*)(ws + WS_W_ABIN), 3, scr, gw, NGW, lane, start);
    __syncthreads();
    LAS float* sv = (LAS float*)lds;
    LAS float* part = (LAS float*)(lds + 40960);
    for (int i = tid; i < 9 * 1024; i += NTHR) { const float c = i < 8192 ? kin()[1][i] : kin()[3][i - 8192]; sv[i] = silu_f(c); }
    __syncthreads();
    float* mod = (float*)(ws + WS_MOD);
    for (int item = blockIdx.x; item < 192; item += gridDim.x) {
        const int l = item / 96, cgp = item % 96, col = cgp * 64 + lane;
        const float* W = kin()[4] + (size_t)l * D * 6144 + col;
        float a[9];
#pragma unroll
        for (int b = 0; b < 9; ++b) a[b] = 0.f;
#pragma unroll 16
        for (int k = wave * 128; k < wave * 128 + 128; ++k) { const float wv = W[(size_t)k * 6144];
#pragma unroll
            for (int b = 0; b < 9; ++b) a[b] += sv[b * 1024 + k] * wv; }
#pragma unroll
        for (int b = 0; b < 9; ++b) part[(wave * 9 + b) * 64 + lane] = a[b];
        __syncthreads();
        for (int i = tid; i < 576; i += NTHR) { const int b = i >> 6, ln = i & 63; float s = 0.f;
#pragma unroll
            for (int w = 0; w < 8; ++w) s += part[(w * 9 + b) * 64 + ln];
            mod[(size_t)(l * 9 + b) * 6144 + cgp * 64 + ln] = s + kin()[5][l * 6144 + cgp * 64 + ln]; }
        __syncthreads();
    }
}


__device__ __forceinline__ void phase_aux(const Params& p, LAS unsigned char* lds, int tid, int lane, int wave) {
    unsigned char* ws = p.ws; const float* mod = (const float*)(ws + WS_MOD);
    const int gt = blockIdx.x * NTHR + tid, NGT = gridDim.x * NTHR;
    const int gw = blockIdx.x * NWAVES + wave, NGW = gridDim.x * NWAVES;
    float* rss = (float*)(ws + WS_RSS); for (int i = gt; i < 3 * MT; i += NGT) rss[i] = 0.f;
    float* gm = (float*)(ws + WS_GM);
    for (int i = gt; i < 3 * 9 * 1024; i += NGT) { const int s = i / 9216, r = i % 9216, bb = r >> 10, k = r & 1023;
        const float* ng = s == 1 ? kin()[6] + D : (s == 0 ? kin()[7] : kin()[7] + D); const int l = s == 0 ? 0 : 1; const int sc_off = s == 1 ? 1024 : 4096;
        const float gmv_ = ng[k] * (1.0f + mod[(size_t)(l * 9 + bb) * 6144 + sc_off + k]); gm[i] = gmv_; gm[3 * 9216 + i] = fabsf(gmv_) > 1e-30f ? 1.0f / gmv_ : 0.f; }
    __syncthreads();
}
__device__ __forceinline__ void shw_compute(const Params& p, int s, int rank, int nblk, LAS unsigned char* lds, int tid, int lane, int wave) {
    unsigned char* ws = p.ws; const float* mod = (const float*)(ws + WS_MOD);
    const int gw = rank * NWAVES + wave, NGW = nblk * NWAVES;
    LAS float* shl = (LAS float*)lds;
    float* shw = (float*)(ws + WS_SHW);
    const int l = s == 0 ? 0 : 1, sh_off = s == 1 ? 0 : 3072, N = s == 1 ? NMLP : 2 * DFF;
    const bf16* Wt = (const bf16*)(ws + (s == 0 ? WS_W_GU0 : (s == 1 ? WS_W_MLIN : WS_W_GU1)));
    float* dst = shw + (s == 0 ? 0 : (s == 1 ? 9 * 5632 : 9 * 5632 + 9 * 3328));
    __syncthreads();
    for (int i = tid; i < 9 * 1024; i += NTHR) shl[i] = mod[(size_t)(l * 9 + (i >> 10)) * 6144 + sh_off + (i & 1023)];
    __syncthreads();
    for (int n = gw; n < N; n += NGW) {
        float w[16]; { const u32x4* wp = (const u32x4*)(Wt + (size_t)n * D + lane * 16); float t8[8]; unpack8(wp[0], t8);
#pragma unroll
            for (int e = 0; e < 8; ++e) w[e] = t8[e];
            unpack8(wp[1], t8);
#pragma unroll
            for (int e = 0; e < 8; ++e) w[8 + e] = t8[e]; }
        float res = 0.f;
#pragma unroll
        for (int bb = 0; bb < 9; ++bb) { float a = 0.f; const LAS f32x4* sp = (const LAS f32x4*)(shl + bb * 1024 + lane * 16);
#pragma unroll
            for (int j = 0; j < 4; ++j) { const f32x4 sv = sp[j]; a += (w[4 * j] * sv[0] + w[4 * j + 1] * sv[1]) + (w[4 * j + 2] * sv[2] + w[4 * j + 3] * sv[3]); }
            a = wave_sum(a); if (lane == bb) res = a; }
        if (lane < 9) dst[(size_t)lane * N + n] = res;
    }
    __syncthreads();
}
__device__ __forceinline__ void side_weights(const Params& p, int set, int rank, int nblk, LAS unsigned char* lds, int tid, int lane, int wave) {
    unsigned char* ws = p.ws;
    const int gw = rank * NWAVES + wave, NGW = nblk * NWAVES;
    LAS float* scr = (LAS float*)(lds + wave * 8704);
    int start = 0;
    if (set == 0) {
        transpose_matrix(kin()[19], D, D, (bf16*)(ws + WS_W_ABOUT), 0, scr, gw, NGW, lane, start);
        transpose_matrix(kin()[8], D, DFF, (bf16*)(ws + WS_W_GU0), 1, scr, gw, NGW, lane, start);
        transpose_matrix(kin()[9], D, DFF, (bf16*)(ws + WS_W_GU0), 2, scr, gw, NGW, lane, start);
    } else if (set == 1) {
        transpose_matrix(kin()[10], DFF, D, (bf16*)(ws + WS_W_DN0), 0, scr, gw, NGW, lane, start);
        transpose_matrix(kin()[20], D, NML, (bf16*)(ws + WS_W_MLIN), 0, scr, gw, NGW, lane, start);
        u32x4* z = (u32x4*)(ws + WS_W_MLIN + (size_t)NML * D * 2); const int n16 = (NMLP - NML) * D * 2 / 16;
        for (int i = rank * NTHR + tid; i < n16; i += nblk * NTHR) z[i] = (u32x4){0u, 0u, 0u, 0u};
    } else {
        transpose_matrix(kin()[25], D, D, (bf16*)(ws + WS_W_MLOUT), 0, scr, gw, NGW, lane, start);
        transpose_matrix(kin()[8] + (size_t)D * DFF, D, DFF, (bf16*)(ws + WS_W_GU1), 1, scr, gw, NGW, lane, start);
        transpose_matrix(kin()[9] + (size_t)D * DFF, D, DFF, (bf16*)(ws + WS_W_GU1), 2, scr, gw, NGW, lane, start);
        transpose_matrix(kin()[10] + (size_t)DFF * D, DFF, D, (bf16*)(ws + WS_W_DN1), 0, scr, gw, NGW, lane, start);
    }
    __syncthreads();
}

__device__ __forceinline__ void phase_norm(const float* __restrict__ src_lat, const float* __restrict__ src_ctx, const float* __restrict__ g, const float* __restrict__ modl, int sh_off, int sc_off, int Mrows, bf16* __restrict__ H, int lane, int wave) {
    const int gw = blockIdx.x * NWAVES + wave, NGW = gridDim.x * NWAVES;
    f32x4 gv[4];
#pragma unroll
    for (int j = 0; j < 4; ++j) gv[j] = ((const f32x4*)g)[lane + 64 * j];
#pragma unroll 2
    for (int row = gw; row < Mrows; row += NGW) {
        const float* src = row < MLAT ? src_lat : src_ctx; const int bb = row < MLAT ? (row >> 12) : 8;
        const f32x4* xr = (const f32x4*)(src + (size_t)row * D) + lane;
        f32x4 v[4]; float ss = 0.f;
#pragma unroll
        for (int j = 0; j < 4; ++j) { v[j] = xr[64 * j]; ss += (v[j].x * v[j].x + v[j].y * v[j].y) + (v[j].z * v[j].z + v[j].w * v[j].w); }
        const float rstd = rsqrtf(wave_sum(ss) * (1.f / D) + EPS);
        const f32x4* sc = (const f32x4*)(modl + (size_t)bb * 6144 + sc_off) + lane; const f32x4* sh = (const f32x4*)(modl + (size_t)bb * 6144 + sh_off) + lane;
        u32x2* o = (u32x2*)(H + (size_t)row * D) + lane;
#pragma unroll
        for (int j = 0; j < 4; ++j) { const f32x4 y = v[j] * rstd * gv[j] * (sc[64 * j] + 1.0f) + sh[64 * j]; u32x2 w; w.x = pk2(y.x, y.y); w.y = pk2(y.z, y.w); o[64 * j] = w; }
    }
}

__device__ __forceinline__ void phase_qknorm(bf16* QKV, const float* qg, const float* kg, int lane, int wave) {
    const int gw = blockIdx.x * NWAVES + wave, NGW = gridDim.x * NWAVES;
    float gq[8], gk[8];
#pragma unroll
    for (int e = 0; e < 8; ++e) { gq[e] = qg[(lane & 7) * 8 + e] * 0.125f; gk[e] = kg[(lane & 7) * 8 + e]; }
    for (int item = gw; item < MT * 2; item += NGW) {
        const int row = item >> 1, half = item & 1;
        u32x4* ptr = (u32x4*)(QKV + (size_t)row * LDQ0 + half * 512) + lane;
        float f[8]; unpack8(*ptr, f);
        float ss = 0.f;
#pragma unroll
        for (int e = 0; e < 8; ++e) ss += f[e] * f[e];
        ss += __shfl_xor(ss, 1); ss += __shfl_xor(ss, 2); ss += __shfl_xor(ss, 4);
        const float rstd = rsqrtf(ss * (1.f / 64.f) + EPS);
#pragma unroll
        for (int e = 0; e < 8; ++e) f[e] = f[e] * rstd * (half ? gk[e] : gq[e]);
        *ptr = pack8f(f);
    }
}

__device__ __forceinline__ void phase_conv(const bf16* QKV, const float* cw, const float* cb, const float* lng, const float* lnb, bf16* ATT, LAS unsigned char* lds, int tid, int lane, int wave) {
    LAS unsigned short* glu = (LAS unsigned short*)lds;
    LAS float* ybuf = (LAS float*)(lds + 65536);
    float w[31];
#pragma unroll
    for (int i = 0; i < 31; ++i) w[i] = cw[i * 512 + tid];
    const float bias = cb[tid];
    float lg[8], lb[8];
#pragma unroll
    for (int e = 0; e < 8; ++e) { lg[e] = lng[lane * 8 + e]; lb[e] = lnb[lane * 8 + e]; }
    u32x4 ru[8];
#define CONV_LOAD(it_) do { int sb_, sl_, t0_; if ((it_) < 1024) { sb_ = ((it_) >> 7) * TL; sl_ = TL; t0_ = ((it_) & 127) * 32; } else { const int j_ = (it_) - 1024; sb_ = MLAT + (j_ >> 3) * NCTX; sl_ = NCTX; t0_ = (j_ & 7) * 32; } \
        _Pragma("unroll") for (int ps_ = 0; ps_ < 8; ++ps_) { const int i_ = ps_ * 8 + (tid >> 6); const int t_ = t0_ - 15 + i_; ru[ps_] = (u32x4){0u, 0u, 0u, 0u}; \
            if (i_ < 62 && t_ >= 0 && t_ < sl_) ru[ps_] = *(const u32x4*)(QKV + (size_t)(sb_ + t_) * LDQ0 + 1536 + lane * 8); } } while (0)
    if ((int)blockIdx.x < 1088) CONV_LOAD((int)blockIdx.x);
    for (int it = blockIdx.x; it < 1088; it += gridDim.x) {
        int seq_base, t0;
        if (it < 1024) { seq_base = (it >> 7) * TL; t0 = (it & 127) * 32; } else { const int j = it - 1024; seq_base = MLAT + (j >> 3) * NCTX; t0 = (j & 7) * 32; }
#pragma unroll
        for (int ps = 0; ps < 8; ++ps) { const int i = ps * 8 + (tid >> 6); if (i < 62) *(LAS u32x4*)(glu + i * 512 + lane * 8) = ru[ps]; }
        if (it + (int)gridDim.x < 1088) CONV_LOAD(it + (int)gridDim.x);
        __syncthreads();
        for (int tg = 0; tg < 4; ++tg) {
            float v[38];
#pragma unroll
            for (int j = 0; j < 38; ++j) v[j] = bf2f(glu[(tg * 8 + j) * 512 + tid]);
#pragma unroll
            for (int t = 0; t < 8; ++t) { float a = bias;
#pragma unroll
                for (int k = 0; k < 31; ++k) a += v[t + k] * w[k];
                ybuf[(tg * 8 + t) * 512 + tid] = a; }
        }
        __syncthreads();
#pragma unroll
        for (int q = 0; q < 4; ++q) { const int t = wave * 4 + q; const LAS f32x4* yp = (const LAS f32x4*)(ybuf + t * 512 + lane * 8);
            const f32x4 a = yp[0], b = yp[1]; float f[8] = {a.x, a.y, a.z, a.w, b.x, b.y, b.z, b.w};
            float s = 0.f;
#pragma unroll
            for (int e = 0; e < 8; ++e) s += f[e];
            const float mu = wave_sum(s) * (1.f / 512.f); float s2 = 0.f;
#pragma unroll
            for (int e = 0; e < 8; ++e) { f[e] -= mu; s2 += f[e] * f[e]; }
            const float rstd = rsqrtf(wave_sum(s2) * (1.f / 512.f) + EPS);
#pragma unroll
            for (int e = 0; e < 8; ++e) f[e] = silu_f(f[e] * rstd * lg[e] + lb[e]);
            *(u32x4*)(ATT + (size_t)(seq_base + t0 + t) * D + 512 + lane * 8) = pack8f(f); }
    }
    __syncthreads();
}

constexpr int AVS = 144;
template <int NQR>
__device__ __forceinline__ void attn_wave(const bf16* QKV, int tq0, int h, int krlo, int nkr, int tkloc0, const LAS char* ck, const LAS char* cv, const LAS float* rpbh, int rbase, int qc0, int kc0, bf16* ATT, LAS char* vl, int lane, const LAS float* gqk) {
    const int fr = lane & 15, g = lane >> 4, q4 = (lane & 15) >> 2, p4 = lane & 3;
    bf16x8 qf[NQR][2]; f32x4 oacc[NQR][4]; float lrun[NQR]; int r0q[NQR];
    const float sref = __builtin_bit_cast(float, __builtin_amdgcn_readfirstlane(__builtin_bit_cast(int, gqk[64])));
#pragma unroll
    for (int qr = 0; qr < NQR; ++qr) {
        const bf16* qp = QKV + (size_t)(tq0 + 64 * qr + fr) * LDQ0 + h * 64 + 8 * g;
        { float a8[8], b8[8]; unpack8(*(const u32x4*)qp, a8); unpack8(*(const u32x4*)(qp + 32), b8); float ss = 0.f;
#pragma unroll
          for (int e = 0; e < 8; ++e) ss += a8[e] * a8[e] + b8[e] * b8[e];
          ss += __shfl_xor(ss, 16); ss += __shfl_xor(ss, 32); const float rq = rsqrtf(ss * (1.f / 64.f) + EPS);
#pragma unroll
          for (int e = 0; e < 8; ++e) { a8[e] *= rq * gqk[8 * g + e]; b8[e] *= rq * gqk[32 + 8 * g + e]; }
          qf[qr][0] = __builtin_bit_cast(bf16x8, pack8f(a8)); qf[qr][1] = __builtin_bit_cast(bf16x8, pack8f(b8)); }
#pragma unroll
        for (int c = 0; c < 4; ++c) oacc[qr][c] = (f32x4){0.f, 0.f, 0.f, 0.f};
        lrun[qr] = 0.f; r0q[qr] = min(max(rbase + qr - 4, 0), 56);
    }
    const int qcol = qc0 + fr; const int lo = min(max(qcol - 8, 0), 48);
#define ATT_QR_BODY(LOCAL, KR) \
    _Pragma("unroll") for (int qr = 0; qr < NQR; ++qr) { \
        if (!(LOCAL) || ((KR) >= r0q[qr] && (KR) < r0q[qr] + 8)) { \
            f32x4 st[2]; \
            _Pragma("unroll") for (int jb = 0; jb < 2; ++jb) { st[jb] = MFMA16(kf[2 * jb], qf[qr][0], ((f32x4){0.f, 0.f, 0.f, 0.f})); st[jb] = MFMA16(kf[2 * jb + 1], qf[qr][1], st[jb]); } \
            float ps = 0.f; float pv[8]; \
            if (LOCAL) { const LAS float* rrow = rpbh + ((KR) - (rbase + qr) + 7) * 31; \
                _Pragma("unroll") for (int jb = 0; jb < 2; ++jb) _Pragma("unroll") for (int e = 0; e < 4; ++e) { const int kcol = kc0 + 16 * jb + 4 * g + e; const bool valid = (kcol >= lo) && (kcol < lo + 16); \
                    const int rel = min(max(kcol - qcol + 15, 0), 30); const float bv = valid ? rrow[rel] : -1e30f; \
                    const float pe = __builtin_amdgcn_exp2f(st[jb][e] + bv); pv[jb * 4 + e] = pe; ps += pe; } \
            } else { \
                _Pragma("unroll") for (int jb = 0; jb < 2; ++jb) _Pragma("unroll") for (int e = 0; e < 4; ++e) { const float pe = __builtin_amdgcn_exp2f(st[jb][e] - sref); pv[jb * 4 + e] = pe; ps += pe; } \
            } \
            lrun[qr] += ps; \
            const bf16x8 pf = __builtin_bit_cast(bf16x8, pack8f(pv)); \
            _Pragma("unroll") for (int c = 0; c < 4; ++c) oacc[qr][c] = MFMA16(vfr[c], pf, oacc[qr][c]); \
        } }
    if (nkr > 0) {
        bf16x8 kf[4]; u32x4 vv[4];
        {
            const bf16* kp = QKV + (size_t)(tkloc0 + fr) * LDQ0 + 512 + h * 64 + 8 * g;
            kf[0] = *(const bf16x8*)kp; kf[1] = *(const bf16x8*)(kp + 32); kf[2] = *(const bf16x8*)(kp + 16 * LDQ0); kf[3] = *(const bf16x8*)(kp + 16 * LDQ0 + 32);
#pragma unroll
            for (int i = 0; i < 4; ++i) { const int c = lane + 64 * i; vv[i] = *(const u32x4*)(QKV + (size_t)(tkloc0 + (c >> 3)) * LDQ0 + 1024 + h * 64 + (c & 7) * 8); }
        }
#pragma unroll 1
        for (int s = 0; s < nkr; ++s) {
            bf16x8 kn[4]; u32x4 vn[4];
            if (s + 1 < nkr) {
                const int tk0 = tkloc0 + (s + 1) * 64;
                const bf16* kp = QKV + (size_t)(tk0 + fr) * LDQ0 + 512 + h * 64 + 8 * g;
                kn[0] = *(const bf16x8*)kp; kn[1] = *(const bf16x8*)(kp + 32); kn[2] = *(const bf16x8*)(kp + 16 * LDQ0); kn[3] = *(const bf16x8*)(kp + 16 * LDQ0 + 32);
#pragma unroll
                for (int i = 0; i < 4; ++i) { const int c = lane + 64 * i; vn[i] = *(const u32x4*)(QKV + (size_t)(tk0 + (c >> 3)) * LDQ0 + 1024 + h * 64 + (c & 7) * 8); }
            } else {
#pragma unroll
                for (int i = 0; i < 4; ++i) { kn[i] = (bf16x8){0, 0, 0, 0, 0, 0, 0, 0}; vn[i] = (u32x4){0u, 0u, 0u, 0u}; }
            }
#pragma unroll
            for (int i = 0; i < 4; ++i) { const int c = lane + 64 * i; *(LAS u32x4*)(vl + (c >> 3) * AVS + (c & 7) * 16) = vv[i]; }
            asm volatile("s_waitcnt lgkmcnt(0)" ::: "memory");
            bf16x8 vfr[4];
#pragma unroll
            for (int c = 0; c < 4; ++c) vfr[c] = cat44(trread(vl + (4 * g + q4) * AVS + (16 * c + 4 * p4) * 2), trread(vl + (16 + 4 * g + q4) * AVS + (16 * c + 4 * p4) * 2));
            asm volatile("s_waitcnt lgkmcnt(0)" ::: "memory");
            const int kr = krlo + s;
#pragma unroll
            for (int jb = 0; jb < 2; ++jb) { float a8[8], b8[8]; unpack8(__builtin_bit_cast(u32x4, kf[2 * jb]), a8); unpack8(__builtin_bit_cast(u32x4, kf[2 * jb + 1]), b8); float ss = 0.f;
#pragma unroll
                for (int e = 0; e < 8; ++e) ss += a8[e] * a8[e] + b8[e] * b8[e];
                ss += __shfl_xor(ss, 16); ss += __shfl_xor(ss, 32); const float rk = rsqrtf(ss * (1.f / 64.f) + EPS);
#pragma unroll
                for (int e = 0; e < 8; ++e) { a8[e] *= rk; b8[e] *= rk; }
                kf[2 * jb] = __builtin_bit_cast(bf16x8, pack8f(a8)); kf[2 * jb + 1] = __builtin_bit_cast(bf16x8, pack8f(b8));
                if (jb == 0) asm volatile("" : "+v"(kf[2]), "+v"(kf[3]) : "v"(kf[0]), "v"(kf[1]));
            }
            ATT_QR_BODY(true, kr)
#pragma unroll
            for (int i = 0; i < 4; ++i) { kf[i] = kn[i]; vv[i] = vn[i]; }
        }
    }
    int lane2 = lane; asm volatile("" : "+v"(lane2));
    const int fr2 = lane2 & 15, g2 = lane2 >> 4, q42 = (lane2 & 15) >> 2, p42 = lane2 & 3;
#pragma unroll 1
    for (int s = 0; s < 8; ++s) {
        const LAS char* kb = ck + (32 * s + fr2) * AVS + 16 * g2; const LAS char* vb = cv + 32 * s * AVS;
        bf16x8 kf[4];
        kf[0] = *(const LAS bf16x8*)kb; kf[1] = *(const LAS bf16x8*)(kb + 64); kf[2] = *(const LAS bf16x8*)(kb + 16 * AVS); kf[3] = *(const LAS bf16x8*)(kb + 16 * AVS + 64);
        bf16x8 vfr[4];
#pragma unroll
        for (int c = 0; c < 4; ++c) vfr[c] = cat44(trread(vb + (4 * g2 + q42) * AVS + (16 * c + 4 * p42) * 2), trread(vb + (16 + 4 * g2 + q42) * AVS + (16 * c + 4 * p42) * 2));
        ATT_QR_BODY(false, 0)
    }
#undef ATT_QR_BODY
#pragma unroll
    for (int qr = 0; qr < NQR; ++qr) {
        float lt = lrun[qr]; lt += __shfl_xor(lt, 16); lt += __shfl_xor(lt, 32);
        const float inv = 1.0f / lt;
        bf16* op = ATT + (size_t)(tq0 + 64 * qr + fr2) * D + h * 64 + 4 * g2;
#pragma unroll
        for (int c = 0; c < 4; ++c) { u32x2 w; w.x = pk2(oacc[qr][c][0] * inv, oacc[qr][c][1] * inv); w.y = pk2(oacc[qr][c][2] * inv, oacc[qr][c][3] * inv); *(u32x2*)(op + 16 * c) = w; }
    }
}

__device__ __forceinline__ void attn_stage_ctx(const bf16* QKV, int b, int h, LAS char* ck, LAS char* cv, int tid) {
#pragma unroll
    for (int i = 0; i < 4; ++i) { const int id = tid + 512 * i; const int key = id >> 3, dc = id & 7;
        const bf16* rp = QKV + (size_t)(MLAT + b * NCTX + key) * LDQ0 + h * 64 + dc * 8;
        float f[8]; unpack8(*(const u32x4*)(rp + 512), f); float ss = 0.f;
#pragma unroll
        for (int e = 0; e < 8; ++e) ss += f[e] * f[e];
        ss += __shfl_xor(ss, 1); ss += __shfl_xor(ss, 2); ss += __shfl_xor(ss, 4);
        const float rk = rsqrtf(ss * (1.f / 64.f) + EPS);
#pragma unroll
        for (int e = 0; e < 8; ++e) f[e] *= rk;
        *(LAS u32x4*)(ck + key * AVS + dc * 16) = pack8f(f);
        *(LAS u32x4*)(cv + key * AVS + dc * 16) = *(const u32x4*)(rp + 1024); }
}

__device__ __forceinline__ void phase_attn(const bf16* QKV, const float* rpb, const float* qg, const float* kg, bf16* ATT, LAS unsigned char* lds, int lane, int wave) {
    LAS char* vl = (LAS char*)lds + wave * 4608;
    LAS char* ck = (LAS char*)lds + 36864; LAS char* cv = (LAS char*)lds + 73728;
    LAS float* rpbl = (LAS float*)(lds + 110592);
    LAS float* gqk = (LAS float*)(lds + 126976);
    if (threadIdx.x < 64) { const float gv = qg[threadIdx.x] * kg[threadIdx.x] * (0.125f * 1.44269504f); gqk[threadIdx.x] = gv;
        const float bnd = 64.0f * wave_max(fabsf(gv)); if (threadIdx.x == 0) gqk[64] = bnd; }
    __syncthreads();
    { const float bnd = gqk[64]; for (int i = threadIdx.x; i < 8 * 15 * 31; i += NTHR) rpbl[i] = rpb[i] * 1.44269504f - bnd; }
    for (int item = blockIdx.x; item < 512; item += gridDim.x) {
        const int h = item & 7, rgp = (item >> 3) & 7, b = item >> 6;
        __syncthreads();
        { int lane_i = lane; asm volatile("" : "+v"(lane_i)); attn_stage_ctx(QKV, b, h, ck, cv, wave * 64 + lane_i); }
        __syncthreads();
        const int cgp = wave & 3, rg = 2 * rgp + (wave >> 2);
        const int rbase = 4 * rg; const int krlo = min(max(rbase - 4, 0), 56); const int krhi = min(max(rbase + 3 - 4, 0), 56) + 8;
        const int kc0 = cgp == 0 ? 0 : (cgp == 1 ? 8 : (cgp == 2 ? 24 : 32));
        attn_wave<4>(QKV, b * TL + rbase * 64 + 16 * cgp, h, krlo, krhi - krlo, b * TL + krlo * 64 + kc0, ck, cv, rpbl + h * 15 * 31, rbase, 16 * cgp, kc0, ATT, vl, lane, gqk);
    }
    { int lane_b = lane; asm volatile("" : "+v"(lane_b)); lane = lane_b; }
    for (int item = ((int)blockIdx.x + (int)gridDim.x / 2) % (int)gridDim.x; item < 64; item += gridDim.x) {
        const int h = item & 7, b = item >> 3;
        __syncthreads();
        { int lane_i = lane; asm volatile("" : "+v"(lane_i)); attn_stage_ctx(QKV, b, h, ck, cv, wave * 64 + lane_i); }
        __syncthreads();
#pragma unroll 1
        for (int k = 0; k < 2; ++k) attn_wave<1>(QKV, MLAT + b * NCTX + 16 * (wave + 8 * k), h, 0, 0, 0, ck, cv, rpbl, 0, 0, 0, ATT, vl, lane, gqk);
    }
    __syncthreads();
}

__device__ __forceinline__ void phase_mlprep(const bf16* __restrict__ QKVO, const float* __restrict__ cw, const float* __restrict__ cb, bf16* __restrict__ QKP, bf16* __restrict__ CTXQK, int lane, int wave) {
    const int gw = blockIdx.x * NWAVES + wave, NGW = gridDim.x * NWAVES;
    for (int half = 0; half < 2; ++half) {
        const int cbase = half * 512 + lane * 8;
        float w[5][8], bias[8];
#pragma unroll
        for (int k = 0; k < 5; ++k)
#pragma unroll
            for (int e = 0; e < 8; ++e) w[k][e] = cw[k * 1024 + cbase + e];
#pragma unroll
        for (int e = 0; e < 8; ++e) bias[e] = cb[cbase + e];
        float inv[8];
#pragma unroll
        for (int e = 0; e < 8; ++e) inv[e] = exp2f(-(float)((lane & 1) * 8 + e) * (13.287712379549449f / 16.f));
        const int mrows = half == 0 ? MLAT : MT;
#pragma unroll 2
        for (int row = gw; row < mrows; row += NGW) {
            int t, len; if (row < MLAT) { t = row & (TL - 1); len = TL; } else { t = (row - MLAT) & (NCTX - 1); len = NCTX; }
            float a[8];
#pragma unroll
            for (int e = 0; e < 8; ++e) a[e] = bias[e];
#pragma unroll
            for (int k = 0; k < 5; ++k) { const int tt = t + k - 2;
                if (tt >= 0 && tt < len) { float f[8]; unpack8(*(const u32x4*)(QKVO + (size_t)(row + k - 2) * LDQ1 + cbase), f);
#pragma unroll
                    for (int e = 0; e < 8; ++e) a[e] += f[e] * w[k][e]; } }
            const float qs = half == 0 ? 0.125f : 1.0f;
#pragma unroll
            for (int e = 0; e < 8; ++e) a[e] = silu_f(a[e]) * qs;
            if (row < MLAT) {
                const float pos = (float)((lane & 4) ? (t & 63) : (t >> 6));
#pragma unroll
                for (int e = 0; e < 8; ++e) { const float ang = pos * inv[e]; const float cs = __cosf(ang), sn = __sinf(ang); const float other = __shfl_xor(a[e], 2);
                    a[e] = (lane & 2) ? (other * sn + a[e] * cs) : (a[e] * cs - other * sn); }
                *(u32x4*)(QKP + (size_t)row * D + cbase) = pack8f(a);
            } else {
                *(u32x4*)(CTXQK + (size_t)(row - MLAT) * D + cbase) = pack8f(a);
            }
        }
    }
}

constexpr int SKS = 144;
__device__ __forceinline__ void phase_mlscan(const bf16* QKVO, const bf16* QKP, const bf16* CTXQK, const float* GATES, bf16* SPREV, float* NPREV, float* MPREV, LAS unsigned char* lds, int tid, int lane, int wave) {
    LAS char* tb = (LAS char*)lds;
    LAS float* lnb = (LAS float*)(lds + 73728);
    LAS float* weT = (LAS float*)(lds + 77824);
    LAS float* totT = (LAS float*)(lds + 95232);
    LAS float* mlocT = totT + 64;
    LAS float* mbefT = totT + 128;
    LAS float* mnewT = totT + 192;
    LAS float* decT = totT + 256;
    const int g = lane >> 4, fr = lane & 15, q4 = (lane & 15) >> 2, p4 = lane & 3;
    const int dvb = wave >> 1, dkb0 = 2 * (wave & 1);
    for (int item = blockIdx.x; item < 256; item += gridDim.x) {
        const int vh = item & 1, dir = (item >> 1) & 1, h = (item >> 2) & 7, b = item >> 5;
#define SCAN_ROW0(st) ((st) < 2 ? MLAT + b * NCTX + (dir ? 1 - (st) : (st)) * 128 : b * TL + (dir ? 31 - ((st) - 2) : (st) - 2) * 128)
#pragma unroll 1
        for (int st = wave; st < 34; st += 8) {
            const int r0 = SCAN_ROW0(st);
            const float* gp = GATES + (size_t)(r0 + 2 * lane) * 32 + dir * 8 + h;
            const float ig0 = gp[0], ig1 = gp[32], lf0 = gp[16], lf1 = gp[48];
            float ps = lf0 + lf1;
#pragma unroll
            for (int o = 1; o < 64; o <<= 1) { const float t = __shfl_up(ps, o); if (lane >= o) ps += t; }
            const float total = __shfl(ps, 63); const float cum1 = ps, cum0 = ps - lf1;
            float we0, we1;
            if (dir == 0) { we0 = total - cum0 + ig0; we1 = total - cum1 + ig1; } else { we0 = (cum0 - lf0) + ig0; we1 = (cum1 - lf1) + ig1; }
            const float mloc = wave_max(fmaxf(we0, we1));
            weT[st * 128 + 2 * lane] = we0; weT[st * 128 + 2 * lane + 1] = we1;
            if (lane == 0) { totT[st] = total; mlocT[st] = mloc; }
        }
        __syncthreads();
        if (wave == 0) {
            float m = 0.f;
#pragma unroll 1
            for (int st = 0; st < 34; ++st) { const float total = totT[st], mloc = mlocT[st]; const float mnew = fmaxf(total + m, mloc); const float dec = __expf(total + m - mnew);
                if (lane == 0) { mbefT[st] = m; mnewT[st] = mnew; decT[st] = dec; } m = mnew; }
        }
        __syncthreads();
        u32x4 nk[2], nv[2];
#define SCAN_LOAD(st) do { const bool ic_ = (st) < 2; const int r0_ = SCAN_ROW0(st); \
            _Pragma("unroll") for (int i_ = 0; i_ < 2; ++i_) { const int id_ = tid + 512 * i_; const int l_ = id_ >> 3, c_ = id_ & 7; \
                const bf16* kp_ = ic_ ? CTXQK + (size_t)(r0_ - MLAT + l_) * D + 512 + h * 64 + c_ * 8 : QKP + (size_t)(r0_ + l_) * D + 512 + h * 64 + c_ * 8; \
                nk[i_] = *(const u32x4*)kp_; nv[i_] = *(const u32x4*)(QKVO + (size_t)(r0_ + l_) * LDQ1 + 1024 + h * 128 + vh * 64 + c_ * 8); } } while (0)
#define SCAN_STAGE(st) do { LAS char* lk_ = tb + ((st) & 1) * 36864; LAS char* lv_ = lk_ + 18432; const float mn_ = mnewT[st]; \
            _Pragma("unroll") for (int i_ = 0; i_ < 2; ++i_) { const int id_ = tid + 512 * i_; const int l_ = id_ >> 3, c_ = id_ & 7; \
                float f_[8]; unpack8(nk[i_], f_); const float wl_ = __expf(weT[(st) * 128 + l_] - mn_); \
                _Pragma("unroll") for (int e_ = 0; e_ < 8; ++e_) f_[e_] *= wl_; \
                *(LAS u32x4*)(lk_ + l_ * SKS + c_ * 16) = pack8f(f_); *(LAS u32x4*)(lv_ + l_ * SKS + c_ * 16) = nv[i_]; } } while (0)
        SCAN_LOAD(0); SCAN_STAGE(0); SCAN_LOAD(1);
        __syncthreads();
        f32x4 acc[2]; acc[0] = (f32x4){0.f, 0.f, 0.f, 0.f}; acc[1] = acc[0];
        float nst = 0.f;
#pragma unroll 1
        for (int step = 0; step < 34; ++step) {
            if (step >= 2) {
                const int cc = dir ? 31 - (step - 2) : step - 2;
                const size_t idx = (size_t)((b * 8 + h) * 2 + dir) * 32 + cc;
#pragma unroll
                for (int t = 0; t < 2; ++t) { u32x2 w; w.x = pk2(acc[t][0], acc[t][1]); w.y = pk2(acc[t][2], acc[t][3]);
                    *(u32x2*)(SPREV + (idx * 64 + 16 * (dkb0 + t) + fr) * 128 + vh * 64 + 16 * dvb + 4 * g) = w; }
                if (vh == 0 && tid < 64) NPREV[idx * 64 + tid] = nst;
                if (vh == 0 && tid == 0) MPREV[idx] = mbefT[step];
            }
            if (step + 1 < 34) { SCAN_STAGE(step + 1); if (step + 2 < 34) SCAN_LOAD(step + 2); }
            const LAS char* lk = tb + (step & 1) * 36864; const LAS char* lv = lk + 18432;
            const float decay = decT[step];
            acc[0] = acc[0] * decay; acc[1] = acc[1] * decay;
#pragma unroll
            for (int s4 = 0; s4 < 4; ++s4) {
                const int rb = (32 * s4 + 8 * g + q4) * SKS;
                const bf16x8 af = cat44(trread(lv + rb + (16 * dvb + 4 * p4) * 2), trread(lv + rb + 4 * SKS + (16 * dvb + 4 * p4) * 2));
#pragma unroll
                for (int t = 0; t < 2; ++t) { const bf16x8 bfr = cat44(trread(lk + rb + (16 * (dkb0 + t) + 4 * p4) * 2), trread(lk + rb + 4 * SKS + (16 * (dkb0 + t) + 4 * p4) * 2));
                    acc[t] = MFMA16(af, bfr, acc[t]); }
            }
            { const int dk = tid & 63, part = tid >> 6; float s = 0.f;
#pragma unroll
              for (int l = 0; l < 16; ++l) s += bf2f(*(const LAS unsigned short*)(lk + (part * 16 + l) * SKS + dk * 2));
              lnb[(step & 1) * 512 + part * 64 + dk] = s; }
            __syncthreads();
            if (tid < 64) { float s = 0.f;
#pragma unroll
                for (int pt = 0; pt < 8; ++pt) s += lnb[(step & 1) * 512 + pt * 64 + tid];
                nst = decay * nst + s; }
        }
        __syncthreads();
#undef SCAN_ROW0
#undef SCAN_LOAD
#undef SCAN_STAGE
    }
}

constexpr int OVS = 272;
__device__ __forceinline__ void phase_mlout(const bf16* QKVO, const bf16* QKP, const float* GATES, const bf16* SPREV, const float* NPREV, const float* MPREV, const float* normg, bf16* HN,
                                            LAS unsigned char* lds, int tid, int lane, int wave) {
    LAS char* lk = (LAS char*)lds; LAS char* lv = (LAS char*)lds + 18432; LAS char* ls = (LAS char*)lds + 53248;
    LAS float* arr = (LAS float*)(lds + 88064);
    const int g = lane >> 4, fr = lane & 15, q4 = (lane & 15) >> 2, p4 = lane & 3;
    u32x4 pvv[4], pss[4]; float pg0 = 0.f, pg1 = 0.f, pl0 = 0.f, pl1 = 0.f, pmp = 0.f, pnp = 0.f; bf16x8 pq[2];
#define MLOUT_LOAD(it_) do { const int c_ = (it_) & 31, h_ = ((it_) >> 5) & 7, b_ = (it_) >> 8; const int r0_ = b_ * TL + c_ * 128; \
        _Pragma("unroll") for (int i_ = 0; i_ < 4; ++i_) { const int id_ = tid + 512 * i_; pvv[i_] = *(const u32x4*)(QKVO + (size_t)(r0_ + (id_ >> 4)) * LDQ1 + 1024 + h_ * 128 + (id_ & 15) * 8); } \
        _Pragma("unroll") for (int i_ = 0; i_ < 4; ++i_) { const int id_ = tid + 512 * i_; const int dr_ = id_ >> 10, rem_ = id_ & 1023; \
            const size_t ix_ = (size_t)((b_ * 8 + h_) * 2 + dr_) * 32 + c_; pss[i_] = *(const u32x4*)(SPREV + (ix_ * 64 + (rem_ >> 4)) * 128 + (rem_ & 15) * 8); } \
        { const int tq_ = r0_ + 16 * wave + fr; const bf16* qp_ = QKP + (size_t)tq_ * D + h_ * 64 + 8 * g; pq[0] = *(const bf16x8*)qp_; pq[1] = *(const bf16x8*)(qp_ + 32); } \
        if (wave < 2) { const size_t ix_ = (size_t)((b_ * 8 + h_) * 2 + wave) * 32 + c_; const float* gp_ = GATES + (size_t)(r0_ + 2 * lane) * 32 + wave * 8 + h_; \
            pg0 = gp_[0]; pg1 = gp_[32]; pl0 = gp_[16]; pl1 = gp_[48]; pmp = MPREV[ix_]; pnp = NPREV[ix_ * 64 + lane]; } } while (0)
    if ((int)blockIdx.x < 2048) MLOUT_LOAD((int)blockIdx.x);
    for (int item = blockIdx.x; item < 2048; item += gridDim.x) {
        const int c = item & 31, h = (item >> 5) & 7, b = item >> 8;
        const int row0 = b * TL + c * 128;
#pragma unroll
        for (int i = 0; i < 2; ++i) { const int id = tid + 512 * i; const int l = id >> 3, c16 = id & 7; *(LAS u32x4*)(lk + l * SKS + c16 * 16) = *(const u32x4*)(QKP + (size_t)(row0 + l) * D + 512 + h * 64 + c16 * 8); }
#pragma unroll
        for (int i = 0; i < 4; ++i) { const int id = tid + 512 * i; const int l = id >> 4, c16 = id & 15; *(LAS u32x4*)(lv + l * OVS + c16 * 16) = pvv[i]; }
#pragma unroll
        for (int i = 0; i < 4; ++i) { const int id = tid + 512 * i; const int dr = id >> 10, rem = id & 1023; const int l = rem >> 4, c16 = rem & 15; *(LAS u32x4*)(ls + dr * 17408 + l * OVS + c16 * 16) = pss[i]; }
        const float cg0 = pg0, cg1 = pg1, cl0 = pl0, cl1 = pl1, cmp_ = pmp, cnp = pnp; bf16x8 qf[2]; qf[0] = pq[0]; qf[1] = pq[1];
        if (item + (int)gridDim.x < 2048) MLOUT_LOAD(item + (int)gridDim.x);
        if (wave < 2) {
            const int dr = wave; const size_t idx = (size_t)((b * 8 + h) * 2 + dr) * 32 + c;
            const float ig0 = cg0, ig1 = cg1, lf0 = cl0, lf1 = cl1;
            float ps = lf0 + lf1;
#pragma unroll
            for (int o = 1; o < 64; o <<= 1) { const float t = __shfl_up(ps, o); if (lane >= o) ps += t; }
            const float total = __shfl(ps, 63);
            float cum0, cum1;
            if (dr == 0) { cum1 = ps; cum0 = ps - lf1; } else { cum0 = total - (ps - lf1 - lf0); cum1 = total - (ps - lf1); }
            const float a0 = ig0 - cum0, a1 = ig1 - cum1;
            float am0, am1;
            if (dr == 0) { float pm = fmaxf(a0, a1);
#pragma unroll
                for (int o = 1; o < 64; o <<= 1) { const float t = __shfl_up(pm, o); if (lane >= o) pm = fmaxf(pm, t); }
                float prev = __shfl_up(pm, 1); if (lane == 0) prev = -1e30f; am0 = fmaxf(prev, a0); am1 = pm;
            } else { float pm = fmaxf(a0, a1);
#pragma unroll
                for (int o = 1; o < 64; o <<= 1) { const float t = __shfl_down(pm, o); if (lane + o < 64) pm = fmaxf(pm, t); }
                float nxt = __shfl_down(pm, 1); if (lane == 63) nxt = -1e30f; am0 = pm; am1 = fmaxf(nxt, a1);
            }
            const float mp = cmp_;
            const float mx0 = fmaxf(mp, am0), mx1 = fmaxf(mp, am1);
            LAS float* ar = arr + dr * 576;
            ar[2 * lane] = a0; ar[2 * lane + 1] = a1;
            ar[128 + 2 * lane] = -mx0; ar[128 + 2 * lane + 1] = -mx1;
            ar[256 + 2 * lane] = __expf(mp - mx0); ar[256 + 2 * lane + 1] = __expf(mp - mx1);
            ar[384 + 2 * lane] = __expf(-(cum0 + mx0)); ar[384 + 2 * lane + 1] = __expf(-(cum1 + mx1));
            ar[512 + lane] = cnp;
        }
        __syncthreads();
        const int tq = row0 + 16 * wave + fr; const int iq = 16 * wave + fr;
        u32x2 cow[8];
#pragma unroll
        for (int d = 0; d < 8; ++d) cow[d] = *(const u32x2*)(QKVO + (size_t)tq * LDQ1 + 2048 + h * 128 + 16 * d + 4 * g);
        float qv[16];
        { float t8[8]; unpack8(__builtin_bit_cast(u32x4, qf[0]), t8);
#pragma unroll
          for (int e = 0; e < 8; ++e) qv[e] = t8[e];
          unpack8(__builtin_bit_cast(u32x4, qf[1]), t8);
#pragma unroll
          for (int e = 0; e < 8; ++e) qv[8 + e] = t8[e]; }
        f32x4 hsum[8];
#pragma unroll
        for (int d = 0; d < 8; ++d) hsum[d] = (f32x4){0.f, 0.f, 0.f, 0.f};
#pragma unroll
        for (int dr = 0; dr < 2; ++dr) {
            const LAS float* ar = arr + dr * 576;
            const float bmq = ar[128 + iq], inter = ar[256 + iq], emq = ar[384 + iq];
            float qn = 0.f;
#pragma unroll
            for (int e = 0; e < 8; ++e) { qn += qv[e] * ar[512 + 8 * g + e]; qn += qv[8 + e] * ar[512 + 32 + 8 * g + e]; }
            qn += __shfl_xor(qn, 16); qn += __shfl_xor(qn, 32);
            bf16x8 qs[2];
            { float t8[8];
#pragma unroll
              for (int e = 0; e < 8; ++e) t8[e] = qv[e] * inter;
              qs[0] = __builtin_bit_cast(bf16x8, pack8f(t8));
#pragma unroll
              for (int e = 0; e < 8; ++e) t8[e] = qv[8 + e] * inter;
              qs[1] = __builtin_bit_cast(bf16x8, pack8f(t8)); }
            f32x4 acc[8];
            const LAS char* lsd = ls + dr * 17408;
#pragma unroll
            for (int d = 0; d < 8; ++d) { acc[d] = (f32x4){0.f, 0.f, 0.f, 0.f};
#pragma unroll
                for (int ks = 0; ks < 2; ++ks) { const int rb = (32 * ks + 8 * g + q4) * OVS + (16 * d + 4 * p4) * 2;
                    acc[d] = MFMA16(cat44(trread(lsd + rb), trread(lsd + rb + 4 * OVS)), qs[ks], acc[d]); } }
            float psum = 0.f;
            const int jlo = dr == 0 ? 0 : (wave >> 1), jhi = dr == 0 ? (wave >> 1) : 3;
            for (int jp = jlo; jp <= jhi; ++jp) {
                float pv[8];
#pragma unroll
                for (int jj = 0; jj < 2; ++jj) { const int jb = 2 * jp + jj;
                    const LAS char* kp = lk + (16 * jb + fr) * SKS + 8 * g * 2;
                    f32x4 st = MFMA16(*(const LAS bf16x8*)kp, qf[0], ((f32x4){0.f, 0.f, 0.f, 0.f})); st = MFMA16(*(const LAS bf16x8*)(kp + 64), qf[1], st);
                    const f32x4 av = *(const LAS f32x4*)(ar + 16 * jb + 4 * g);
#pragma unroll
                    for (int e = 0; e < 4; ++e) { const int j = 16 * jb + 4 * g + e; const bool valid = dr == 0 ? (j <= iq) : (j >= iq);
                        const float wgt = valid ? __expf(bmq + av[e]) : 0.f; const float pe = wgt * st[e]; pv[jj * 4 + e] = pe; psum += pe; } }
                const bf16x8 pf = __builtin_bit_cast(bf16x8, pack8f(pv));
#pragma unroll
                for (int d = 0; d < 8; ++d) { const int rb0 = (32 * jp + 4 * g + q4) * OVS + (16 * d + 4 * p4) * 2;
                    acc[d] = MFMA16(cat44(trread(lv + rb0), trread(lv + rb0 + 16 * OVS)), pf, acc[d]); }
            }
            psum += __shfl_xor(psum, 16); psum += __shfl_xor(psum, 32);
            const float den = inter * qn + psum;
            const float hs = 1.0f / fmaxf(fabsf(den), emq);
#pragma unroll
            for (int d = 0; d < 8; ++d) hsum[d] = hsum[d] + acc[d] * hs;
        }
        float ss = 0.f;
#pragma unroll
        for (int d = 0; d < 8; ++d) ss += (hsum[d][0] * hsum[d][0] + hsum[d][1] * hsum[d][1]) + (hsum[d][2] * hsum[d][2] + hsum[d][3] * hsum[d][3]);
        ss += __shfl_xor(ss, 16); ss += __shfl_xor(ss, 32);
        const float rstd = rsqrtf(ss * (1.f / 128.f) + EPS);
#pragma unroll
        for (int d = 0; d < 8; ++d) { const int col = h * 128 + 16 * d + 4 * g;
            const f32x4 ng = *(const f32x4*)(normg + col); const u32x2 ow = cow[d];
            const float o0 = bflo(ow.x), o1 = bfhi(ow.x), o2 = bflo(ow.y), o3 = bfhi(ow.y);
            u32x2 w; w.x = pk2(hsum[d][0] * rstd * ng[0] * fast_sig(o0), hsum[d][1] * rstd * ng[1] * fast_sig(o1));
            w.y = pk2(hsum[d][2] * rstd * ng[2] * fast_sig(o2), hsum[d][3] * rstd * ng[3] * fast_sig(o3));
            *(u32x2*)(HN + (size_t)tq * D + col) = w; }
        __syncthreads();
    }
}

#define XB_TMO      128
#define XB_XCNT(j)  (256  + 64 * (j))
#define XB_XSUB(j)  (1280 + 64 * (j))
#define XB_XGEN(j)  (2304 + 64 * (j))
#define XB_TOP      3328
#define XB_TOPGEN   3392
#define XCD_BAR_WORDS 3456
#define XB_SPIN_CAP (1u << 18)

__device__ __forceinline__ unsigned xb_ld(unsigned* p)              { return __hip_atomic_load(p, __ATOMIC_RELAXED, __HIP_MEMORY_SCOPE_AGENT); }
__device__ __forceinline__ unsigned xb_add(unsigned* p, unsigned v) { return __hip_atomic_fetch_add(p, v, __ATOMIC_RELAXED, __HIP_MEMORY_SCOPE_AGENT); }
__device__ __forceinline__ unsigned xb_xcc_id() { return (unsigned)__builtin_amdgcn_s_getreg((3 << 11) | 20) & 0xFu; }
#define XB_SPIN(cond, bar) do { unsigned _sp = 0; while (cond) { __builtin_amdgcn_s_sleep(1); \
    if ((++_sp & 255u) == 0u) { if (xb_ld(&(bar)[XB_TMO])) break; if (_sp > XB_SPIN_CAP) { atomicAdd(&(bar)[XB_TMO], 1u); break; } } } } while (0)

struct XcdBarrier {
    unsigned* bar; unsigned x;
    volatile LAS unsigned* st;
};

__device__ __forceinline__ XcdBarrier xcd_barrier_post(unsigned* bar, volatile LAS unsigned* st) {
    XcdBarrier b; b.bar = bar; b.x = xb_xcc_id(); b.st = st;
    if (threadIdx.x == 0) (void)xb_add(&bar[XB_XCNT(b.x)], 1u);
    return b;
}
__device__ __forceinline__ void xcd_barrier_complete(unsigned* bar, unsigned x, unsigned& nloc, unsigned& nx) {
    const unsigned G = gridDim.x * gridDim.y * gridDim.z;
    unsigned sum, cnt, mine, sp = 0u;
    for (;;) {
        sum = 0u; cnt = 0u; mine = 0u;
#pragma unroll
        for (unsigned j = 0; j < 16; ++j) { const unsigned c = xb_ld(&bar[XB_XCNT(j)]); sum += c; cnt += (c > 0u) ? 1u : 0u; mine = (j == x) ? c : mine; }
        if (sum == G) break;
        __builtin_amdgcn_s_sleep(1);
        if ((++sp & 255u) == 0u) { if (xb_ld(&bar[XB_TMO])) break; if (sp > XB_SPIN_CAP) { atomicAdd(&bar[XB_TMO], 1u); break; } }
    }
    nloc = mine > 0u ? mine : 1u; nx = cnt > 0u ? cnt : 1u;
}

__device__ __forceinline__ void xcd_barrier(const XcdBarrier& b) {
    asm volatile("s_waitcnt vmcnt(0)" ::: "memory");
    __syncthreads();
    if (threadIdx.x == 0) {
        unsigned* bar = b.bar;
        __builtin_amdgcn_s_waitcnt(0);
        unsigned nloc = b.st[0], nx = b.st[1];
        if (nloc == 0u) { xcd_barrier_complete(bar, b.x, nloc, nx); b.st[0] = nloc; b.st[1] = nx; }
        const unsigned old = xb_add(&bar[XB_XSUB(b.x)], 1u);
        const unsigned gen = old / nloc;
        if (old + 1u == (gen + 1u) * nloc) {
            __builtin_amdgcn_fence(__ATOMIC_RELEASE, "agent");
            asm volatile("s_waitcnt vmcnt(0)" ::: "memory");
            const unsigned og = xb_add(&bar[XB_TOP], 1u);
            const unsigned tg = og / nx;
            if (og + 1u == (tg + 1u) * nx) xb_add(&bar[XB_TOPGEN], 1u);
            else XB_SPIN(xb_ld(&bar[XB_TOPGEN]) == tg, bar);
            __builtin_amdgcn_fence(__ATOMIC_ACQUIRE, "agent");
            xb_add(&bar[XB_XGEN(b.x)], 1u);
            asm volatile("s_waitcnt vmcnt(0)" ::: "memory");
        } else {
            XB_SPIN(xb_ld(&bar[XB_XGEN(b.x)]) == gen, bar);
            __builtin_amdgcn_fence(__ATOMIC_ACQUIRE, "agent");
            asm volatile("s_waitcnt vmcnt(0)" ::: "memory");
        }
    }
    __syncthreads();
}

__global__ void __launch_bounds__(NTHR) fwd_megakernel(Params p) {
    extern __shared__ __attribute__((aligned(16))) unsigned char lds_raw[];
    LAS unsigned char* lds = (LAS unsigned char*)lds_raw;
    cg::grid_group grid = cg::this_grid();
    const int tid = threadIdx.x, lane = tid & 63, wave = __builtin_amdgcn_readfirstlane(tid >> 6);
#define KWS ((unsigned char*)((const unsigned char* const __attribute__((address_space(4)))*)kin())[27])
#define KOUT ((unsigned char*)((const unsigned char* const __attribute__((address_space(4)))*)kin())[26])
#define ws KWS
#define mod ((float*)(KWS + WS_MOD))
#define BUFA ((bf16*)(KWS + WS_BUFA))
#define XSA ((bf16*)(KWS + WS_XS))
#define XSB ((bf16*)(KWS + WS_XS + 68 * MiB))
#define QKV ((bf16*)(KWS + WS_QKV))
#define GATES ((float*)(KWS + WS_GATES))
#define CTXQK ((bf16*)(KWS + WS_CTXQK))
#define NPREV ((float*)(KWS + WS_NPREV))
#define MPREV ((float*)(KWS + WS_MPREV))
#define QKP ((bf16*)KOUT)
#define SPREV ((bf16*)(KOUT + 64 * MiB))
#define x_in (kin()[0])
#define ctx_in (kin()[2] - (size_t)MLAT * D)
    const int lo = p.ph_lo, hi = p.ph_hi;
    if (tid < 4) ((LAS unsigned*)(lds + LDS_XB_OFF))[tid] = 0u;
    __syncthreads();
    const XcdBarrier xbar = xcd_barrier_post((unsigned*)(ws + WS_BAR), (volatile LAS unsigned*)(lds + LDS_XB_OFF));
    const int G = gridDim.x, bx = blockIdx.x;
#define RUN(k) (lo <= (k) && (k) < hi)
#define NREP(k) ((((REPMASK) >> (k)) & 1) ? 2 : 1)
#define SIDE(units) const int ex_ = (units) % G; const bool idle_ = ex_ == 0 || bx >= ex_; const int rank_ = ex_ == 0 ? bx : bx - ex_, nblk_ = ex_ == 0 ? G : G - ex_;
#define SYNC(k) do { if (RUN(k) && (k) + 1 < hi) { if (hi > 1000) grid.sync(); else xcd_barrier(xbar); } } while (0)

    if (RUN(0)) for (int rp = 0; rp < NREP(0); ++rp) phase_prologue(p, lds, tid, lane, wave);
    SYNC(0);
#define RSS ((float*)(KWS + WS_RSS))
#define SHW ((const float*)(KWS + WS_SHW))
#define GM ((const float*)(KWS + WS_GM))
#define GMI (GM + 3 * 9216)
#define AOUT ((bf16*)KOUT)
    if (RUN(1)) { phase_aux(p, lds, tid, lane, wave); phase_norm(x_in, ctx_in, kin()[6], mod, 0, 1024, MT, BUFA, lane, wave); }
    SYNC(1);
    if (RUN(2)) { pg8::Gemm g{BUFA, (const bf16*)(ws + WS_W_ABIN), MT, NAB, D}; pg8::StaticOrder S; S.init(MT, NAB, G, bx); pg8::EpiStoreGLU E{QKV, LDQ0};
        pg8::gemm_phase<pg8::EpiStoreGLU, pg8::StaticOrder, true, true>(lds, g, S, E);
        SIDE((MT / 256) * (NAB / 256)); if (idle_) side_weights(p, 0, rank_, nblk_, lds, tid, lane, wave); }
    SYNC(2);
    if (RUN(4)) { shw_compute(p, 0, bx, G, lds, tid, lane, wave);
        for (int rp = 0; rp < NREP(20); ++rp) phase_conv(QKV, kin()[15], kin()[16], kin()[17], kin()[18], BUFA, lds, tid, lane, wave);
        for (int rp = 0; rp < NREP(4); ++rp) phase_attn(QKV, kin()[14], kin()[12], kin()[13], BUFA, lds, lane, wave); }
    SYNC(4);
    if (RUN(5)) { pg8::Gemm g{BUFA, (const bf16*)(ws + WS_W_ABOUT), MT, D, D}; pg8::StaticOrder S; S.init(MT, D, G, bx); pg8::EpiResid2<false> E{x_in, ctx_in, nullptr, mod + 2048, GM, AOUT, RSS};
        pg8::gemm_phase<pg8::EpiResid2<false>, pg8::StaticOrder, true, true>(lds, g, S, E);
        SIDE((MT / 256) * (D / 256)); if (idle_) { side_weights(p, 1, rank_, nblk_, lds, tid, lane, wave); side_weights(p, 2, rank_, nblk_, lds, tid, lane, wave); } }
    SYNC(5);
    if (RUN(7)) { pg8::Gemm g{AOUT, (const bf16*)(ws + WS_W_GU0), MT, 2 * DFF, D}; pg8::StaticOrder S; S.init(MT, 2 * DFF, G, bx); pg8::EpiSwiGLU2 E{QKV, DFF, RSS, SHW, 2 * DFF};
        pg8::gemm_phase<pg8::EpiSwiGLU2, pg8::StaticOrder, true, true>(lds, g, S, E);
        SIDE((MT / 256) * (2 * DFF / 256)); if (idle_) shw_compute(p, 1, rank_, nblk_, lds, tid, lane, wave); }
    SYNC(7);
#define mod1 (mod + 9 * 6144)
    if (G == 256) {
        if (RUN(8)) { pg8::Gemm g{QKV, (const bf16*)(ws + WS_W_DN0), MT, D, DFF}; pg8::StaticOrder S; S.init(MLAT, D, G, bx); pg8::EpiResid2<true> E{AOUT, AOUT, GMI, mod + 5120, GM + 9216, XSB, RSS + MT};
            pg8::gemm_phase<pg8::EpiResid2<true>, pg8::StaticOrder, true, true>(lds, g, S, E); }
        SYNC(8);
        if (RUN(9)) {
            if (bx < 32) { pg8::Gemm g{QKV, (const bf16*)(ws + WS_W_DN0), MT, D, DFF}; pg8::OneUnit S{128 + (bx >> 2), bx & 3, 1}; pg8::EpiResid2<true> E{AOUT, AOUT, GMI, mod + 5120, GM + 9216, XSB, RSS + MT};
                pg8::gemm_phase<pg8::EpiResid2<true>, pg8::OneUnit, true, true>(lds, g, S, E); }
            else { pg8::Gemm g{XSB, (const bf16*)(ws + WS_W_MLIN), MT, NMLP, D}; pg8::XcdPanels S{(bx - 32) & 7, (bx - 32) >> 3, 28, 8, 8, 0, 0, NMLP / 256};
                pg8::EpiMlIn2 E{QKV, GATES, kin()[23], RSS + MT, SHW + 9 * 5632};
                pg8::gemm_phase<pg8::EpiMlIn2, pg8::XcdPanels, true, true>(lds, g, S, E); }
        }
        SYNC(9);
        if (RUN(10)) { pg8::Gemm g{XSB, (const bf16*)(ws + WS_W_MLIN), MT, NMLP, D}; pg8::XcdPanels S{bx & 7, bx >> 3, 32, 9, 8, 64, 128, NMLP / 256};
            pg8::EpiMlIn2 E{QKV, GATES, kin()[23], RSS + MT, SHW + 9 * 5632};
            pg8::gemm_phase<pg8::EpiMlIn2, pg8::XcdPanels, true, true>(lds, g, S, E); }
        SYNC(10);
    } else {
    if (RUN(8)) { pg8::Gemm g{QKV, (const bf16*)(ws + WS_W_DN0), MT, D, DFF}; pg8::StaticOrder S; S.init(MT, D, G, bx); pg8::EpiResid2<true> E{AOUT, AOUT, GMI, mod + 5120, GM + 9216, XSB, RSS + MT};
        pg8::gemm_phase<pg8::EpiResid2<true>, pg8::StaticOrder, true, true>(lds, g, S, E); }
    SYNC(8);
    if (RUN(10)) { pg8::Gemm g{XSB, (const bf16*)(ws + WS_W_MLIN), MT, NMLP, D}; pg8::StaticOrder S; S.init(MT, NMLP, G, bx); pg8::EpiMlIn2 E{QKV, GATES, kin()[23], RSS + MT, SHW + 9 * 5632};
        pg8::gemm_phase<pg8::EpiMlIn2, pg8::StaticOrder, true, true>(lds, g, S, E); }
    SYNC(10);
    }
    if (RUN(11)) shw_compute(p, 2, bx, G, lds, tid, lane, wave);
    if (RUN(11)) for (int rp = 0; rp < NREP(11); ++rp) phase_mlprep(QKV, kin()[21], kin()[22], QKP, CTXQK, lane, wave);
    SYNC(11);
    if (RUN(12)) for (int rp = 0; rp < NREP(12); ++rp) phase_mlscan(QKV, QKP, CTXQK, GATES, SPREV, NPREV, MPREV, lds, tid, lane, wave);
    SYNC(12);
    if (RUN(13)) for (int rp = 0; rp < NREP(13); ++rp) phase_mlout(QKV, QKP, GATES, SPREV, NPREV, MPREV, kin()[24], BUFA, lds, tid, lane, wave);
    SYNC(13);
    if (RUN(14)) { pg8::Gemm g{BUFA, (const bf16*)(ws + WS_W_MLOUT), MLAT, D, D}; pg8::StaticOrder S; S.init(MLAT, D, G, bx); pg8::EpiResid2<true> E{XSB, XSB, GMI + 9216, mod1 + 2048, GM + 2 * 9216, XSA, RSS + 2 * MT};
        pg8::gemm_phase<pg8::EpiResid2<true>, pg8::StaticOrder, true, true>(lds, g, S, E); }
    SYNC(14);
    if (RUN(16)) { pg8::Gemm g{XSA, (const bf16*)(ws + WS_W_GU1), MLAT, 2 * DFF, D}; pg8::StaticOrder S; S.init(MLAT, 2 * DFF, G, bx); pg8::EpiSwiGLU2 E{QKV, DFF, RSS + 2 * MT, SHW + 9 * 5632 + 9 * 3328, 2 * DFF};
        pg8::gemm_phase<pg8::EpiSwiGLU2, pg8::StaticOrder, true, true>(lds, g, S, E); }
    SYNC(16);
    if (RUN(17)) { pg8::Gemm g{QKV, (const bf16*)(ws + WS_W_DN1), MLAT, D, DFF}; pg8::StaticOrder S; S.init(MLAT, D, G, bx); pg8::EpiResid E{XSA, XSA, GMI + 2 * 9216, (float*)KOUT, mod1 + 5120};
        pg8::gemm_phase<pg8::EpiResid, pg8::StaticOrder, true, true>(lds, g, S, E); }
#undef RUN
#undef SYNC
#undef ws
#undef mod
#undef BUFA
#undef XSA
#undef XSB
#undef QKV
#undef GATES
#undef CTXQK
#undef NPREV
#undef MPREV
#undef QKP
#undef SPREV
#undef x_in
#undef ctx_in
#undef RSS
#undef SHW
#undef GM
#undef GMI
#undef AOUT
#undef mod1
#undef KWS
#undef KOUT
}

extern "C" void kernel_launch(void* const* d_in, const int* in_sizes, int n_in, void* d_out, int out_size, void* d_ws, size_t ws_size, hipStream_t stream) {
    static int grid = 0;
    if (grid == 0) {
        if (n_in != 26 || out_size != MLAT * D || ws_size < WS_END) { fprintf(stderr, "kernel_launch: unexpected shapes (n_in %d out %d ws %zu)\n", n_in, out_size, ws_size); grid = -1; return; }
        int dev = 0, cus = 0, per_cu = 0;
        hipGetDevice(&dev); hipDeviceGetAttribute(&cus, hipDeviceAttributeMultiprocessorCount, dev);
        hipFuncSetAttribute((const void*)fwd_megakernel, hipFuncAttributeMaxDynamicSharedMemorySize, LDS_BYTES);
        hipOccupancyMaxActiveBlocksPerMultiprocessor(&per_cu, (const void*)fwd_megakernel, NTHR, LDS_BYTES);
        if (per_cu < 1) { fprintf(stderr, "kernel_launch: occupancy query says %d blocks per CU\n", per_cu); per_cu = 1; }
        (void)hipGetLastError();
        grid = cus * per_cu;
    }
    if (grid < 0) return;
    if (hipMemsetAsync((char*)d_ws + WS_BAR, 0, WS_BAR_BYTES, stream) != hipSuccess) { fprintf(stderr, "kernel_launch: memset of barrier words failed\n"); return; }
    Params p{};
    for (int i = 0; i < 26; ++i) p.in[i] = (const float*)d_in[i];
    p.out = (float*)d_out; p.ws = (unsigned char*)d_ws; p.ph_lo = 0; p.ph_hi = 18; p.rep = REPMASK;
    void* args[] = {&p};
    hipError_t e = hipLaunchCooperativeKernel((const void*)fwd_megakernel, dim3(grid), dim3(NTHR), args, LDS_BYTES, stream);
    if (e != hipSuccess) fprintf(stderr, "cooperative launch failed: %s (grid %d)\n", hipGetErrorString(e), grid);
}
```

```cpp
#include <hip/hip_runtime.h>
#include <hip/hip_cooperative_groups.h>
#include <cstdio>
#include <cstdint>
namespace cg = cooperative_groups;
#ifndef REPMASK
#define REPMASK 0
#endif

namespace pg8 {
#define PG8_LAS __attribute__((address_space(3)))
typedef unsigned short bf16_t;
typedef short bf16x8 __attribute__((ext_vector_type(8)));
typedef float f32x4 __attribute__((ext_vector_type(4)));
typedef unsigned u32x4 __attribute__((ext_vector_type(4)));
typedef unsigned u32x2 __attribute__((ext_vector_type(2)));
constexpr int BM = 256, BK = 64, HALF = 128, HTB = HALF * BK * 2  , STAGE_BYTES = 8 * HTB, NXCD = 8, WGM = 4;

__host__ __device__ __forceinline__ int lds_byte(int r, int c) { const int st = (r >> 4) * 2 + (c >> 5), rr = r & 15, cc = c & 31, ob = rr * 64 + cc * 2; return st * 1024 + (ob ^ (((ob >> 9) & 1) << 5)); }
__host__ __device__ __forceinline__ void stage_rc(int b, int& R, int& C) { const int st = b / 1024, sb = b % 1024, swz = sb ^ (((sb >> 9) & 1) << 5); R = (st >> 1) * 16 + swz / 64; C = (st & 1) * 32 + (swz % 64) / 2; }
__host__ __device__ __forceinline__ int perm32(int rho) { const int n = rho >> 4, i = rho & 15; return 8 * (i >> 2) + 4 * n + (i & 3); }

struct Unit { int pm, pn; };
struct Gemm { const bf16_t* A; const bf16_t* Bt; int M, N, K; };

struct StaticOrder {
    int nM, nN, nwg, G, c;
    __host__ __device__ void init(int M, int N, int G_, int c_) { nM = M / BM; nN = N / BM; nwg = nM * nN; G = G_; c = c_; }
    __host__ __device__ bool next(int i, Unit& u) const {
        const long L = (long)i * G + c; if (L >= nwg) return false;
        int wgid = (int)L; { const int q = nwg / NXCD, r = nwg % NXCD, xcd = wgid % NXCD, off = wgid / NXCD; wgid = (xcd < r ? xcd * (q + 1) : r * (q + 1) + (xcd - r) * q) + off; }
        const int nig = WGM * nN, gid = wgid / nig, fm = gid * WGM, gsz = (nM - fm) < WGM ? (nM - fm) : WGM;
        u.pm = fm + ((wgid % nig) % gsz); u.pn = (wgid % nig) / gsz; return true;
    }
    __device__ __forceinline__ void a_ready(const Unit&) const {}
    __device__ __forceinline__ void done(const Unit&) const {}
};


struct OneUnit { int pm, pn, valid;
    __device__ __forceinline__ bool next(int i, Unit& u) const { if (i != 0 || !valid) return false; u.pm = pm; u.pn = pn; return true; }
    __device__ __forceinline__ void a_ready(const Unit&) const {}
    __device__ __forceinline__ void done(const Unit&) const {} };
struct XcdPanels { int x, j, nb, P, PL, pm0, pmx, nN;
    __device__ __forceinline__ bool next(int i, Unit& u) const {
        const int t = i * nb + j; if (j < 0 || t >= P * nN) return false;
        int grp = t / (2 * nN), r = t - grp * 2 * nN; const int gsz = (P - 2 * grp) >= 2 ? 2 : 1;
        const int idx = 2 * grp + (gsz == 2 ? (r & 1) : 0); u.pn = gsz == 2 ? (r >> 1) : r;
        u.pm = idx < PL ? pm0 + x * PL + idx : pmx + x; return true; }
    __device__ __forceinline__ void a_ready(const Unit&) const {}
    __device__ __forceinline__ void done(const Unit&) const {} };

__device__ __forceinline__ unsigned cvt_pk_bf16(float lo, float hi) { unsigned r; asm volatile("v_cvt_pk_bf16_f32 %0, %1, %2" : "=v"(r) : "v"(lo), "v"(hi)); return r; }
__device__ __forceinline__ u32x4 pack8(const f32x4 v0, const f32x4 v1) { u32x4 w; w.x = cvt_pk_bf16(v0[0], v0[1]); w.y = cvt_pk_bf16(v0[2], v0[3]); w.z = cvt_pk_bf16(v1[0], v1[1]); w.w = cvt_pk_bf16(v1[2], v1[3]); return w; }
__device__ __forceinline__ float fast_sigmoid(float x) { return __builtin_amdgcn_rcpf(1.0f + __expf(-x)); }

struct EpiStore {
    static constexpr bool PERM = true, AFTER_DRAIN = false;
    bf16_t* O; int ldc;
    __device__ __forceinline__ void operator()(const f32x4 (&acc)[2][2][4][2], const Unit& u, int wr, int wc, int fr, int fq) const {
        const int row0 = u.pm * BM + wr * 64 + fr, col0 = u.pn * BM + wc * 32 + 8 * fq;
#pragma unroll
        for (int ai = 0; ai < 2; ++ai)
#pragma unroll
            for (int m = 0; m < 4; ++m) { bf16_t* rowp = O + (size_t)(row0 + ai * HALF + m * 16) * ldc + col0;
#pragma unroll
                for (int bj = 0; bj < 2; ++bj) *(u32x4*)(rowp + bj * HALF) = pack8(acc[ai][bj][m][0], acc[ai][bj][m][1]); }
    }
};
struct EpiStoreGLU {
    static constexpr bool PERM = true, AFTER_DRAIN = false;
    bf16_t* O; int ldc;
    __device__ __forceinline__ void operator()(const f32x4 (&acc)[2][2][4][2], const Unit& u, int wr, int wc, int fr, int fq) const {
        const int row0 = u.pm * BM + wr * 64 + fr;
        if (u.pn < 6) {
            const int col0 = u.pn * BM + wc * 32 + 8 * fq;
#pragma unroll
            for (int ai = 0; ai < 2; ++ai)
#pragma unroll
                for (int m = 0; m < 4; ++m) { bf16_t* rowp = O + (size_t)(row0 + ai * HALF + m * 16) * ldc + col0;
#pragma unroll
                    for (int bj = 0; bj < 2; ++bj) *(u32x4*)(rowp + bj * HALF) = pack8(acc[ai][bj][m][0], acc[ai][bj][m][1]); }
        } else {
            const int col0 = 1536 + (u.pn - 6) * HALF + wc * 32 + 8 * fq;
#pragma unroll
            for (int ai = 0; ai < 2; ++ai)
#pragma unroll
                for (int m = 0; m < 4; ++m) { f32x4 o[2];
#pragma unroll
                    for (int n = 0; n < 2; ++n)
#pragma unroll
                        for (int e = 0; e < 4; ++e) o[n][e] = acc[ai][0][m][n][e] * fast_sigmoid(acc[ai][1][m][n][e]);
                    *(u32x4*)(O + (size_t)(row0 + ai * HALF + m * 16) * ldc + col0) = pack8(o[0], o[1]); }
        }
    }
};
struct EpiResid {
    static constexpr bool PERM = true, AFTER_DRAIN = false;
    const bf16_t* res_lat; const bf16_t* res_ctx; const float* rgm; float* out; const float* gate;
    __device__ __forceinline__ void operator()(const f32x4 (&acc)[2][2][4][2], const Unit& u, int wr, int wc, int fr, int fq) const {
        const int base = u.pm * BM; const int bb = base < 32768 ? (base >> 12) : 8; const bf16_t* res = base < 32768 ? res_lat : res_ctx;
        const int row0 = base + wr * 64 + fr, col0 = u.pn * BM + wc * 32 + 8 * fq;
        f32x4 gv[2][2], rgv[2][2];
#pragma unroll
        for (int bj = 0; bj < 2; ++bj)
#pragma unroll
            for (int n = 0; n < 2; ++n) { gv[bj][n] = *(const f32x4*)(gate + (size_t)bb * 6144 + col0 + bj * HALF + 4 * n); rgv[bj][n] = *(const f32x4*)(rgm + (size_t)bb * 1024 + col0 + bj * HALF + 4 * n); }
#pragma unroll
        for (int ai = 0; ai < 2; ++ai)
#pragma unroll
            for (int m = 0; m < 4; ++m) { const size_t ro = (size_t)(row0 + ai * HALF + m * 16) * 1024 + col0;
#pragma unroll
                for (int bj = 0; bj < 2; ++bj)
#pragma unroll
                    for (int n = 0; n < 2; ++n) { const size_t ix = ro + bj * HALF + 4 * n; const u32x2 rw = *(const u32x2*)(res + ix);
                        const f32x4 r = {__builtin_bit_cast(float, rw.x << 16), __builtin_bit_cast(float, rw.x & 0xffff0000u), __builtin_bit_cast(float, rw.y << 16), __builtin_bit_cast(float, rw.y & 0xffff0000u)};
                        *(f32x4*)(out + ix) = r * rgv[bj][n] + gv[bj][n] * acc[ai][bj][m][n]; } }
    }
};
struct EpiSwiGLU {
    static constexpr bool PERM = true, AFTER_DRAIN = false;
    bf16_t* O; int ldc;
    __device__ __forceinline__ void operator()(const f32x4 (&acc)[2][2][4][2], const Unit& u, int wr, int wc, int fr, int fq) const {
        const int row0 = u.pm * BM + wr * 64 + fr, col0 = u.pn * HALF + wc * 32 + 8 * fq;
#pragma unroll
        for (int ai = 0; ai < 2; ++ai)
#pragma unroll
            for (int m = 0; m < 4; ++m) {
                f32x4 o[2];
#pragma unroll
                for (int n = 0; n < 2; ++n)
#pragma unroll
                    for (int e = 0; e < 4; ++e) { const float g = acc[ai][0][m][n][e], up = acc[ai][1][m][n][e]; o[n][e] = g * fast_sigmoid(g) * up; }
                *(u32x4*)(O + (size_t)(row0 + ai * HALF + m * 16) * ldc + col0) = pack8(o[0], o[1]);
            }
    }
};
struct EpiMlIn {
    static constexpr bool PERM = true, AFTER_DRAIN = false;
    bf16_t* O; float* gates; const float* gate_b;
    __device__ __forceinline__ void operator()(const f32x4 (&acc)[2][2][4][2], const Unit& u, int wr, int wc, int fr, int fq) const {
        const int row0 = u.pm * BM + wr * 64 + fr;
        if (u.pn < 12) {
            const int col0 = u.pn * BM + wc * 32 + 8 * fq;
#pragma unroll
            for (int ai = 0; ai < 2; ++ai)
#pragma unroll
                for (int m = 0; m < 4; ++m) { bf16_t* rowp = O + (size_t)(row0 + ai * HALF + m * 16) * 3072 + col0;
#pragma unroll
                    for (int bj = 0; bj < 2; ++bj) *(u32x4*)(rowp + bj * HALF) = pack8(acc[ai][bj][m][0], acc[ai][bj][m][1]); }
        } else if (wc == 0) {
            const int col0 = 8 * fq;
#pragma unroll
            for (int ai = 0; ai < 2; ++ai)
#pragma unroll
                for (int m = 0; m < 4; ++m)
#pragma unroll
                    for (int n = 0; n < 2; ++n) { f32x4 v = acc[ai][0][m][n] + *(const f32x4*)(gate_b + col0 + 4 * n);
                        if (col0 >= 16) {
#pragma unroll
                            for (int e = 0; e < 4; ++e) { const float x = v[e]; v[e] = fminf(x, 0.f) - log1pf(__expf(-fabsf(x))); } }
                        *(f32x4*)(gates + (size_t)(row0 + ai * HALF + m * 16) * 32 + col0 + 4 * n) = v; }
        }
    }
};


template <bool RES_SCALED> struct EpiResid2 {
    static constexpr bool PERM = true, AFTER_DRAIN = false;
    const void* res_lat; const void* res_ctx; const float* rgm; const float* gate; const float* gm; bf16_t* A2; float* rss;
    __device__ __forceinline__ void operator()(const f32x4 (&acc)[2][2][4][2], const Unit& u, int wr, int wc, int fr, int fq) const {
        const int base = u.pm * BM; const int bb = base < 32768 ? (base >> 12) : 8; const void* res = base < 32768 ? res_lat : res_ctx;
        const int row0 = base + wr * 64 + fr, col0 = u.pn * BM + wc * 32 + 8 * fq;
        f32x4 gv[2][2], gmv[2][2], rgv[2][2];
#pragma unroll
        for (int bj = 0; bj < 2; ++bj)
#pragma unroll
            for (int n = 0; n < 2; ++n) { gv[bj][n] = *(const f32x4*)(gate + (size_t)bb * 6144 + col0 + bj * HALF + 4 * n); gmv[bj][n] = *(const f32x4*)(gm + (size_t)bb * 1024 + col0 + bj * HALF + 4 * n);
                if constexpr (RES_SCALED) rgv[bj][n] = *(const f32x4*)(rgm + (size_t)bb * 1024 + col0 + bj * HALF + 4 * n); else rgv[bj][n] = (f32x4){1.f, 1.f, 1.f, 1.f}; }
#pragma unroll
        for (int ai = 0; ai < 2; ++ai)
#pragma unroll
            for (int m = 0; m < 4; ++m) { const int row = row0 + ai * HALF + m * 16; const size_t ro = (size_t)row * 1024 + col0; float ss = 0.f;
#pragma unroll
                for (int bj = 0; bj < 2; ++bj) { f32x4 r[2];
                    if constexpr (RES_SCALED) { const u32x4 rw = *(const u32x4*)((const bf16_t*)res + ro + bj * HALF);
                        r[0] = (f32x4){__builtin_bit_cast(float, rw.x << 16), __builtin_bit_cast(float, rw.x & 0xffff0000u), __builtin_bit_cast(float, rw.y << 16), __builtin_bit_cast(float, rw.y & 0xffff0000u)} * rgv[bj][0];
                        r[1] = (f32x4){__builtin_bit_cast(float, rw.z << 16), __builtin_bit_cast(float, rw.z & 0xffff0000u), __builtin_bit_cast(float, rw.w << 16), __builtin_bit_cast(float, rw.w & 0xffff0000u)} * rgv[bj][1]; }
                    else { r[0] = *(const f32x4*)((const float*)res + ro + bj * HALF); r[1] = *(const f32x4*)((const float*)res + ro + bj * HALF + 4); }
                    f32x4 o[2];
#pragma unroll
                    for (int n = 0; n < 2; ++n) { o[n] = r[n] + gv[bj][n] * acc[ai][bj][m][n]; ss += (o[n][0] * o[n][0] + o[n][1] * o[n][1]) + (o[n][2] * o[n][2] + o[n][3] * o[n][3]); }
                    *(u32x4*)(A2 + ro + bj * HALF) = pack8(o[0] * gmv[bj][0], o[1] * gmv[bj][1]); }
                ss += __shfl_xor(ss, 16); ss += __shfl_xor(ss, 32);
                if (fq == 0) (void)__hip_atomic_fetch_add(rss + row, ss, __ATOMIC_RELAXED, __HIP_MEMORY_SCOPE_AGENT); }
    }
};
struct EpiSwiGLU2 {
    static constexpr bool PERM = true, AFTER_DRAIN = false;
    bf16_t* O; int ldc; const float* rss; const float* shw; int ldn;
    __device__ __forceinline__ void operator()(const f32x4 (&acc)[2][2][4][2], const Unit& u, int wr, int wc, int fr, int fq) const {
        const int base = u.pm * BM; const int bb = base < 32768 ? (base >> 12) : 8;
        const int row0 = base + wr * 64 + fr, col0 = u.pn * HALF + wc * 32 + 8 * fq, bcol0 = u.pn * BM + wc * 32 + 8 * fq;
        f32x4 sg[2], su[2];
#pragma unroll
        for (int n = 0; n < 2; ++n) { sg[n] = *(const f32x4*)(shw + (size_t)bb * ldn + bcol0 + 4 * n); su[n] = *(const f32x4*)(shw + (size_t)bb * ldn + bcol0 + HALF + 4 * n); }
#pragma unroll
        for (int ai = 0; ai < 2; ++ai)
#pragma unroll
            for (int m = 0; m < 4; ++m) { const int row = row0 + ai * HALF + m * 16; const float rstd = rsqrtf(rss[row] * (1.f / 1024.f) + 1e-6f);
                f32x4 o[2];
#pragma unroll
                for (int n = 0; n < 2; ++n)
#pragma unroll
                    for (int e = 0; e < 4; ++e) { const float g = acc[ai][0][m][n][e] * rstd + sg[n][e], up = acc[ai][1][m][n][e] * rstd + su[n][e]; o[n][e] = g * fast_sigmoid(g) * up; }
                *(u32x4*)(O + (size_t)row * ldc + col0) = pack8(o[0], o[1]);
            }
    }
};
struct EpiMlIn2 {
    static constexpr bool PERM = true, AFTER_DRAIN = false;
    bf16_t* O; float* gates; const float* gate_b; const float* rss; const float* shw;
    __device__ __forceinline__ void operator()(const f32x4 (&acc)[2][2][4][2], const Unit& u, int wr, int wc, int fr, int fq) const {
        const int base = u.pm * BM; const int bb = base < 32768 ? (base >> 12) : 8;
        const int row0 = base + wr * 64 + fr;
        if (u.pn < 12) {
            const int col0 = u.pn * BM + wc * 32 + 8 * fq;
            f32x4 sv[2][2];
#pragma unroll
            for (int bj = 0; bj < 2; ++bj)
#pragma unroll
                for (int n = 0; n < 2; ++n) sv[bj][n] = *(const f32x4*)(shw + (size_t)bb * 3328 + col0 + bj * HALF + 4 * n);
#pragma unroll
            for (int ai = 0; ai < 2; ++ai)
#pragma unroll
                for (int m = 0; m < 4; ++m) { const int row = row0 + ai * HALF + m * 16; const float rstd = rsqrtf(rss[row] * (1.f / 1024.f) + 1e-6f); bf16_t* rowp = O + (size_t)row * 3072 + col0;
#pragma unroll
                    for (int bj = 0; bj < 2; ++bj) *(u32x4*)(rowp + bj * HALF) = pack8(acc[ai][bj][m][0] * rstd + sv[bj][0], acc[ai][bj][m][1] * rstd + sv[bj][1]); }
        } else if (wc == 0) {
            const int col0 = 8 * fq;
#pragma unroll
            for (int ai = 0; ai < 2; ++ai)
#pragma unroll
                for (int m = 0; m < 4; ++m) { const int row = row0 + ai * HALF + m * 16; const float rstd = rsqrtf(rss[row] * (1.f / 1024.f) + 1e-6f);
#pragma unroll
                    for (int n = 0; n < 2; ++n) { f32x4 v = acc[ai][0][m][n] * rstd + *(const f32x4*)(shw + (size_t)bb * 3328 + 3072 + col0 + 4 * n) + *(const f32x4*)(gate_b + col0 + 4 * n);
                        if (col0 >= 16) {
#pragma unroll
                            for (int e = 0; e < 4; ++e) { const float x = v[e]; v[e] = fminf(x, 0.f) - log1pf(__expf(-fabsf(x))); } }
                        *(f32x4*)(gates + (size_t)row * 32 + col0 + 4 * n) = v; } }
        }
    }
};

template <class Epi, class Sched, bool ALIGN_EPI = false, bool SP2 = false>
__device__ __forceinline__ void gemm_phase(PG8_LAS unsigned char* lds, const Gemm g, const Sched& S, const Epi& E) {
    const int tid = threadIdx.x, wid = __builtin_amdgcn_readfirstlane(tid >> 6), lane = tid & 63, wr = wid >> 2, wc = wid & 3, fr = lane & 15, fq = lane >> 4;
    const int K = g.K, nt = K / BK;
    unsigned voffA[2], voffB[2];
#pragma unroll
    for (int i = 0; i < 2; ++i) { int R, C; stage_rc(tid * 16 + i * 8192, R, C); const int Rb = Epi::PERM ? ((R & ~31) + perm32(R & 31)) : R;
        voffA[i] = (unsigned)(R * K + C) * 2u; voffB[i] = (unsigned)(Rb * K + C) * 2u; }
    const size_t kstep = (size_t)(BK * 2);
    const size_t hstep = (size_t)HALF * K * 2;
    const size_t tstep = 2 * hstep;
    const unsigned ldsw = (unsigned)wid * 1024u;
    const int aoff = lds_byte(wr * 64 + fr, fq * 8), boff = lds_byte(wc * 32 + fr, fq * 8);
#define PG8_SA(b, h) (((b) * 2 + (h)) * HTB)
#define PG8_SB(b, h) ((4 + (b) * 2 + (h)) * HTB)
#define PG8_STAGE(bufoff, gbase, voff) do { _Pragma("unroll") for (int _i = 0; _i < 2; ++_i) \
        __builtin_amdgcn_global_load_lds((const unsigned*)((const char*)(gbase) + (voff)[_i]), (PG8_LAS unsigned*)(lds + (bufoff) + ldsw + _i * 8192), 16, 0, 0); } while (0)
#define PG8_LDA(dst, b, h) do { _Pragma("unroll") for (int m = 0; m < 4; ++m) _Pragma("unroll") for (int k = 0; k < 2; ++k) dst[m][k] = *(const PG8_LAS bf16x8*)(lds + PG8_SA(b, h) + aoff + m * 2048 + k * 1024); } while (0)
#define PG8_LDB(dst, b, h) do { _Pragma("unroll") for (int n = 0; n < 2; ++n) _Pragma("unroll") for (int k = 0; k < 2; ++k) dst[n][k] = *(const PG8_LAS bf16x8*)(lds + PG8_SB(b, h) + boff + n * 2048 + k * 1024); } while (0)
#define PG8_MMA(ai, bj, At, Bt) do { __builtin_amdgcn_s_setprio(1); _Pragma("unroll") for (int m = 0; m < 4; ++m) _Pragma("unroll") for (int n = 0; n < 2; ++n) _Pragma("unroll") for (int k = 0; k < 2; ++k) \
        acc[ai][bj][m][n] = __builtin_amdgcn_mfma_f32_16x16x32_bf16(Bt[n][k], At[m][k], acc[ai][bj][m][n], 0, 0, 0); __builtin_amdgcn_s_setprio(0); } while (0)
#define PG8_WAIT_V(n) asm volatile("s_waitcnt vmcnt(" #n ")" ::: "memory")
#define PG8_WAIT_L(n) asm volatile("s_waitcnt lgkmcnt(" #n ")" ::: "memory")
#define PG8_BAR __builtin_amdgcn_s_barrier()
#define PG8_SCHED __builtin_amdgcn_sched_barrier(0)
    Unit cur, nxt; int ui = 0;
    if (!S.next(0, cur)) return;
    f32x4 acc[2][2][4][2];
#pragma unroll
    for (int a = 0; a < 2; ++a)
#pragma unroll
        for (int b = 0; b < 2; ++b)
#pragma unroll
            for (int m = 0; m < 4; ++m)
#pragma unroll
                for (int n = 0; n < 2; ++n) acc[a][b][m][n] = (f32x4){0.f, 0.f, 0.f, 0.f};
    bf16x8 At[4][2], B0[2][2], B1[2][2];
    const char* cA = (const char*)g.A + (size_t)cur.pm * tstep; const char* cB = (const char*)g.Bt + (size_t)cur.pn * tstep;
    S.a_ready(cur);
    if constexpr (SP2) {
        PG8_STAGE(PG8_SB(0, 0), cB, voffB); PG8_STAGE(PG8_SB(0, 1), cB + hstep, voffB); PG8_STAGE(PG8_SA(0, 0), cA, voffA); PG8_STAGE(PG8_SA(0, 1), cA + hstep, voffA);
        if (wr == 1) PG8_BAR;
        PG8_WAIT_V(2); PG8_BAR;
        PG8_STAGE(PG8_SB(1, 0), cB + kstep, voffB); PG8_STAGE(PG8_SA(1, 0), cA + kstep, voffA); PG8_STAGE(PG8_SB(1, 1), cB + hstep + kstep, voffB);
        PG8_WAIT_V(6); PG8_BAR;
    } else {
        PG8_STAGE(PG8_SB(0, 0), cB, voffB); PG8_STAGE(PG8_SA(0, 0), cA, voffA); PG8_STAGE(PG8_SB(0, 1), cB + hstep, voffB); PG8_STAGE(PG8_SA(0, 1), cA + hstep, voffA);
        if (wr == 1) PG8_BAR;
        PG8_WAIT_V(4); PG8_BAR;
        PG8_STAGE(PG8_SB(1, 0), cB + kstep, voffB); PG8_STAGE(PG8_SA(1, 0), cA + kstep, voffA); PG8_STAGE(PG8_SB(1, 1), cB + hstep + kstep, voffB);
        PG8_WAIT_V(6); PG8_BAR;
    }
    for (;;) {
        const bool has_next = S.next(ui + 1, nxt);
        const char* nA = has_next ? (const char*)g.A + (size_t)nxt.pm * tstep : cA; const char* nB = has_next ? (const char*)g.Bt + (size_t)nxt.pn * tstep : cB;
        for (int t = 0; t < nt; t += 2) {
            const bool last = (t == nt - 2);
            const char* a1 = cA + (size_t)(t + 1) * kstep;
            const char* a2 = last ? nA : cA + (size_t)(t + 2) * kstep; const char* b2 = last ? nB : cB + (size_t)(t + 2) * kstep;
            const char* a3 = a2 + kstep; const char* b3 = b2 + kstep;
            if (last && has_next) S.a_ready(nxt);
            if constexpr (SP2) {
            PG8_LDB(B0, 0, 0); PG8_LDB(B1, 0, 1); PG8_SCHED; PG8_LDA(At, 0, 0); PG8_STAGE(PG8_SA(1, 1), a1 + hstep, voffA);
            PG8_WAIT_V(8); PG8_WAIT_L(0); PG8_BAR; PG8_MMA(0, 0, At, B0); PG8_MMA(0, 1, At, B1); PG8_BAR; PG8_SCHED;
            PG8_LDA(At, 0, 1); PG8_STAGE(PG8_SB(0, 0), b2, voffB); PG8_STAGE(PG8_SB(0, 1), b2 + hstep, voffB); PG8_STAGE(PG8_SA(0, 0), a2, voffA);
            PG8_WAIT_V(8); PG8_WAIT_L(0); PG8_BAR; PG8_MMA(1, 0, At, B0); PG8_MMA(1, 1, At, B1); PG8_BAR; PG8_SCHED;
            PG8_LDB(B0, 1, 0); PG8_LDB(B1, 1, 1); PG8_SCHED; PG8_LDA(At, 1, 0); PG8_STAGE(PG8_SA(0, 1), a2 + hstep, voffA);
            PG8_WAIT_V(8); PG8_WAIT_L(0); PG8_BAR; PG8_MMA(0, 0, At, B0); PG8_MMA(0, 1, At, B1); PG8_BAR; PG8_SCHED;
            PG8_LDA(At, 1, 1); PG8_STAGE(PG8_SB(1, 0), b3, voffB); PG8_STAGE(PG8_SB(1, 1), b3 + hstep, voffB); PG8_STAGE(PG8_SA(1, 0), a3, voffA);
            PG8_WAIT_V(8); PG8_WAIT_L(0); PG8_BAR; PG8_MMA(1, 0, At, B0); PG8_MMA(1, 1, At, B1); PG8_BAR; PG8_SCHED;
            } else {
            PG8_LDB(B0, 0, 0); PG8_SCHED; PG8_LDA(At, 0, 0); PG8_STAGE(PG8_SA(1, 1), a1 + hstep, voffA);
            PG8_WAIT_L(8); PG8_BAR; PG8_WAIT_L(0); PG8_MMA(0, 0, At, B0); PG8_BAR; PG8_SCHED;
            PG8_LDB(B1, 0, 1); PG8_STAGE(PG8_SB(0, 0), b2, voffB);
            PG8_BAR; PG8_WAIT_L(0); PG8_MMA(0, 1, At, B1); PG8_BAR;
            PG8_LDA(At, 0, 1); PG8_STAGE(PG8_SA(0, 0), a2, voffA);
            PG8_BAR; PG8_WAIT_L(0); PG8_MMA(1, 0, At, B0); PG8_BAR; PG8_SCHED;
            PG8_STAGE(PG8_SB(0, 1), b2 + hstep, voffB);
            PG8_WAIT_V(6); PG8_BAR; PG8_MMA(1, 1, At, B1); PG8_BAR;
            PG8_LDB(B0, 1, 0); PG8_SCHED; PG8_LDA(At, 1, 0); PG8_STAGE(PG8_SA(0, 1), a2 + hstep, voffA);
            PG8_WAIT_L(8); PG8_BAR; PG8_WAIT_L(0); PG8_MMA(0, 0, At, B0); PG8_BAR; PG8_SCHED;
            PG8_LDB(B1, 1, 1); PG8_STAGE(PG8_SB(1, 0), b3, voffB);
            PG8_BAR; PG8_WAIT_L(0); PG8_MMA(0, 1, At, B1); PG8_BAR;
            PG8_LDA(At, 1, 1); PG8_STAGE(PG8_SA(1, 0), a3, voffA);
            PG8_BAR; PG8_WAIT_L(0); PG8_MMA(1, 0, At, B0); PG8_BAR; PG8_SCHED;
            PG8_STAGE(PG8_SB(1, 1), b3 + hstep, voffB);
            PG8_WAIT_V(6); PG8_BAR; PG8_MMA(1, 1, At, B1); PG8_BAR;
            }
        }
        if constexpr (ALIGN_EPI) { if (wr == 0) PG8_BAR; }
        if constexpr (!Epi::AFTER_DRAIN) { E(acc, cur, wr, wc, fr, fq); S.done(cur); }
        if (!has_next) break;
#pragma unroll
        for (int a = 0; a < 2; ++a)
#pragma unroll
            for (int b = 0; b < 2; ++b)
#pragma unroll
                for (int m = 0; m < 4; ++m)
#pragma unroll
                    for (int n = 0; n < 2; ++n) acc[a][b][m][n] = (f32x4){0.f, 0.f, 0.f, 0.f};
        cur = nxt; cA = nA; cB = nB; ++ui;
        if constexpr (ALIGN_EPI) { if (wr == 1) PG8_BAR; }
    }
    PG8_WAIT_V(0);
    if constexpr (!ALIGN_EPI) { if (wr == 0) PG8_BAR; }
    PG8_BAR;
    if constexpr (Epi::AFTER_DRAIN) { E.fused(acc, cur, wr, wc, fr, fq, lds, wid, lane); S.done(cur); }
#undef PG8_SA
#undef PG8_SB
#undef PG8_STAGE
#undef PG8_LDA
#undef PG8_LDB
#undef PG8_MMA
#undef PG8_WAIT_V
#undef PG8_WAIT_L
#undef PG8_BAR
#undef PG8_SCHED
}
}

constexpr int D = 1024, NB = 8, TL = 4096, NCTX = 256, MLAT = NB * TL, MCTX = NB * NCTX, MT = MLAT + MCTX;
constexpr int DFF = 2816, NAB = 2560, NML = 3104, NMLP = 3328, LDQ0 = 2048, LDQ1 = 3072;
constexpr int NTHR = 512, NWAVES = 8;
constexpr float EPS = 1e-6f;
constexpr size_t MiB = 1u << 20;
constexpr size_t WS_MOD = 0;
constexpr size_t WS_W_ABIN = 1 * MiB, WS_W_ABOUT = 6 * MiB, WS_W_GU0 = 8 * MiB, WS_W_GU1 = 19 * MiB, WS_W_DN0 = 30 * MiB, WS_W_DN1 = 36 * MiB, WS_W_MLIN = 42 * MiB, WS_W_MLOUT = 49 * MiB;
constexpr size_t WS_BUFA = 52 * MiB;
constexpr size_t WS_XS = 120 * MiB;
constexpr size_t WS_QKV = 256 * MiB;
constexpr size_t WS_GATES = 460 * MiB;
constexpr size_t WS_CTXQK = 466 * MiB;
constexpr size_t WS_NPREV = 471 * MiB;
constexpr size_t WS_MPREV = 473 * MiB;
constexpr size_t WS_RSS = 474 * MiB;
constexpr size_t WS_SHW = 475 * MiB;
constexpr size_t WS_GM = 476 * MiB;
constexpr size_t WS_END = 477 * MiB;
constexpr size_t WS_BAR = 512 * 1024;
constexpr size_t WS_BAR_BYTES = 16384;
constexpr int LDS_BYTES = 147456;
constexpr int LDS_XB_OFF = 131072 + 256;

#define LAS __attribute__((address_space(3)))
typedef unsigned short bf16;
typedef short bf16x8 __attribute__((ext_vector_type(8)));
typedef short s16x4 __attribute__((ext_vector_type(4)));
typedef float f32x4 __attribute__((ext_vector_type(4)));
typedef unsigned u32x4 __attribute__((ext_vector_type(4)));
typedef unsigned u32x2 __attribute__((ext_vector_type(2)));

__device__ __forceinline__ float bf2f(unsigned h) { return __builtin_bit_cast(float, h << 16); }
__device__ __forceinline__ float bflo(unsigned w) { return __builtin_bit_cast(float, w << 16); }
__device__ __forceinline__ float bfhi(unsigned w) { return __builtin_bit_cast(float, w & 0xffff0000u); }
__device__ __forceinline__ unsigned f2bf(float f) { unsigned u = __builtin_bit_cast(unsigned, f); return (u + 0x7fffu + ((u >> 16) & 1u)) >> 16; }
typedef float f32x2_t __attribute__((ext_vector_type(2))); typedef __bf16 bf16x2_t __attribute__((ext_vector_type(2)));
__device__ __forceinline__ unsigned pk2(float lo, float hi) { const f32x2_t v = {lo, hi}; const bf16x2_t b = __builtin_convertvector(v, bf16x2_t); return __builtin_bit_cast(unsigned, b); }
__device__ __forceinline__ float wave_sum(float v) {
#pragma unroll
    for (int o = 1; o < 64; o <<= 1) v += __shfl_xor(v, o);
    return v;
}
__device__ __forceinline__ float wave_max(float v) {
#pragma unroll
    for (int o = 1; o < 64; o <<= 1) v = fmaxf(v, __shfl_xor(v, o));
    return v;
}
__device__ __forceinline__ float fast_sig(float x) { return __builtin_amdgcn_rcpf(1.0f + __expf(-x)); }
__device__ __forceinline__ float silu_f(float x) { return x * __builtin_amdgcn_rcpf(1.0f + __expf(-x)); }
__device__ __forceinline__ void unpack8(const u32x4 w, float (&f)[8]) { f[0] = bflo(w.x); f[1] = bfhi(w.x); f[2] = bflo(w.y); f[3] = bfhi(w.y); f[4] = bflo(w.z); f[5] = bfhi(w.z); f[6] = bflo(w.w); f[7] = bfhi(w.w); }
__device__ __forceinline__ u32x4 pack8f(const float (&f)[8]) { u32x4 w; w.x = pk2(f[0], f[1]); w.y = pk2(f[2], f[3]); w.z = pk2(f[4], f[5]); w.w = pk2(f[6], f[7]); return w; }
typedef short v4i16_t __attribute__((ext_vector_type(4)));
__device__ __forceinline__ s16x4 trread(const LAS char* p) { return __builtin_bit_cast(s16x4, __builtin_amdgcn_ds_read_tr16_b64_v4i16((LAS v4i16_t*)p)); }
__device__ __forceinline__ bf16x8 cat44(const s16x4 a, const s16x4 b) { bf16x8 r; r[0] = a[0]; r[1] = a[1]; r[2] = a[2]; r[3] = a[3]; r[4] = b[0]; r[5] = b[1]; r[6] = b[2]; r[7] = b[3]; return r; }
#define MFMA16(a, b, c) __builtin_amdgcn_mfma_f32_16x16x32_bf16((a), (b), (c), 0, 0, 0)

struct Params {
    const float* in[26]; float* out; unsigned char* ws; int ph_lo, ph_hi; int rep, pad;
};
typedef const float* const __attribute__((address_space(4)))* kin_ptr_t;
__device__ __forceinline__ kin_ptr_t kin() { kin_ptr_t q = (kin_ptr_t)__builtin_amdgcn_kernarg_segment_ptr(); asm volatile("" : "+s"(q)); return q; }

__device__ __forceinline__ void transpose_matrix(const float* W, int K, int N, bf16* WT, int kind, LAS float* scr, int gw, int NGW, int lane, int& start) {
    const int nblk = N / 32, items = nblk * (K / 64);
    int first = gw - start; if (first < 0) first += NGW;
    for (int it = first; it < items; it += NGW) {
        const int kb = it / nblk, nb = it % nblk, k0 = 64 * kb, n0 = 32 * nb;
        { const int kr = lane >> 3, nc = lane & 7; f32x4 v[8];
#pragma unroll
          for (int i = 0; i < 8; ++i) v[i] = *(const f32x4*)(W + (size_t)(k0 + 8 * i + kr) * N + n0 + 4 * nc);
#pragma unroll
          for (int i = 0; i < 8; ++i) { LAS float* sp = scr + (8 * i + kr) * 33 + 4 * nc; sp[0] = v[i][0]; sp[1] = v[i][1]; sp[2] = v[i][2]; sp[3] = v[i][3]; } }
        asm volatile("s_waitcnt lgkmcnt(0)" ::: "memory");
        const int drow0 = kind == 0 ? n0 : (kind == 3 ? (n0 < 1536 ? n0 : (n0 < 2048 ? 1536 + ((n0 - 1536) >> 7) * 256 + ((n0 - 1536) & 127) : 1536 + ((n0 - 2048) >> 7) * 256 + 128 + ((n0 - 2048) & 127)))
                                                  : ((n0 >> 7) * 256 + (kind == 2 ? 128 : 0) + (n0 & 127)));
        const int c = lane & 7;
#pragma unroll
        for (int j = 0; j < 4; ++j) { const int n = (lane >> 3) + 8 * j; const LAS float* s = scr + (8 * c) * 33 + n;
            u32x4 o; o.x = pk2(s[0 * 33], s[1 * 33]); o.y = pk2(s[2 * 33], s[3 * 33]); o.z = pk2(s[4 * 33], s[5 * 33]); o.w = pk2(s[6 * 33], s[7 * 33]);
            *(u32x4*)(WT + (size_t)(drow0 + n) * K + k0 + 8 * c) = o; }
        asm volatile("s_waitcnt lgkmcnt(0)" ::: "memory");
    }
    start = (start + items) % NGW;
}

__device__ __forceinline__ void phase_prologue(const Params& p, LAS unsigned char* lds, int tid, int lane, int wave) {
    unsigned char* ws = p.ws;
    const int gw = blockIdx.x * NWAVES + wave, NGW = gridDim.x * NWAVES;
    LAS float* scr = (LAS float*)(lds + wave * 8704);
    int start = 0;
    transpose_matrix(kin()[11], D, NAB, (bf16*)(ws + WS_W_ABIN), 3, scr, gw, NGW, lane, start);
    __syncthreads();
    LAS float* sv = (LAS float*)lds;
    LAS float* part = (LAS float*)(lds + 40960);
    for (int i = tid; i < 9 * 1024; i += NTHR) { const float c = i < 8192 ? kin()[1][i] : kin()[3][i - 8192]; sv[i] = silu_f(c); }
    __syncthreads();
    float* mod = (float*)(ws + WS_MOD);
    for (int item = blockIdx.x; item < 192; item += gridDim.x) {
        const int l = item / 96, cgp = item % 96, col = cgp * 64 + lane;
        const float* W = kin()[4] + (size_t)l * D * 6144 + col;
        float a[9];
#pragma unroll
        for (int b = 0; b < 9; ++b) a[b] = 0.f;
#pragma unroll 16
        for (int k = wave * 128; k < wave * 128 + 128; ++k) { const float wv = W[(size_t)k * 6144];
#pragma unroll
            for (int b = 0; b < 9; ++b) a[b] += sv[b * 1024 + k] * wv; }
#pragma unroll
        for (int b = 0; b < 9; ++b) part[(wave * 9 + b) * 64 + lane] = a[b];
        __syncthreads();
        for (int i = tid; i < 576; i += NTHR) { const int b = i >> 6, ln = i & 63; float s = 0.f;
#pragma unroll
            for (int w = 0; w < 8; ++w) s += part[(w * 9 + b) * 64 + ln];
            mod[(size_t)(l * 9 + b) * 6144 + cgp * 64 + ln] = s + kin()[5][l * 6144 + cgp * 64 + ln]; }
        __syncthreads();
    }
}


__device__ __forceinline__ void phase_aux(const Params& p, LAS unsigned char* lds, int tid, int lane, int wave) {
    unsigned char* ws = p.ws; const float* mod = (const float*)(ws + WS_MOD);
    const int gt = blockIdx.x * NTHR + tid, NGT = gridDim.x * NTHR;
    const int gw = blockIdx.x * NWAVES + wave, NGW = gridDim.x * NWAVES;
    float* rss = (float*)(ws + WS_RSS); for (int i = gt; i < 3 * MT; i += NGT) rss[i] = 0.f;
    float* gm = (float*)(ws + WS_GM);
    for (int i = gt; i < 3 * 9 * 1024; i += NGT) { const int s = i / 9216, r = i % 9216, bb = r >> 10, k = r & 1023;
        const float* ng = s == 1 ? kin()[6] + D : (s == 0 ? kin()[7] : kin()[7] + D); const int l = s == 0 ? 0 : 1; const int sc_off = s == 1 ? 1024 : 4096;
        const float gmv_ = ng[k] * (1.0f + mod[(size_t)(l * 9 + bb) * 6144 + sc_off + k]); gm[i] = gmv_; gm[3 * 9216 + i] = fabsf(gmv_) > 1e-30f ? 1.0f / gmv_ : 0.f; }
    __syncthreads();
}
__device__ __forceinline__ void shw_compute(const Params& p, int s, int rank, int nblk, LAS unsigned char* lds, int tid, int lane, int wave) {
    unsigned char* ws = p.ws; const float* mod = (const float*)(ws + WS_MOD);
    const int gw = rank * NWAVES + wave, NGW = nblk * NWAVES;
    LAS float* shl = (LAS float*)lds;
    float* shw = (float*)(ws + WS_SHW);
    const int l = s == 0 ? 0 : 1, sh_off = s == 1 ? 0 : 3072, N = s == 1 ? NMLP : 2 * DFF;
    const bf16* Wt = (const bf16*)(ws + (s == 0 ? WS_W_GU0 : (s == 1 ? WS_W_MLIN : WS_W_GU1)));
    float* dst = shw + (s == 0 ? 0 : (s == 1 ? 9 * 5632 : 9 * 5632 + 9 * 3328));
    __syncthreads();
    for (int i = tid; i < 9 * 1024; i += NTHR) shl[i] = mod[(size_t)(l * 9 + (i >> 10)) * 6144 + sh_off + (i & 1023)];
    __syncthreads();
    for (int n = gw; n < N; n += NGW) {
        float w[16]; { const u32x4* wp = (const u32x4*)(Wt + (size_t)n * D + lane * 16); float t8[8]; unpack8(wp[0], t8);
#pragma unroll
            for (int e = 0; e < 8; ++e) w[e] = t8[e];
            unpack8(wp[1], t8);
#pragma unroll
            for (int e = 0; e < 8; ++e) w[8 + e] = t8[e]; }
        float res = 0.f;
#pragma unroll
        for (int bb = 0; bb < 9; ++bb) { float a = 0.f; const LAS f32x4* sp = (const LAS f32x4*)(shl + bb * 1024 + lane * 16);
#pragma unroll
            for (int j = 0; j < 4; ++j) { const f32x4 sv = sp[j]; a += (w[4 * j] * sv[0] + w[4 * j + 1] * sv[1]) + (w[4 * j + 2] * sv[2] + w[4 * j + 3] * sv[3]); }
            a = wave_sum(a); if (lane == bb) res = a; }
        if (lane < 9) dst[(size_t)lane * N + n] = res;
    }
    __syncthreads();
}
__device__ __forceinline__ void side_weights(const Params& p, int set, int rank, int nblk, LAS unsigned char* lds, int tid, int lane, int wave) {
    unsigned char* ws = p.ws;
    const int gw = rank * NWAVES + wave, NGW = nblk * NWAVES;
    LAS float* scr = (LAS float*)(lds + wave * 8704);
    int start = 0;
    if (set == 0) {
        transpose_matrix(kin()[19], D, D, (bf16*)(ws + WS_W_ABOUT), 0, scr, gw, NGW, lane, start);
        transpose_matrix(kin()[8], D, DFF, (bf16*)(ws + WS_W_GU0), 1, scr, gw, NGW, lane, start);
        transpose_matrix(kin()[9], D, DFF, (bf16*)(ws + WS_W_GU0), 2, scr, gw, NGW, lane, start);
    } else if (set == 1) {
        transpose_matrix(kin()[10], DFF, D, (bf16*)(ws + WS_W_DN0), 0, scr, gw, NGW, lane, start);
        transpose_matrix(kin()[20], D, NML, (bf16*)(ws + WS_W_MLIN), 0, scr, gw, NGW, lane, start);
        u32x4* z = (u32x4*)(ws + WS_W_MLIN + (size_t)NML * D * 2); const int n16 = (NMLP - NML) * D * 2 / 16;
        for (int i = rank * NTHR + tid; i < n16; i += nblk * NTHR) z[i] = (u32x4){0u, 0u, 0u, 0u};
    } else {
        transpose_matrix(kin()[25], D, D, (bf16*)(ws + WS_W_MLOUT), 0, scr, gw, NGW, lane, start);
        transpose_matrix(kin()[8] + (size_t)D * DFF, D, DFF, (bf16*)(ws + WS_W_GU1), 1, scr, gw, NGW, lane, start);
        transpose_matrix(kin()[9] + (size_t)D * DFF, D, DFF, (bf16*)(ws + WS_W_GU1), 2, scr, gw, NGW, lane, start);
        transpose_matrix(kin()[10] + (size_t)DFF * D, DFF, D, (bf16*)(ws + WS_W_DN1), 0, scr, gw, NGW, lane, start);
    }
    __syncthreads();
}

__device__ __forceinline__ void phase_norm(const float* __restrict__ src_lat, const float* __restrict__ src_ctx, const float* __restrict__ g, const float* __restrict__ modl, int sh_off, int sc_off, int Mrows, bf16* __restrict__ H, int lane, int wave) {
    const int gw = blockIdx.x * NWAVES + wave, NGW = gridDim.x * NWAVES;
    f32x4 gv[4];
#pragma unroll
    for (int j = 0; j < 4; ++j) gv[j] = ((const f32x4*)g)[lane + 64 * j];
#pragma unroll 2
    for (int row = gw; row < Mrows; row += NGW) {
        const float* src = row < MLAT ? src_lat : src_ctx; const int bb = row < MLAT ? (row >> 12) : 8;
        const f32x4* xr = (const f32x4*)(src + (size_t)row * D) + lane;
        f32x4 v[4]; float ss = 0.f;
#pragma unroll
        for (int j = 0; j < 4; ++j) { v[j] = xr[64 * j]; ss += (v[j].x * v[j].x + v[j].y * v[j].y) + (v[j].z * v[j].z + v[j].w * v[j].w); }
        const float rstd = rsqrtf(wave_sum(ss) * (1.f / D) + EPS);
        const f32x4* sc = (const f32x4*)(modl + (size_t)bb * 6144 + sc_off) + lane; const f32x4* sh = (const f32x4*)(modl + (size_t)bb * 6144 + sh_off) + lane;
        u32x2* o = (u32x2*)(H + (size_t)row * D) + lane;
#pragma unroll
        for (int j = 0; j < 4; ++j) { const f32x4 y = v[j] * rstd * gv[j] * (sc[64 * j] + 1.0f) + sh[64 * j]; u32x2 w; w.x = pk2(y.x, y.y); w.y = pk2(y.z, y.w); o[64 * j] = w; }
    }
}

__device__ __forceinline__ void phase_qknorm(bf16* QKV, const float* qg, const float* kg, int lane, int wave) {
    const int gw = blockIdx.x * NWAVES + wave, NGW = gridDim.x * NWAVES;
    float gq[8], gk[8];
#pragma unroll
    for (int e = 0; e < 8; ++e) { gq[e] = qg[(lane & 7) * 8 + e] * 0.125f; gk[e] = kg[(lane & 7) * 8 + e]; }
    for (int item = gw; item < MT * 2; item += NGW) {
        const int row = item >> 1, half = item & 1;
        u32x4* ptr = (u32x4*)(QKV + (size_t)row * LDQ0 + half * 512) + lane;
        float f[8]; unpack8(*ptr, f);
        float ss = 0.f;
#pragma unroll
        for (int e = 0; e < 8; ++e) ss += f[e] * f[e];
        ss += __shfl_xor(ss, 1); ss += __shfl_xor(ss, 2); ss += __shfl_xor(ss, 4);
        const float rstd = rsqrtf(ss * (1.f / 64.f) + EPS);
#pragma unroll
        for (int e = 0; e < 8; ++e) f[e] = f[e] * rstd * (half ? gk[e] : gq[e]);
        *ptr = pack8f(f);
    }
}

__device__ __forceinline__ void phase_conv(const bf16* QKV, const float* cw, const float* cb, const float* lng, const float* lnb, bf16* ATT, LAS unsigned char* lds, int tid, int lane, int wave) {
    LAS unsigned short* glu = (LAS unsigned short*)lds;
    LAS float* ybuf = (LAS float*)(lds + 65536);
    float w[31];
#pragma unroll
    for (int i = 0; i < 31; ++i) w[i] = cw[i * 512 + tid];
    const float bias = cb[tid];
    float lg[8], lb[8];
#pragma unroll
    for (int e = 0; e < 8; ++e) { lg[e] = lng[lane * 8 + e]; lb[e] = lnb[lane * 8 + e]; }
    u32x4 ru[8];
#define CONV_LOAD(it_) do { int sb_, sl_, t0_; if ((it_) < 1024) { sb_ = ((it_) >> 7) * TL; sl_ = TL; t0_ = ((it_) & 127) * 32; } else { const int j_ = (it_) - 1024; sb_ = MLAT + (j_ >> 3) * NCTX; sl_ = NCTX; t0_ = (j_ & 7) * 32; } \
        _Pragma("unroll") for (int ps_ = 0; ps_ < 8; ++ps_) { const int i_ = ps_ * 8 + (tid >> 6); const int t_ = t0_ - 15 + i_; ru[ps_] = (u32x4){0u, 0u, 0u, 0u}; \
            if (i_ < 62 && t_ >= 0 && t_ < sl_) ru[ps_] = *(const u32x4*)(QKV + (size_t)(sb_ + t_) * LDQ0 + 1536 + lane * 8); } } while (0)
    if ((int)blockIdx.x < 1088) CONV_LOAD((int)blockIdx.x);
    for (int it = blockIdx.x; it < 1088; it += gridDim.x) {
        int seq_base, t0;
        if (it < 1024) { seq_base = (it >> 7) * TL; t0 = (it & 127) * 32; } else { const int j = it - 1024; seq_base = MLAT + (j >> 3) * NCTX; t0 = (j & 7) * 32; }
#pragma unroll
        for (int ps = 0; ps < 8; ++ps) { const int i = ps * 8 + (tid >> 6); if (i < 62) *(LAS u32x4*)(glu + i * 512 + lane * 8) = ru[ps]; }
        if (it + (int)gridDim.x < 1088) CONV_LOAD(it + (int)gridDim.x);
        __syncthreads();
        for (int tg = 0; tg < 4; ++tg) {
            float v[38];
#pragma unroll
            for (int j = 0; j < 38; ++j) v[j] = bf2f(glu[(tg * 8 + j) * 512 + tid]);
#pragma unroll
            for (int t = 0; t < 8; ++t) { float a = bias;
#pragma unroll
                for (int k = 0; k < 31; ++k) a += v[t + k] * w[k];
                ybuf[(tg * 8 + t) * 512 + tid] = a; }
        }
        __syncthreads();
#pragma unroll
        for (int q = 0; q < 4; ++q) { const int t = wave * 4 + q; const LAS f32x4* yp = (const LAS f32x4*)(ybuf + t * 512 + lane * 8);
            const f32x4 a = yp[0], b = yp[1]; float f[8] = {a.x, a.y, a.z, a.w, b.x, b.y, b.z, b.w};
            float s = 0.f;
#pragma unroll
            for (int e = 0; e < 8; ++e) s += f[e];
            const float mu = wave_sum(s) * (1.f / 512.f); float s2 = 0.f;
#pragma unroll
            for (int e = 0; e < 8; ++e) { f[e] -= mu; s2 += f[e] * f[e]; }
            const float rstd = rsqrtf(wave_sum(s2) * (1.f / 512.f) + EPS);
#pragma unroll
            for (int e = 0; e < 8; ++e) f[e] = silu_f(f[e] * rstd * lg[e] + lb[e]);
            *(u32x4*)(ATT + (size_t)(seq_base + t0 + t) * D + 512 + lane * 8) = pack8f(f); }
    }
    __syncthreads();
}

constexpr int AVS = 144;
template <int NQR>
__device__ __forceinline__ void attn_wave(const bf16* QKV, int tq0, int h, int krlo, int nkr, int tkloc0, const LAS char* ck, const LAS char* cv, const LAS float* rpbh, int rbase, int qc0, int kc0, bf16* ATT, LAS char* vl, int lane, const LAS float* gqk) {
    const int fr = lane & 15, g = lane >> 4, q4 = (lane & 15) >> 2, p4 = lane & 3;
    bf16x8 qf[NQR][2]; f32x4 oacc[NQR][4]; float lrun[NQR]; int r0q[NQR];
    const float sref = __builtin_bit_cast(float, __builtin_amdgcn_readfirstlane(__builtin_bit_cast(int, gqk[64])));
#pragma unroll
    for (int qr = 0; qr < NQR; ++qr) {
        const bf16* qp = QKV + (size_t)(tq0 + 64 * qr + fr) * LDQ0 + h * 64 + 8 * g;
        { float a8[8], b8[8]; unpack8(*(const u32x4*)qp, a8); unpack8(*(const u32x4*)(qp + 32), b8); float ss = 0.f;
#pragma unroll
          for (int e = 0; e < 8; ++e) ss += a8[e] * a8[e] + b8[e] * b8[e];
          ss += __shfl_xor(ss, 16); ss += __shfl_xor(ss, 32); const float rq = rsqrtf(ss * (1.f / 64.f) + EPS);
#pragma unroll
          for (int e = 0; e < 8; ++e) { a8[e] *= rq * gqk[8 * g + e]; b8[e] *= rq * gqk[32 + 8 * g + e]; }
          qf[qr][0] = __builtin_bit_cast(bf16x8, pack8f(a8)); qf[qr][1] = __builtin_bit_cast(bf16x8, pack8f(b8)); }
#pragma unroll
        for (int c = 0; c < 4; ++c) oacc[qr][c] = (f32x4){0.f, 0.f, 0.f, 0.f};
        lrun[qr] = 0.f; r0q[qr] = min(max(rbase + qr - 4, 0), 56);
    }
    const int qcol = qc0 + fr; const int lo = min(max(qcol - 8, 0), 48);
#define ATT_QR_BODY(LOCAL, KR) \
    _Pragma("unroll") for (int qr = 0; qr < NQR; ++qr) { \
        if (!(LOCAL) || ((KR) >= r0q[qr] && (KR) < r0q[qr] + 8)) { \
            f32x4 st[2]; \
            _Pragma("unroll") for (int jb = 0; jb < 2; ++jb) { st[jb] = MFMA16(kf[2 * jb], qf[qr][0], ((f32x4){0.f, 0.f, 0.f, 0.f})); st[jb] = MFMA16(kf[2 * jb + 1], qf[qr][1], st[jb]); } \
            float ps = 0.f; float pv[8]; \
            if (LOCAL) { const LAS float* rrow = rpbh + ((KR) - (rbase + qr) + 7) * 31; \
                _Pragma("unroll") for (int jb = 0; jb < 2; ++jb) _Pragma("unroll") for (int e = 0; e < 4; ++e) { const int kcol = kc0 + 16 * jb + 4 * g + e; const bool valid = (kcol >= lo) && (kcol < lo + 16); \
                    const int rel = min(max(kcol - qcol + 15, 0), 30); const float bv = valid ? rrow[rel] : -1e30f; \
                    const float pe = __builtin_amdgcn_exp2f(st[jb][e] + bv); pv[jb * 4 + e] = pe; ps += pe; } \
            } else { \
                _Pragma("unroll") for (int jb = 0; jb < 2; ++jb) _Pragma("unroll") for (int e = 0; e < 4; ++e) { const float pe = __builtin_amdgcn_exp2f(st[jb][e] - sref); pv[jb * 4 + e] = pe; ps += pe; } \
            } \
            lrun[qr] += ps; \
            const bf16x8 pf = __builtin_bit_cast(bf16x8, pack8f(pv)); \
            _Pragma("unroll") for (int c = 0; c < 4; ++c) oacc[qr][c] = MFMA16(vfr[c], pf, oacc[qr][c]); \
        } }
    if (nkr > 0) {
        bf16x8 kf[4]; u32x4 vv[4];
        {
            const bf16* kp = QKV + (size_t)(tkloc0 + fr) * LDQ0 + 512 + h * 64 + 8 * g;
            kf[0] = *(const bf16x8*)kp; kf[1] = *(const bf16x8*)(kp + 32); kf[2] = *(const bf16x8*)(kp + 16 * LDQ0); kf[3] = *(const bf16x8*)(kp + 16 * LDQ0 + 32);
#pragma unroll
            for (int i = 0; i < 4; ++i) { const int c = lane + 64 * i; vv[i] = *(const u32x4*)(QKV + (size_t)(tkloc0 + (c >> 3)) * LDQ0 + 1024 + h * 64 + (c & 7) * 8); }
        }
#pragma unroll 1
        for (int s = 0; s < nkr; ++s) {
            bf16x8 kn[4]; u32x4 vn[4];
            if (s + 1 < nkr) {
                const int tk0 = tkloc0 + (s + 1) * 64;
                const bf16* kp = QKV + (size_t)(tk0 + fr) * LDQ0 + 512 + h * 64 + 8 * g;
                kn[0] = *(const bf16x8*)kp; kn[1] = *(const bf16x8*)(kp + 32); kn[2] = *(const bf16x8*)(kp + 16 * LDQ0); kn[3] = *(const bf16x8*)(kp + 16 * LDQ0 + 32);
#pragma unroll
                for (int i = 0; i < 4; ++i) { const int c = lane + 64 * i; vn[i] = *(const u32x4*)(QKV + (size_t)(tk0 + (c >> 3)) * LDQ0 + 1024 + h * 64 + (c & 7) * 8); }
            } else {
#pragma unroll
                for (int i = 0; i < 4; ++i) { kn[i] = (bf16x8){0, 0, 0, 0, 0, 0, 0, 0}; vn[i] = (u32x4){0u, 0u, 0u, 0u}; }
            }
#pragma unroll
            for (int i = 0; i < 4; ++i) { const int c = lane + 64 * i; *(LAS u32x4*)(vl + (c >> 3) * AVS + (c & 7) * 16) = vv[i]; }
            asm volatile("s_waitcnt lgkmcnt(0)" ::: "memory");
            bf16x8 vfr[4];
#pragma unroll
            for (int c = 0; c < 4; ++c) vfr[c] = cat44(trread(vl + (4 * g + q4) * AVS + (16 * c + 4 * p4) * 2), trread(vl + (16 + 4 * g + q4) * AVS + (16 * c + 4 * p4) * 2));
            asm volatile("s_waitcnt lgkmcnt(0)" ::: "memory");
            const int kr = krlo + s;
#pragma unroll
            for (int jb = 0; jb < 2; ++jb) { float a8[8], b8[8]; unpack8(__builtin_bit_cast(u32x4, kf[2 * jb]), a8); unpack8(__builtin_bit_cast(u32x4, kf[2 * jb + 1]), b8); float ss = 0.f;
#pragma unroll
                for (int e = 0; e < 8; ++e) ss += a8[e] * a8[e] + b8[e] * b8[e];
                ss += __shfl_xor(ss, 16); ss += __shfl_xor(ss, 32); const float rk = rsqrtf(ss * (1.f / 64.f) + EPS);
#pragma unroll
                for (int e = 0; e < 8; ++e) { a8[e] *= rk; b8[e] *= rk; }
                kf[2 * jb] = __builtin_bit_cast(bf16x8, pack8f(a8)); kf[2 * jb + 1] = __builtin_bit_cast(bf16x8, pack8f(b8));
                if (jb == 0) asm volatile("" : "+v"(kf[2]), "+v"(kf[3]) : "v"(kf[0]), "v"(kf[1]));
            }
            ATT_QR_BODY(true, kr)
#pragma unroll
            for (int i = 0; i < 4; ++i) { kf[i] = kn[i]; vv[i] = vn[i]; }
        }
    }
    int lane2 = lane; asm volatile("" : "+v"(lane2));
    const int fr2 = lane2 & 15, g2 = lane2 >> 4, q42 = (lane2 & 15) >> 2, p42 = lane2 & 3;
#pragma unroll 1
    for (int s = 0; s < 8; ++s) {
        const LAS char* kb = ck + (32 * s + fr2) * AVS + 16 * g2; const LAS char* vb = cv + 32 * s * AVS;
        bf16x8 kf[4];
        kf[0] = *(const LAS bf16x8*)kb; kf[1] = *(const LAS bf16x8*)(kb + 64); kf[2] = *(const LAS bf16x8*)(kb + 16 * AVS); kf[3] = *(const LAS bf16x8*)(kb + 16 * AVS + 64);
        bf16x8 vfr[4];
#pragma unroll
        for (int c = 0; c < 4; ++c) vfr[c] = cat44(trread(vb + (4 * g2 + q42) * AVS + (16 * c + 4 * p42) * 2), trread(vb + (16 + 4 * g2 + q42) * AVS + (16 * c + 4 * p42) * 2));
        ATT_QR_BODY(false, 0)
    }
#undef ATT_QR_BODY
#pragma unroll
    for (int qr = 0; qr < NQR; ++qr) {
        float lt = lrun[qr]; lt += __shfl_xor(lt, 16); lt += __shfl_xor(lt, 32);
        const float inv = 1.0f / lt;
        bf16* op = ATT + (size_t)(tq0 + 64 * qr + fr2) * D + h * 64 + 4 * g2;
#pragma unroll
        for (int c = 0; c < 4; ++c) { u32x2 w; w.x = pk2(oacc[qr][c][0] * inv, oacc[qr][c][1] * inv); w.y = pk2(oacc[qr][c][2] * inv, oacc[qr][c][3] * inv); *(u32x2*)(op + 16 * c) = w; }
    }
}

__device__ __forceinline__ void attn_stage_ctx(const bf16* QKV, int b, int h, LAS char* ck, LAS char* cv, int tid) {
#pragma unroll
    for (int i = 0; i < 4; ++i) { const int id = tid + 512 * i; const int key = id >> 3, dc = id & 7;
        const bf16* rp = QKV + (size_t)(MLAT + b * NCTX + key) * LDQ0 + h * 64 + dc * 8;
        float f[8]; unpack8(*(const u32x4*)(rp + 512), f); float ss = 0.f;
#pragma unroll
        for (int e = 0; e < 8; ++e) ss += f[e] * f[e];
        ss += __shfl_xor(ss, 1); ss += __shfl_xor(ss, 2); ss += __shfl_xor(ss, 4);
        const float rk = rsqrtf(ss * (1.f / 64.f) + EPS);
#pragma unroll
        for (int e = 0; e < 8; ++e) f[e] *= rk;
        *(LAS u32x4*)(ck + key * AVS + dc * 16) = pack8f(f);
        *(LAS u32x4*)(cv + key * AVS + dc * 16) = *(const u32x4*)(rp + 1024); }
}

__device__ __forceinline__ void phase_attn(const bf16* QKV, const float* rpb, const float* qg, const float* kg, bf16* ATT, LAS unsigned char* lds, int lane, int wave) {
    LAS char* vl = (LAS char*)lds + wave * 4608;
    LAS char* ck = (LAS char*)lds + 36864; LAS char* cv = (LAS char*)lds + 73728;
    LAS float* rpbl = (LAS float*)(lds + 110592);
    LAS float* gqk = (LAS float*)(lds + 126976);
    if (threadIdx.x < 64) { const float gv = qg[threadIdx.x] * kg[threadIdx.x] * (0.125f * 1.44269504f); gqk[threadIdx.x] = gv;
        const float bnd = 64.0f * wave_max(fabsf(gv)); if (threadIdx.x == 0) gqk[64] = bnd; }
    __syncthreads();
    { const float bnd = gqk[64]; for (int i = threadIdx.x; i < 8 * 15 * 31; i += NTHR) rpbl[i] = rpb[i] * 1.44269504f - bnd; }
    for (int item = blockIdx.x; item < 512; item += gridDim.x) {
        const int h = item & 7, rgp = (item >> 3) & 7, b = item >> 6;
        __syncthreads();
        { int lane_i = lane; asm volatile("" : "+v"(lane_i)); attn_stage_ctx(QKV, b, h, ck, cv, wave * 64 + lane_i); }
        __syncthreads();
        const int cgp = wave & 3, rg = 2 * rgp + (wave >> 2);
        const int rbase = 4 * rg; const int krlo = min(max(rbase - 4, 0), 56); const int krhi = min(max(rbase + 3 - 4, 0), 56) + 8;
        const int kc0 = cgp == 0 ? 0 : (cgp == 1 ? 8 : (cgp == 2 ? 24 : 32));
        attn_wave<4>(QKV, b * TL + rbase * 64 + 16 * cgp, h, krlo, krhi - krlo, b * TL + krlo * 64 + kc0, ck, cv, rpbl + h * 15 * 31, rbase, 16 * cgp, kc0, ATT, vl, lane, gqk);
    }
    { int lane_b = lane; asm volatile("" : "+v"(lane_b)); lane = lane_b; }
    for (int item = ((int)blockIdx.x + (int)gridDim.x / 2) % (int)gridDim.x; item < 64; item += gridDim.x) {
        const int h = item & 7, b = item >> 3;
        __syncthreads();
        { int lane_i = lane; asm volatile("" : "+v"(lane_i)); attn_stage_ctx(QKV, b, h, ck, cv, wave * 64 + lane_i); }
        __syncthreads();
#pragma unroll 1
        for (int k = 0; k < 2; ++k) attn_wave<1>(QKV, MLAT + b * NCTX + 16 * (wave + 8 * k), h, 0, 0, 0, ck, cv, rpbl, 0, 0, 0, ATT, vl, lane, gqk);
    }
    __syncthreads();
}

__device__ __forceinline__ void phase_mlprep(const bf16* __restrict__ QKVO, const float* __restrict__ cw, const float* __restrict__ cb, bf16* __restrict__ QKP, bf16* __restrict__ CTXQK, LAS unsigned char* lds, int lane, int wave) {
    const int gw = blockIdx.x * NWAVES + wave, NGW = gridDim.x * NWAVES;
    LAS float* cosT = (LAS float*)lds; LAS float* sinT = cosT + 1024;
    for (int i = wave * 64 + lane; i < 1024; i += NTHR) { const float ang = (float)(i >> 4) * exp2f(-(float)(i & 15) * (13.287712379549449f / 16.f)); cosT[i] = __cosf(ang); sinT[i] = __sinf(ang); }
    __syncthreads();
    for (int half = 0; half < 2; ++half) {
        const int cbase = half * 512 + lane * 8;
        float w[5][8], bias[8];
#pragma unroll
        for (int k = 0; k < 5; ++k)
#pragma unroll
            for (int e = 0; e < 8; ++e) w[k][e] = cw[k * 1024 + cbase + e];
#pragma unroll
        for (int e = 0; e < 8; ++e) bias[e] = cb[cbase + e];
        const int mrows = half == 0 ? MLAT : MT;
#pragma unroll 2
        for (int row = gw; row < mrows; row += NGW) {
            int t, len; if (row < MLAT) { t = row & (TL - 1); len = TL; } else { t = (row - MLAT) & (NCTX - 1); len = NCTX; }
            float a[8];
#pragma unroll
            for (int e = 0; e < 8; ++e) a[e] = bias[e];
#pragma unroll
            for (int k = 0; k < 5; ++k) { const int tt = t + k - 2;
                if (tt >= 0 && tt < len) { float f[8]; unpack8(*(const u32x4*)(QKVO + (size_t)(row + k - 2) * LDQ1 + cbase), f);
#pragma unroll
                    for (int e = 0; e < 8; ++e) a[e] += f[e] * w[k][e]; } }
            const float qs = half == 0 ? 0.125f : 1.0f;
#pragma unroll
            for (int e = 0; e < 8; ++e) a[e] = silu_f(a[e]) * qs;
            if (row < MLAT) {
                const int pos = (lane & 4) ? (t & 63) : (t >> 6); const int ti = pos * 16 + (lane & 1) * 8;
                const f32x4 c0 = *(const LAS f32x4*)(cosT + ti), c1 = *(const LAS f32x4*)(cosT + ti + 4), s0 = *(const LAS f32x4*)(sinT + ti), s1 = *(const LAS f32x4*)(sinT + ti + 4);
                const float csv[8] = {c0[0], c0[1], c0[2], c0[3], c1[0], c1[1], c1[2], c1[3]}, snv[8] = {s0[0], s0[1], s0[2], s0[3], s1[0], s1[1], s1[2], s1[3]};
#pragma unroll
                for (int e = 0; e < 8; ++e) { const float cs = csv[e], sn = snv[e]; const float other = __shfl_xor(a[e], 2);
                    a[e] = (lane & 2) ? (other * sn + a[e] * cs) : (a[e] * cs - other * sn); }
                *(u32x4*)(QKP + (size_t)row * D + cbase) = pack8f(a);
            } else {
                *(u32x4*)(CTXQK + (size_t)(row - MLAT) * D + cbase) = pack8f(a);
            }
        }
    }
}

constexpr int SKS = 144;
__device__ __forceinline__ void phase_mlscan(const bf16* QKVO, const bf16* QKP, const bf16* CTXQK, const float* GATES, bf16* SPREV, float* NPREV, float* MPREV, LAS unsigned char* lds, int tid, int lane, int wave) {
    LAS char* tb = (LAS char*)lds;
    LAS float* lnb = (LAS float*)(lds + 73728);
    LAS float* weT = (LAS float*)(lds + 77824);
    LAS float* totT = (LAS float*)(lds + 95232);
    LAS float* mlocT = totT + 64;
    LAS float* mbefT = totT + 128;
    LAS float* mnewT = totT + 192;
    LAS float* decT = totT + 256;
    const int g = lane >> 4, fr = lane & 15, q4 = (lane & 15) >> 2, p4 = lane & 3;
    const int dvb = wave >> 1, dkb0 = 2 * (wave & 1);
    for (int item = blockIdx.x; item < 256; item += gridDim.x) {
        const int vh = item & 1, dir = (item >> 1) & 1, h = (item >> 2) & 7, b = item >> 5;
#define SCAN_ROW0(st) ((st) < 2 ? MLAT + b * NCTX + (dir ? 1 - (st) : (st)) * 128 : b * TL + (dir ? 31 - ((st) - 2) : (st) - 2) * 128)
#pragma unroll 1
        for (int st = wave; st < 34; st += 8) {
            const int r0 = SCAN_ROW0(st);
            const float* gp = GATES + (size_t)(r0 + 2 * lane) * 32 + dir * 8 + h;
            const float ig0 = gp[0], ig1 = gp[32], lf0 = gp[16], lf1 = gp[48];
            float ps = lf0 + lf1;
#pragma unroll
            for (int o = 1; o < 64; o <<= 1) { const float t = __shfl_up(ps, o); if (lane >= o) ps += t; }
            const float total = __shfl(ps, 63); const float cum1 = ps, cum0 = ps - lf1;
            float we0, we1;
            if (dir == 0) { we0 = total - cum0 + ig0; we1 = total - cum1 + ig1; } else { we0 = (cum0 - lf0) + ig0; we1 = (cum1 - lf1) + ig1; }
            const float mloc = wave_max(fmaxf(we0, we1));
            weT[st * 128 + 2 * lane] = we0; weT[st * 128 + 2 * lane + 1] = we1;
            if (lane == 0) { totT[st] = total; mlocT[st] = mloc; }
        }
        __syncthreads();
        if (wave == 0) {
            float m = 0.f;
#pragma unroll 1
            for (int st = 0; st < 34; ++st) { const float total = totT[st], mloc = mlocT[st]; const float mnew = fmaxf(total + m, mloc); const float dec = __expf(total + m - mnew);
                if (lane == 0) { mbefT[st] = m; mnewT[st] = mnew; decT[st] = dec; } m = mnew; }
        }
        __syncthreads();
        u32x4 nk[2], nv[2];
#define SCAN_LOAD(st) do { const bool ic_ = (st) < 2; const int r0_ = SCAN_ROW0(st); \
            _Pragma("unroll") for (int i_ = 0; i_ < 2; ++i_) { const int id_ = tid + 512 * i_; const int l_ = id_ >> 3, c_ = id_ & 7; \
                const bf16* kp_ = ic_ ? CTXQK + (size_t)(r0_ - MLAT + l_) * D + 512 + h * 64 + c_ * 8 : QKP + (size_t)(r0_ + l_) * D + 512 + h * 64 + c_ * 8; \
                nk[i_] = *(const u32x4*)kp_; nv[i_] = *(const u32x4*)(QKVO + (size_t)(r0_ + l_) * LDQ1 + 1024 + h * 128 + vh * 64 + c_ * 8); } } while (0)
#define SCAN_STAGE(st) do { LAS char* lk_ = tb + ((st) & 1) * 36864; LAS char* lv_ = lk_ + 18432; const float mn_ = mnewT[st]; \
            _Pragma("unroll") for (int i_ = 0; i_ < 2; ++i_) { const int id_ = tid + 512 * i_; const int l_ = id_ >> 3, c_ = id_ & 7; \
                float f_[8]; unpack8(nk[i_], f_); const float wl_ = __expf(weT[(st) * 128 + l_] - mn_); \
                _Pragma("unroll") for (int e_ = 0; e_ < 8; ++e_) f_[e_] *= wl_; \
                *(LAS u32x4*)(lk_ + l_ * SKS + c_ * 16) = pack8f(f_); *(LAS u32x4*)(lv_ + l_ * SKS + c_ * 16) = nv[i_]; } } while (0)
        SCAN_LOAD(0); SCAN_STAGE(0); SCAN_LOAD(1);
        __syncthreads();
        f32x4 acc[2]; acc[0] = (f32x4){0.f, 0.f, 0.f, 0.f}; acc[1] = acc[0];
        float nst = 0.f;
#pragma unroll 1
        for (int step = 0; step < 34; ++step) {
            if (step >= 2) {
                const int cc = dir ? 31 - (step - 2) : step - 2;
                const size_t idx = (size_t)((b * 8 + h) * 2 + dir) * 32 + cc;
#pragma unroll
                for (int t = 0; t < 2; ++t) { u32x2 w; w.x = pk2(acc[t][0], acc[t][1]); w.y = pk2(acc[t][2], acc[t][3]);
                    *(u32x2*)(SPREV + (idx * 64 + 16 * (dkb0 + t) + fr) * 128 + vh * 64 + 16 * dvb + 4 * g) = w; }
                if (vh == 0 && tid < 64) NPREV[idx * 64 + tid] = nst;
                if (vh == 0 && tid == 0) MPREV[idx] = mbefT[step];
            }
            if (step + 1 < 34) { SCAN_STAGE(step + 1); if (step + 2 < 34) SCAN_LOAD(step + 2); }
            const LAS char* lk = tb + (step & 1) * 36864; const LAS char* lv = lk + 18432;
            const float decay = decT[step];
            acc[0] = acc[0] * decay; acc[1] = acc[1] * decay;
#pragma unroll
            for (int s4 = 0; s4 < 4; ++s4) {
                const int rb = (32 * s4 + 8 * g + q4) * SKS;
                const bf16x8 af = cat44(trread(lv + rb + (16 * dvb + 4 * p4) * 2), trread(lv + rb + 4 * SKS + (16 * dvb + 4 * p4) * 2));
#pragma unroll
                for (int t = 0; t < 2; ++t) { const bf16x8 bfr = cat44(trread(lk + rb + (16 * (dkb0 + t) + 4 * p4) * 2), trread(lk + rb + 4 * SKS + (16 * (dkb0 + t) + 4 * p4) * 2));
                    acc[t] = MFMA16(af, bfr, acc[t]); }
            }
            { const int dk = tid & 63, part = tid >> 6; float s = 0.f;
#pragma unroll
              for (int l = 0; l < 16; ++l) s += bf2f(*(const LAS unsigned short*)(lk + (part * 16 + l) * SKS + dk * 2));
              lnb[(step & 1) * 512 + part * 64 + dk] = s; }
            __syncthreads();
            if (tid < 64) { float s = 0.f;
#pragma unroll
                for (int pt = 0; pt < 8; ++pt) s += lnb[(step & 1) * 512 + pt * 64 + tid];
                nst = decay * nst + s; }
        }
        __syncthreads();
#undef SCAN_ROW0
#undef SCAN_LOAD
#undef SCAN_STAGE
    }
}

constexpr int OVS = 272;
__device__ __forceinline__ void phase_mlout(const bf16* QKVO, const bf16* QKP, const float* GATES, const bf16* SPREV, const float* NPREV, const float* MPREV, const float* normg, bf16* HN,
                                            LAS unsigned char* lds, int tid, int lane, int wave) {
    LAS char* lk = (LAS char*)lds; LAS char* lv = (LAS char*)lds + 18432; LAS char* ls = (LAS char*)lds + 53248;
    LAS float* arr = (LAS float*)(lds + 88064);
    const int g = lane >> 4, fr = lane & 15, q4 = (lane & 15) >> 2, p4 = lane & 3;
    u32x4 pvv[4], pss[4]; float pg0 = 0.f, pg1 = 0.f, pl0 = 0.f, pl1 = 0.f, pmp = 0.f, pnp = 0.f; bf16x8 pq[2];
#define MLOUT_LOAD(it_) do { const int c_ = (it_) & 31, h_ = ((it_) >> 5) & 7, b_ = (it_) >> 8; const int r0_ = b_ * TL + c_ * 128; \
        _Pragma("unroll") for (int i_ = 0; i_ < 4; ++i_) { const int id_ = tid + 512 * i_; pvv[i_] = *(const u32x4*)(QKVO + (size_t)(r0_ + (id_ >> 4)) * LDQ1 + 1024 + h_ * 128 + (id_ & 15) * 8); } \
        _Pragma("unroll") for (int i_ = 0; i_ < 4; ++i_) { const int id_ = tid + 512 * i_; const int dr_ = id_ >> 10, rem_ = id_ & 1023; \
            const size_t ix_ = (size_t)((b_ * 8 + h_) * 2 + dr_) * 32 + c_; pss[i_] = *(const u32x4*)(SPREV + (ix_ * 64 + (rem_ >> 4)) * 128 + (rem_ & 15) * 8); } \
        { const int tq_ = r0_ + 16 * wave + fr; const bf16* qp_ = QKP + (size_t)tq_ * D + h_ * 64 + 8 * g; pq[0] = *(const bf16x8*)qp_; pq[1] = *(const bf16x8*)(qp_ + 32); } \
        if (wave < 2) { const size_t ix_ = (size_t)((b_ * 8 + h_) * 2 + wave) * 32 + c_; const float* gp_ = GATES + (size_t)(r0_ + 2 * lane) * 32 + wave * 8 + h_; \
            pg0 = gp_[0]; pg1 = gp_[32]; pl0 = gp_[16]; pl1 = gp_[48]; pmp = MPREV[ix_]; pnp = NPREV[ix_ * 64 + lane]; } } while (0)
    if ((int)blockIdx.x < 2048) MLOUT_LOAD((int)blockIdx.x);
    for (int item = blockIdx.x; item < 2048; item += gridDim.x) {
        const int c = item & 31, h = (item >> 5) & 7, b = item >> 8;
        const int row0 = b * TL + c * 128;
#pragma unroll
        for (int i = 0; i < 2; ++i) { const int id = tid + 512 * i; const int l = id >> 3, c16 = id & 7; *(LAS u32x4*)(lk + l * SKS + c16 * 16) = *(const u32x4*)(QKP + (size_t)(row0 + l) * D + 512 + h * 64 + c16 * 8); }
#pragma unroll
        for (int i = 0; i < 4; ++i) { const int id = tid + 512 * i; const int l = id >> 4, c16 = id & 15; *(LAS u32x4*)(lv + l * OVS + c16 * 16) = pvv[i]; }
#pragma unroll
        for (int i = 0; i < 4; ++i) { const int id = tid + 512 * i; const int dr = id >> 10, rem = id & 1023; const int l = rem >> 4, c16 = rem & 15; *(LAS u32x4*)(ls + dr * 17408 + l * OVS + c16 * 16) = pss[i]; }
        const float cg0 = pg0, cg1 = pg1, cl0 = pl0, cl1 = pl1, cmp_ = pmp, cnp = pnp; bf16x8 qf[2]; qf[0] = pq[0]; qf[1] = pq[1];
        if (item + (int)gridDim.x < 2048) MLOUT_LOAD(item + (int)gridDim.x);
        if (wave < 2) {
            const int dr = wave; const size_t idx = (size_t)((b * 8 + h) * 2 + dr) * 32 + c;
            const float ig0 = cg0, ig1 = cg1, lf0 = cl0, lf1 = cl1;
            float ps = lf0 + lf1;
#pragma unroll
            for (int o = 1; o < 64; o <<= 1) { const float t = __shfl_up(ps, o); if (lane >= o) ps += t; }
            const float total = __shfl(ps, 63);
            float cum0, cum1;
            if (dr == 0) { cum1 = ps; cum0 = ps - lf1; } else { cum0 = total - (ps - lf1 - lf0); cum1 = total - (ps - lf1); }
            const float a0 = ig0 - cum0, a1 = ig1 - cum1;
            float am0, am1;
            if (dr == 0) { float pm = fmaxf(a0, a1);
#pragma unroll
                for (int o = 1; o < 64; o <<= 1) { const float t = __shfl_up(pm, o); if (lane >= o) pm = fmaxf(pm, t); }
                float prev = __shfl_up(pm, 1); if (lane == 0) prev = -1e30f; am0 = fmaxf(prev, a0); am1 = pm;
            } else { float pm = fmaxf(a0, a1);
#pragma unroll
                for (int o = 1; o < 64; o <<= 1) { const float t = __shfl_down(pm, o); if (lane + o < 64) pm = fmaxf(pm, t); }
                float nxt = __shfl_down(pm, 1); if (lane == 63) nxt = -1e30f; am0 = pm; am1 = fmaxf(nxt, a1);
            }
            const float mp = cmp_;
            const float mx0 = fmaxf(mp, am0), mx1 = fmaxf(mp, am1);
            LAS float* ar = arr + dr * 576;
            ar[2 * lane] = a0; ar[2 * lane + 1] = a1;
            ar[128 + 2 * lane] = -mx0; ar[128 + 2 * lane + 1] = -mx1;
            ar[256 + 2 * lane] = __expf(mp - mx0); ar[256 + 2 * lane + 1] = __expf(mp - mx1);
            ar[384 + 2 * lane] = __expf(-(cum0 + mx0)); ar[384 + 2 * lane + 1] = __expf(-(cum1 + mx1));
            ar[512 + lane] = cnp;
        }
        __syncthreads();
        const int tq = row0 + 16 * wave + fr; const int iq = 16 * wave + fr;
        u32x2 cow[8];
#pragma unroll
        for (int d = 0; d < 8; ++d) cow[d] = *(const u32x2*)(QKVO + (size_t)tq * LDQ1 + 2048 + h * 128 + 16 * d + 4 * g);
        float qv[16];
        { float t8[8]; unpack8(__builtin_bit_cast(u32x4, qf[0]), t8);
#pragma unroll
          for (int e = 0; e < 8; ++e) qv[e] = t8[e];
          unpack8(__builtin_bit_cast(u32x4, qf[1]), t8);
#pragma unroll
          for (int e = 0; e < 8; ++e) qv[8 + e] = t8[e]; }
        f32x4 hsum[8];
#pragma unroll
        for (int d = 0; d < 8; ++d) hsum[d] = (f32x4){0.f, 0.f, 0.f, 0.f};
#pragma unroll
        for (int dr = 0; dr < 2; ++dr) {
            const LAS float* ar = arr + dr * 576;
            const float bmq = ar[128 + iq], inter = ar[256 + iq], emq = ar[384 + iq];
            float qn = 0.f;
#pragma unroll
            for (int e = 0; e < 8; ++e) { qn += qv[e] * ar[512 + 8 * g + e]; qn += qv[8 + e] * ar[512 + 32 + 8 * g + e]; }
            qn += __shfl_xor(qn, 16); qn += __shfl_xor(qn, 32);
            bf16x8 qs[2];
            { float t8[8];
#pragma unroll
              for (int e = 0; e < 8; ++e) t8[e] = qv[e] * inter;
              qs[0] = __builtin_bit_cast(bf16x8, pack8f(t8));
#pragma unroll
              for (int e = 0; e < 8; ++e) t8[e] = qv[8 + e] * inter;
              qs[1] = __builtin_bit_cast(bf16x8, pack8f(t8)); }
            f32x4 acc[8];
            const LAS char* lsd = ls + dr * 17408;
#pragma unroll
            for (int d = 0; d < 8; ++d) { acc[d] = (f32x4){0.f, 0.f, 0.f, 0.f};
#pragma unroll
                for (int ks = 0; ks < 2; ++ks) { const int rb = (32 * ks + 8 * g + q4) * OVS + (16 * d + 4 * p4) * 2;
                    acc[d] = MFMA16(cat44(trread(lsd + rb), trread(lsd + rb + 4 * OVS)), qs[ks], acc[d]); } }
            float psum = 0.f;
            const int jlo = dr == 0 ? 0 : (wave >> 1), jhi = dr == 0 ? (wave >> 1) : 3;
            for (int jp = jlo; jp <= jhi; ++jp) {
                float pv[8];
#pragma unroll
                for (int jj = 0; jj < 2; ++jj) { const int jb = 2 * jp + jj;
                    const LAS char* kp = lk + (16 * jb + fr) * SKS + 8 * g * 2;
                    f32x4 st = MFMA16(*(const LAS bf16x8*)kp, qf[0], ((f32x4){0.f, 0.f, 0.f, 0.f})); st = MFMA16(*(const LAS bf16x8*)(kp + 64), qf[1], st);
                    const f32x4 av = *(const LAS f32x4*)(ar + 16 * jb + 4 * g);
#pragma unroll
                    for (int e = 0; e < 4; ++e) { const int j = 16 * jb + 4 * g + e; const bool valid = dr == 0 ? (j <= iq) : (j >= iq);
                        const float wgt = valid ? __expf(bmq + av[e]) : 0.f; const float pe = wgt * st[e]; pv[jj * 4 + e] = pe; psum += pe; } }
                const bf16x8 pf = __builtin_bit_cast(bf16x8, pack8f(pv));
#pragma unroll
                for (int d = 0; d < 8; ++d) { const int rb0 = (32 * jp + 4 * g + q4) * OVS + (16 * d + 4 * p4) * 2;
                    acc[d] = MFMA16(cat44(trread(lv + rb0), trread(lv + rb0 + 16 * OVS)), pf, acc[d]); }
            }
            psum += __shfl_xor(psum, 16); psum += __shfl_xor(psum, 32);
            const float den = inter * qn + psum;
            const float hs = 1.0f / fmaxf(fabsf(den), emq);
#pragma unroll
            for (int d = 0; d < 8; ++d) hsum[d] = hsum[d] + acc[d] * hs;
        }
        float ss = 0.f;
#pragma unroll
        for (int d = 0; d < 8; ++d) ss += (hsum[d][0] * hsum[d][0] + hsum[d][1] * hsum[d][1]) + (hsum[d][2] * hsum[d][2] + hsum[d][3] * hsum[d][3]);
        ss += __shfl_xor(ss, 16); ss += __shfl_xor(ss, 32);
        const float rstd = rsqrtf(ss * (1.f / 128.f) + EPS);
#pragma unroll
        for (int d = 0; d < 8; ++d) { const int col = h * 128 + 16 * d + 4 * g;
            const f32x4 ng = *(const f32x4*)(normg + col); const u32x2 ow = cow[d];
            const float o0 = bflo(ow.x), o1 = bfhi(ow.x), o2 = bflo(ow.y), o3 = bfhi(ow.y);
            u32x2 w; w.x = pk2(hsum[d][0] * rstd * ng[0] * fast_sig(o0), hsum[d][1] * rstd * ng[1] * fast_sig(o1));
            w.y = pk2(hsum[d][2] * rstd * ng[2] * fast_sig(o2), hsum[d][3] * rstd * ng[3] * fast_sig(o3));
            *(u32x2*)(HN + (size_t)tq * D + col) = w; }
        __syncthreads();
    }
}

#define XB_TMO      128
#define XB_XCNT(j)  (256  + 64 * (j))
#define XB_XSUB(j)  (1280 + 64 * (j))
#define XB_XGEN(j)  (2304 + 64 * (j))
#define XB_TOP      3328
#define XB_TOPGEN   3392
#define XCD_BAR_WORDS 3456
#define XB_SPIN_CAP (1u << 18)

__device__ __forceinline__ unsigned xb_ld(unsigned* p)              { return __hip_atomic_load(p, __ATOMIC_RELAXED, __HIP_MEMORY_SCOPE_AGENT); }
__device__ __forceinline__ unsigned xb_add(unsigned* p, unsigned v) { return __hip_atomic_fetch_add(p, v, __ATOMIC_RELAXED, __HIP_MEMORY_SCOPE_AGENT); }
__device__ __forceinline__ unsigned xb_xcc_id() { return (unsigned)__builtin_amdgcn_s_getreg((3 << 11) | 20) & 0xFu; }
#define XB_SPIN(cond, bar) do { unsigned _sp = 0; while (cond) { __builtin_amdgcn_s_sleep(1); \
    if ((++_sp & 255u) == 0u) { if (xb_ld(&(bar)[XB_TMO])) break; if (_sp > XB_SPIN_CAP) { atomicAdd(&(bar)[XB_TMO], 1u); break; } } } } while (0)

struct XcdBarrier {
    unsigned* bar; unsigned x;
    volatile LAS unsigned* st;
};

__device__ __forceinline__ XcdBarrier xcd_barrier_post(unsigned* bar, volatile LAS unsigned* st) {
    XcdBarrier b; b.bar = bar; b.x = xb_xcc_id(); b.st = st;
    if (threadIdx.x == 0) (void)xb_add(&bar[XB_XCNT(b.x)], 1u);
    return b;
}
__device__ __forceinline__ void xcd_barrier_complete(unsigned* bar, unsigned x, unsigned& nloc, unsigned& nx) {
    const unsigned G = gridDim.x * gridDim.y * gridDim.z;
    unsigned sum, cnt, mine, sp = 0u;
    for (;;) {
        sum = 0u; cnt = 0u; mine = 0u;
#pragma unroll
        for (unsigned j = 0; j < 16; ++j) { const unsigned c = xb_ld(&bar[XB_XCNT(j)]); sum += c; cnt += (c > 0u) ? 1u : 0u; mine = (j == x) ? c : mine; }
        if (sum == G) break;
        __builtin_amdgcn_s_sleep(1);
        if ((++sp & 255u) == 0u) { if (xb_ld(&bar[XB_TMO])) break; if (sp > XB_SPIN_CAP) { atomicAdd(&bar[XB_TMO], 1u); break; } }
    }
    nloc = mine > 0u ? mine : 1u; nx = cnt > 0u ? cnt : 1u;
}

__device__ __forceinline__ void xcd_barrier(const XcdBarrier& b) {
    asm volatile("s_waitcnt vmcnt(0)" ::: "memory");
    __syncthreads();
    if (threadIdx.x == 0) {
        unsigned* bar = b.bar;
        __builtin_amdgcn_s_waitcnt(0);
        unsigned nloc = b.st[0], nx = b.st[1];
        if (nloc == 0u) { xcd_barrier_complete(bar, b.x, nloc, nx); b.st[0] = nloc; b.st[1] = nx; }
        const unsigned old = xb_add(&bar[XB_XSUB(b.x)], 1u);
        const unsigned gen = old / nloc;
        if (old + 1u == (gen + 1u) * nloc) {
            __builtin_amdgcn_fence(__ATOMIC_RELEASE, "agent");
            asm volatile("s_waitcnt vmcnt(0)" ::: "memory");
            const unsigned og = xb_add(&bar[XB_TOP], 1u);
            const unsigned tg = og / nx;
            if (og + 1u == (tg + 1u) * nx) xb_add(&bar[XB_TOPGEN], 1u);
            else XB_SPIN(xb_ld(&bar[XB_TOPGEN]) == tg, bar);
            __builtin_amdgcn_fence(__ATOMIC_ACQUIRE, "agent");
            xb_add(&bar[XB_XGEN(b.x)], 1u);
            asm volatile("s_waitcnt vmcnt(0)" ::: "memory");
        } else {
            XB_SPIN(xb_ld(&bar[XB_XGEN(b.x)]) == gen, bar);
            __builtin_amdgcn_fence(__ATOMIC_ACQUIRE, "agent");
            asm volatile("s_waitcnt vmcnt(0)" ::: "memory");
        }
    }
    __syncthreads();
}

__global__ void __launch_bounds__(NTHR) fwd_megakernel(Params p) {
    extern __shared__ __attribute__((aligned(16))) unsigned char lds_raw[];
    LAS unsigned char* lds = (LAS unsigned char*)lds_raw;
    cg::grid_group grid = cg::this_grid();
    const int tid = threadIdx.x, lane = tid & 63, wave = __builtin_amdgcn_readfirstlane(tid >> 6);
#define KWS ((unsigned char*)((const unsigned char* const __attribute__((address_space(4)))*)kin())[27])
#define KOUT ((unsigned char*)((const unsigned char* const __attribute__((address_space(4)))*)kin())[26])
#define ws KWS
#define mod ((float*)(KWS + WS_MOD))
#define BUFA ((bf16*)(KWS + WS_BUFA))
#define XSA ((bf16*)(KWS + WS_XS))
#define XSB ((bf16*)(KWS + WS_XS + 68 * MiB))
#define QKV ((bf16*)(KWS + WS_QKV))
#define GATES ((float*)(KWS + WS_GATES))
#define CTXQK ((bf16*)(KWS + WS_CTXQK))
#define NPREV ((float*)(KWS + WS_NPREV))
#define MPREV ((float*)(KWS + WS_MPREV))
#define QKP ((bf16*)KOUT)
#define SPREV ((bf16*)(KOUT + 64 * MiB))
#define x_in (kin()[0])
#define ctx_in (kin()[2] - (size_t)MLAT * D)
    const int lo = p.ph_lo, hi = p.ph_hi;
    if (tid < 4) ((LAS unsigned*)(lds + LDS_XB_OFF))[tid] = 0u;
    __syncthreads();
    const XcdBarrier xbar = xcd_barrier_post((unsigned*)(ws + WS_BAR), (volatile LAS unsigned*)(lds + LDS_XB_OFF));
    const int G = gridDim.x, bx = blockIdx.x;
#define RUN(k) (lo <= (k) && (k) < hi)
#define NREP(k) ((((REPMASK) >> (k)) & 1) ? 2 : 1)
#define SIDE(units) const int ex_ = (units) % G; const bool idle_ = ex_ == 0 || bx >= ex_; const int rank_ = ex_ == 0 ? bx : bx - ex_, nblk_ = ex_ == 0 ? G : G - ex_;
#define SYNC(k) do { if (RUN(k) && (k) + 1 < hi) { if (hi > 1000) grid.sync(); else xcd_barrier(xbar); } } while (0)

    if (RUN(0)) for (int rp = 0; rp < NREP(0); ++rp) phase_prologue(p, lds, tid, lane, wave);
    SYNC(0);
#define RSS ((float*)(KWS + WS_RSS))
#define SHW ((const float*)(KWS + WS_SHW))
#define GM ((const float*)(KWS + WS_GM))
#define GMI (GM + 3 * 9216)
#define AOUT ((bf16*)KOUT)
    if (RUN(1)) { phase_aux(p, lds, tid, lane, wave); phase_norm(x_in, ctx_in, kin()[6], mod, 0, 1024, MT, BUFA, lane, wave); }
    SYNC(1);
    if (RUN(2)) { pg8::Gemm g{BUFA, (const bf16*)(ws + WS_W_ABIN), MT, NAB, D}; pg8::StaticOrder S; S.init(MT, NAB, G, bx); pg8::EpiStoreGLU E{QKV, LDQ0};
        pg8::gemm_phase<pg8::EpiStoreGLU, pg8::StaticOrder, true, true>(lds, g, S, E);
        SIDE((MT / 256) * (NAB / 256)); if (idle_) side_weights(p, 0, rank_, nblk_, lds, tid, lane, wave); }
    SYNC(2);
    if (RUN(4)) { shw_compute(p, 0, bx, G, lds, tid, lane, wave);
        for (int rp = 0; rp < NREP(20); ++rp) phase_conv(QKV, kin()[15], kin()[16], kin()[17], kin()[18], BUFA, lds, tid, lane, wave);
        for (int rp = 0; rp < NREP(4); ++rp) phase_attn(QKV, kin()[14], kin()[12], kin()[13], BUFA, lds, lane, wave); }
    SYNC(4);
    if (RUN(5)) { pg8::Gemm g{BUFA, (const bf16*)(ws + WS_W_ABOUT), MT, D, D}; pg8::StaticOrder S; S.init(MT, D, G, bx); pg8::EpiResid2<false> E{x_in, ctx_in, nullptr, mod + 2048, GM, AOUT, RSS};
        pg8::gemm_phase<pg8::EpiResid2<false>, pg8::StaticOrder, true, true>(lds, g, S, E);
        SIDE((MT / 256) * (D / 256)); if (idle_) { side_weights(p, 1, rank_, nblk_, lds, tid, lane, wave); side_weights(p, 2, rank_, nblk_, lds, tid, lane, wave); } }
    SYNC(5);
    if (RUN(7)) { pg8::Gemm g{AOUT, (const bf16*)(ws + WS_W_GU0), MT, 2 * DFF, D}; pg8::StaticOrder S; S.init(MT, 2 * DFF, G, bx); pg8::EpiSwiGLU2 E{QKV, DFF, RSS, SHW, 2 * DFF};
        pg8::gemm_phase<pg8::EpiSwiGLU2, pg8::StaticOrder, true, true>(lds, g, S, E);
        SIDE((MT / 256) * (2 * DFF / 256)); if (idle_) shw_compute(p, 1, rank_, nblk_, lds, tid, lane, wave); }
    SYNC(7);
#define mod1 (mod + 9 * 6144)
    if (G == 256) {
        if (RUN(8)) { pg8::Gemm g{QKV, (const bf16*)(ws + WS_W_DN0), MT, D, DFF}; pg8::StaticOrder S; S.init(MLAT, D, G, bx); pg8::EpiResid2<true> E{AOUT, AOUT, GMI, mod + 5120, GM + 9216, XSB, RSS + MT};
            pg8::gemm_phase<pg8::EpiResid2<true>, pg8::StaticOrder, true, true>(lds, g, S, E); }
        SYNC(8);
        if (RUN(9)) {
            if (bx < 32) { pg8::Gemm g{QKV, (const bf16*)(ws + WS_W_DN0), MT, D, DFF}; pg8::OneUnit S{128 + (bx >> 2), bx & 3, 1}; pg8::EpiResid2<true> E{AOUT, AOUT, GMI, mod + 5120, GM + 9216, XSB, RSS + MT};
                pg8::gemm_phase<pg8::EpiResid2<true>, pg8::OneUnit, true, true>(lds, g, S, E); }
            else { pg8::Gemm g{XSB, (const bf16*)(ws + WS_W_MLIN), MT, NMLP, D}; pg8::XcdPanels S{(bx - 32) & 7, (bx - 32) >> 3, 28, 8, 8, 0, 0, NMLP / 256};
                pg8::EpiMlIn2 E{QKV, GATES, kin()[23], RSS + MT, SHW + 9 * 5632};
                pg8::gemm_phase<pg8::EpiMlIn2, pg8::XcdPanels, true, true>(lds, g, S, E); }
        }
        SYNC(9);
        if (RUN(10)) { pg8::Gemm g{XSB, (const bf16*)(ws + WS_W_MLIN), MT, NMLP, D}; pg8::XcdPanels S{bx & 7, bx >> 3, 32, 9, 8, 64, 128, NMLP / 256};
            pg8::EpiMlIn2 E{QKV, GATES, kin()[23], RSS + MT, SHW + 9 * 5632};
            pg8::gemm_phase<pg8::EpiMlIn2, pg8::XcdPanels, true, true>(lds, g, S, E); }
        SYNC(10);
    } else {
    if (RUN(8)) { pg8::Gemm g{QKV, (const bf16*)(ws + WS_W_DN0), MT, D, DFF}; pg8::StaticOrder S; S.init(MT, D, G, bx); pg8::EpiResid2<true> E{AOUT, AOUT, GMI, mod + 5120, GM + 9216, XSB, RSS + MT};
        pg8::gemm_phase<pg8::EpiResid2<true>, pg8::StaticOrder, true, true>(lds, g, S, E); }
    SYNC(8);
    if (RUN(10)) { pg8::Gemm g{XSB, (const bf16*)(ws + WS_W_MLIN), MT, NMLP, D}; pg8::StaticOrder S; S.init(MT, NMLP, G, bx); pg8::EpiMlIn2 E{QKV, GATES, kin()[23], RSS + MT, SHW + 9 * 5632};
        pg8::gemm_phase<pg8::EpiMlIn2, pg8::StaticOrder, true, true>(lds, g, S, E); }
    SYNC(10);
    }
    if (RUN(11)) shw_compute(p, 2, bx, G, lds, tid, lane, wave);
    if (RUN(11)) for (int rp = 0; rp < NREP(11); ++rp) phase_mlprep(QKV, kin()[21], kin()[22], QKP, CTXQK, lds, lane, wave);
    SYNC(11);
    if (RUN(12)) for (int rp = 0; rp < NREP(12); ++rp) phase_mlscan(QKV, QKP, CTXQK, GATES, SPREV, NPREV, MPREV, lds, tid, lane, wave);
    SYNC(12);
    if (RUN(13)) for (int rp = 0; rp < NREP(13); ++rp) phase_mlout(QKV, QKP, GATES, SPREV, NPREV, MPREV, kin()[24], BUFA, lds, tid, lane, wave);
    SYNC(13);
    if (RUN(14)) { pg8::Gemm g{BUFA, (const bf16*)(ws + WS_W_MLOUT), MLAT, D, D}; pg8::StaticOrder S; S.init(MLAT, D, G, bx); pg8::EpiResid2<true> E{XSB, XSB, GMI + 9216, mod1 + 2048, GM + 2 * 9216, XSA, RSS + 2 * MT};
        pg8::gemm_phase<pg8::EpiResid2<true>, pg8::StaticOrder, true, true>(lds, g, S, E); }
    SYNC(14);
    if (RUN(16)) { pg8::Gemm g{XSA, (const bf16*)(ws + WS_W_GU1), MLAT, 2 * DFF, D}; pg8::StaticOrder S; S.init(MLAT, 2 * DFF, G, bx); pg8::EpiSwiGLU2 E{QKV, DFF, RSS + 2 * MT, SHW + 9 * 5632 + 9 * 3328, 2 * DFF};
        pg8::gemm_phase<pg8::EpiSwiGLU2, pg8::StaticOrder, true, true>(lds, g, S, E); }
    SYNC(16);
    if (RUN(17)) { pg8::Gemm g{QKV, (const bf16*)(ws + WS_W_DN1), MLAT, D, DFF}; pg8::StaticOrder S; S.init(MLAT, D, G, bx); pg8::EpiResid E{XSA, XSA, GMI + 2 * 9216, (float*)KOUT, mod1 + 5120};
        pg8::gemm_phase<pg8::EpiResid, pg8::StaticOrder, true, true>(lds, g, S, E); }
#undef RUN
#undef SYNC
#undef ws
#undef mod
#undef BUFA
#undef XSA
#undef XSB
#undef QKV
#undef GATES
#undef CTXQK
#undef NPREV
#undef MPREV
#undef QKP
#undef SPREV
#undef x_in
#undef ctx_in
#undef RSS
#undef SHW
#undef GM
#undef GMI
#undef AOUT
#undef mod1
#undef KWS
#undef KOUT
}

extern "C" void kernel_launch(void* const* d_in, const int* in_sizes, int n_in, void* d_out, int out_size, void* d_ws, size_t ws_size, hipStream_t stream) {
    static int grid = 0;
    if (grid == 0) {
        if (n_in != 26 || out_size != MLAT * D || ws_size < WS_END) { fprintf(stderr, "kernel_launch: unexpected shapes (n_in %d out %d ws %zu)\n", n_in, out_size, ws_size); grid = -1; return; }
        int dev = 0, cus = 0, per_cu = 0;
        hipGetDevice(&dev); hipDeviceGetAttribute(&cus, hipDeviceAttributeMultiprocessorCount, dev);
        hipFuncSetAttribute((const void*)fwd_megakernel, hipFuncAttributeMaxDynamicSharedMemorySize, LDS_BYTES);
        hipOccupancyMaxActiveBlocksPerMultiprocessor(&per_cu, (const void*)fwd_megakernel, NTHR, LDS_BYTES);
        if (per_cu < 1) { fprintf(stderr, "kernel_launch: occupancy query says %d blocks per CU\n", per_cu); per_cu = 1; }
        (void)hipGetLastError();
        grid = cus * per_cu;
    }
    if (grid < 0) return;
    if (hipMemsetAsync((char*)d_ws + WS_BAR, 0, WS_BAR_BYTES, stream) != hipSuccess) { fprintf(stderr, "kernel_launch: memset of barrier words failed\n"); return; }
    Params p{};
    for (int i = 0; i < 26; ++i) p.in[i] = (const float*)d_in[i];
    p.out = (float*)d_out; p.ws = (unsigned char*)d_ws; p.ph_lo = 0; p.ph_hi = 18; p.rep = REPMASK;
    void* args[] = {&p};
    hipError_t e = hipLaunchCooperativeKernel((const void*)fwd_megakernel, dim3(grid), dim3(NTHR), args, LDS_BYTES, stream);
    if (e != hipSuccess) fprintf(stderr, "cooperative launch failed: %s (grid %d)\n", hipGetErrorString(e), grid);
}
```
